# Optimizing an MI355X kernel written in HIP

```python
import math
import jax, jax.numpy as jnp
from jax import lax
import numpy as np

D_MODEL = 1024
BATCH = 8
SEQ = 4096
DEPTH = 2

HEAD_DIM_A = 64
HEADS_PER_GROUP_A = 4
DIL_GROUPS = ((128, 1), (512, 4), (2048, 16))
N_HEADS_A = HEADS_PER_GROUP_A * len(DIL_GROUPS)
DA = N_HEADS_A * HEAD_DIM_A
DA_OUT = HEADS_PER_GROUP_A * HEAD_DIM_A
POOL_WINDOWS = (2, 4, 8, 16)
POOL_GROUP_DIM = 128
DB = POOL_GROUP_DIM * len(POOL_WINDOWS)
N_HEADS_C = 8
QK_NOPE = 64
QK_ROPE = 32
V_DIM = 64
Q_LORA = 384
KV_LORA = 256
DC = N_HEADS_C * V_DIM
ROPE_THETA = 10000.0
N_EXPERTS = 64
TOP_K = 8
N_GROUPS = 8
TOPK_GROUPS = 4
EXPERT_FF = 256
SHARED_FF = 256
ROUTED_SCALE = 2.5
MOE_BLOCK = 128
Q_BLOCK = 128
EPS = 1e-6
NEG = -1e30
N_IN = 3 * DA + DB + Q_LORA + KV_LORA + QK_ROPE + 3 * D_MODEL

kernel_name = 'hybrid_dilated_pool_mla_moe_adaln'


def rmsnorm(x, g):
    xf = x.astype(jnp.float32)
    y = xf * lax.rsqrt(jnp.mean(xf * xf, axis=-1, keepdims=True) + EPS)
    return (y * g.astype(jnp.float32)).astype(x.dtype)


def adaln(c, w, b):
    m = jax.nn.silu(c) @ w + b
    shift, scale, gate = jnp.split(m, 3, axis=-1)
    return shift[:, None, :], scale[:, None, :], gate[:, None, :]


def rope(x, positions):
    r = x.shape[-1]
    freqs = ROPE_THETA ** (-jnp.arange(0, r, 2, dtype=jnp.float32) / r)
    ang = positions.astype(jnp.float32)[..., None] * freqs
    if x.ndim == 4:
        ang = ang[:, :, None, :]
    cos, sin = jnp.cos(ang), jnp.sin(ang)
    xf = x.astype(jnp.float32)
    x1, x2 = xf[..., : r // 2], xf[..., r // 2:]
    return jnp.concatenate([x1 * cos - x2 * sin, x2 * cos + x1 * sin], axis=-1).astype(x.dtype)


def dilated_attention(q, k, v, dilation, n_back):
    B, S, H, Dh = q.shape
    L = S // dilation
    qb_len = math.gcd(L, Q_BLOCK)
    nb = L // qb_len
    kw_len = qb_len + n_back

    def by_residue(t):
        return t.reshape(B, L, dilation, H, Dh).transpose(0, 2, 1, 3, 4)

    qr, kr, vr = by_residue(q), by_residue(k), by_residue(v)
    pad = ((0, 0), (0, 0), (n_back, 0), (0, 0), (0, 0))
    win = jnp.arange(nb)[:, None] * qb_len + jnp.arange(kw_len)[None, :]
    kw = jnp.pad(kr, pad)[:, :, win]
    vw = jnp.pad(vr, pad)[:, :, win]
    qb = qr.reshape(B, dilation, nb, qb_len, H, Dh)
    s = jnp.einsum('brnqhe,brnkhe->brnhqk', qb, kw).astype(jnp.float32) * (Dh ** -0.5)
    dist = jnp.arange(qb_len)[:, None] + n_back - jnp.arange(kw_len)[None, :]
    kpos = (jnp.arange(nb) * qb_len)[:, None, None] + jnp.arange(kw_len)[None, None, :] - n_back
    valid = ((dist >= 0) & (dist <= n_back))[None] & (kpos >= 0)
    s = jnp.where(valid[None, None, :, None], s, NEG)
    m = jnp.max(s, axis=-1, keepdims=True)
    p = jnp.exp(s - m)
    den = jnp.sum(p, axis=-1, keepdims=True)
    o = jnp.einsum('brnhqk,brnkhe->brnqhe', (p / den).astype(v.dtype), vw)
    lse = (m + jnp.log(den))[..., 0]
    o = o.reshape(B, dilation, L, H, Dh).transpose(0, 2, 1, 3, 4).reshape(B, S, H, Dh)
    lse = lse.transpose(0, 1, 2, 4, 3).reshape(B, dilation, L, H).transpose(0, 2, 1, 3).reshape(B, S, H)
    return o, lse


def pool_mixer(u, pool_w, pool_scale):
    B, S, _ = u.shape
    ug = u.reshape(B, S, len(POOL_WINDOWS), POOL_GROUP_DIM).astype(jnp.float32)
    cs = jnp.cumsum(ug, axis=1)
    t = jnp.arange(S)
    outs = []
    for gi, w in enumerate(POOL_WINDOWS):
        csg = cs[:, :, gi]
        lag = jnp.pad(csg, ((0, 0), (w, 0), (0, 0)))[:, :S]
        cnt = jnp.minimum(t + 1, w).astype(jnp.float32)[None, :, None]
        outs.append((csg - lag) / cnt - ug[:, :, gi])
    pooled = jnp.stack(outs, axis=2).astype(u.dtype)
    mixed = jnp.einsum('bsgc,gcd->bsgd', pooled, pool_w).reshape(B, S, DB)
    return mixed * pool_scale


def mla(cq, ckv, kr, positions, cq_g, ckv_g, w_uq, w_ukv):
    B, S, _ = cq.shape
    q = (rmsnorm(cq, cq_g) @ w_uq).reshape(B, S, N_HEADS_C, QK_NOPE + QK_ROPE)
    qn, qr = q[..., :QK_NOPE], rope(q[..., QK_NOPE:], positions)
    kv = (rmsnorm(ckv, ckv_g) @ w_ukv).reshape(B, S, N_HEADS_C, QK_NOPE + V_DIM)
    kn, v = kv[..., :QK_NOPE], kv[..., QK_NOPE:]
    krr = rope(kr, positions)
    nb = S // Q_BLOCK
    scale = (QK_NOPE + QK_ROPE) ** -0.5
    kpos = jnp.arange(S)

    def blocks(t):
        return t.reshape(B, nb, Q_BLOCK, *t.shape[2:]).swapaxes(0, 1)

    def attend(args):
        i, qn_b, qr_b = args
        s = (jnp.einsum('bqhe,bkhe->bhqk', qn_b, kn) + jnp.einsum('bqhr,bkr->bhqk', qr_b, krr)).astype(jnp.float32) * scale
        qpos = i * Q_BLOCK + jnp.arange(Q_BLOCK)
        s = jnp.where(kpos[None, :] <= qpos[:, None], s, NEG)
        p = jax.nn.softmax(s, axis=-1).astype(v.dtype)
        return jnp.einsum('bhqk,bkhe->bqhe', p, v)

    o = lax.map(attend, (jnp.arange(nb), blocks(qn), blocks(qr)))
    return o.swapaxes(0, 1).reshape(B, S, DC)


def token_mixer(h, positions, w_in, pool_w, pool_scale, cq_g, ckv_g, w_uq, w_ukv, w_oa, w_ob, w_oc, w_out):
    B, S, _ = h.shape
    sizes = (DA, DA, DA, DB, Q_LORA, KV_LORA, QK_ROPE, D_MODEL, D_MODEL, D_MODEL)
    points = [int(p) for p in np.cumsum(sizes)[:-1]]
    qa, ka, va, ub, cq, ckv, kr, ga, gb, gc = jnp.split(h @ w_in, points, axis=-1)
    qa, ka, va = (t.reshape(B, S, N_HEADS_A, HEAD_DIM_A) for t in (qa, ka, va))
    outs, lses = [], []
    for g, (window, dil) in enumerate(DIL_GROUPS):
        sl = slice(g * HEADS_PER_GROUP_A, (g + 1) * HEADS_PER_GROUP_A)
        o, l = dilated_attention(qa[:, :, sl], ka[:, :, sl], va[:, :, sl], dil, window // dil)
        outs.append(o)
        lses.append(l)
    wts = jax.nn.softmax(jnp.stack(lses), axis=0)
    ya = jnp.einsum('gbsh,gbshe->bshe', wts, jnp.stack(outs).astype(jnp.float32)).reshape(B, S, DA_OUT).astype(h.dtype)
    yb = pool_mixer(ub, pool_w, pool_scale)
    yc = mla(cq, ckv, kr, positions, cq_g, ckv_g, w_uq, w_ukv)
    mix = jax.nn.sigmoid(ga) * (ya @ w_oa) + jax.nn.sigmoid(gb) * (yb @ w_ob) + jax.nn.sigmoid(gc) * (yc @ w_oc)
    return mix @ w_out


def routed_experts(h2, router_w, router_bias, w1, w3, w2):
    N, D = h2.shape
    scores = jax.nn.sigmoid((h2 @ router_w).astype(jnp.float32))
    sel = scores + router_bias.astype(jnp.float32)
    grp = sel.reshape(N, N_GROUPS, N_EXPERTS // N_GROUPS)
    grp_score = lax.top_k(grp, 2)[0].sum(-1)
    top_g = lax.top_k(grp_score, TOPK_GROUPS)[1]
    gmask = jax.nn.one_hot(top_g, N_GROUPS, dtype=jnp.float32).sum(1) > 0
    emask = jnp.repeat(gmask, N_EXPERTS // N_GROUPS, axis=1)
    _, idx = lax.top_k(jnp.where(emask, sel, NEG), TOP_K)
    wk = jnp.take_along_axis(scores, idx, axis=1)
    wk = wk / jnp.sum(wk, axis=-1, keepdims=True) * ROUTED_SCALE
    M = N * TOP_K
    flat_e = idx.reshape(-1).astype(jnp.int32)
    flat_tok = jnp.arange(M, dtype=jnp.int32) // TOP_K
    flat_w = wk.reshape(-1)
    order = jnp.argsort(flat_e)
    se = flat_e[order]
    counts = jnp.bincount(flat_e, length=N_EXPERTS)
    padded = (counts + MOE_BLOCK - 1) // MOE_BLOCK * MOE_BLOCK
    start = jnp.cumsum(counts) - counts
    pend = jnp.cumsum(padded)
    pstart = pend - padded
    dest = jnp.arange(M, dtype=jnp.int32) - start[se] + pstart[se]
    P = (M + MOE_BLOCK - 1) // MOE_BLOCK * MOE_BLOCK + N_EXPERTS * MOE_BLOCK
    nblk = P // MOE_BLOCK
    slot_tok = jnp.full((P,), N, jnp.int32).at[dest].set(flat_tok[order])
    slot_w = jnp.zeros((P,), h2.dtype).at[dest].set(flat_w[order].astype(h2.dtype))
    blk_e = jnp.minimum(jnp.searchsorted(pend, jnp.arange(nblk) * MOE_BLOCK, side='right'), N_EXPERTS - 1)
    x_pad = jnp.concatenate([h2, jnp.zeros((1, D), h2.dtype)], axis=0)

    def run(args):
        e, tok, w = args
        xb = x_pad[tok]
        y = (jax.nn.silu(xb @ w1[e]) * (xb @ w3[e])) @ w2[e]
        return y * w[:, None]

    ys = lax.map(run, (blk_e, slot_tok.reshape(nblk, MOE_BLOCK), slot_w.reshape(nblk, MOE_BLOCK)))
    out = jnp.zeros((N + 1, D), h2.dtype).at[slot_tok].add(ys.reshape(P, D))
    return out[:N]


def channel_mixer(h, router_w, router_bias, w1, w3, w2, sh_w1, sh_w3, sh_w2):
    B, S, D = h.shape
    h2 = h.reshape(B * S, D)
    shared = (jax.nn.silu(h2 @ sh_w1) * (h2 @ sh_w3)) @ sh_w2
    return (shared + routed_experts(h2, router_w, router_bias, w1, w3, w2)).reshape(B, S, D)


def setup_inputs(seed: int = 0) -> dict:
    key = jax.random.key(seed)
    ks = jax.random.split(key, 32)
    f32 = jnp.float32
    L = DEPTH

    def nrm(k, shape, fan_in, scale=1.0):
        return jax.random.normal(k, shape, f32) * (scale * fan_in ** -0.5)

    def gain(k, shape):
        return 1.0 + 0.05 * jax.random.normal(k, shape, f32)

    x = jax.random.normal(ks[0], (BATCH, SEQ, D_MODEL), f32)
    c = jax.random.normal(ks[1], (BATCH, D_MODEL), f32)
    positions = (jnp.arange(SEQ, dtype=jnp.int32)[None, :] + jax.random.randint(ks[2], (BATCH, 1), 0, 4096)).astype(jnp.int32)
    return {
        'x': x,
        'c': c,
        'positions': positions,
        'ada_mix_w': nrm(ks[3], (L, D_MODEL, 3 * D_MODEL), D_MODEL, 0.5),
        'ada_mix_b': 0.02 * jax.random.normal(ks[4], (L, 3 * D_MODEL), f32),
        'norm_mix_g': gain(ks[5], (L, D_MODEL)),
        'w_in': nrm(ks[6], (L, D_MODEL, N_IN), D_MODEL),
        'pool_w': nrm(ks[7], (L, len(POOL_WINDOWS), POOL_GROUP_DIM, POOL_GROUP_DIM), POOL_GROUP_DIM),
        'pool_scale': gain(ks[8], (L, DB)),
        'cq_norm_g': gain(ks[9], (L, Q_LORA)),
        'ckv_norm_g': gain(ks[10], (L, KV_LORA)),
        'w_uq': nrm(ks[11], (L, Q_LORA, N_HEADS_C * (QK_NOPE + QK_ROPE)), Q_LORA),
        'w_ukv': nrm(ks[12], (L, KV_LORA, N_HEADS_C * (QK_NOPE + V_DIM)), KV_LORA),
        'w_oa': nrm(ks[13], (L, DA_OUT, D_MODEL), DA_OUT),
        'w_ob': nrm(ks[14], (L, DB, D_MODEL), DB),
        'w_oc': nrm(ks[15], (L, DC, D_MODEL), DC),
        'w_out': nrm(ks[16], (L, D_MODEL, D_MODEL), D_MODEL),
        'ada_ffn_w': nrm(ks[17], (L, D_MODEL, 3 * D_MODEL), D_MODEL, 0.5),
        'ada_ffn_b': 0.02 * jax.random.normal(ks[18], (L, 3 * D_MODEL), f32),
        'norm_ffn_g': gain(ks[19], (L, D_MODEL)),
        'router_w': nrm(ks[20], (L, D_MODEL, N_EXPERTS), D_MODEL),
        'router_bias': 0.01 * jax.random.normal(ks[21], (L, N_EXPERTS), f32),
        'exp_w1': nrm(ks[22], (L, N_EXPERTS, D_MODEL, EXPERT_FF), D_MODEL),
        'exp_w3': nrm(ks[23], (L, N_EXPERTS, D_MODEL, EXPERT_FF), D_MODEL),
        'exp_w2': nrm(ks[24], (L, N_EXPERTS, EXPERT_FF, D_MODEL), EXPERT_FF),
        'sh_w1': nrm(ks[25], (L, D_MODEL, SHARED_FF), D_MODEL),
        'sh_w3': nrm(ks[26], (L, D_MODEL, SHARED_FF), D_MODEL),
        'sh_w2': nrm(ks[27], (L, SHARED_FF, D_MODEL), SHARED_FF),
        'final_g': gain(ks[28], (D_MODEL,)),
    }


def reference(x, c, positions, ada_mix_w, ada_mix_b, norm_mix_g, w_in, pool_w, pool_scale, cq_norm_g, ckv_norm_g, w_uq, w_ukv, w_oa, w_ob, w_oc, w_out, ada_ffn_w, ada_ffn_b, norm_ffn_g, router_w, router_bias, exp_w1, exp_w3, exp_w2, sh_w1, sh_w3, sh_w2, final_g):
    for l in range(DEPTH):
        shift, scale, gate = adaln(c, ada_mix_w[l], ada_mix_b[l])
        h = rmsnorm(x, norm_mix_g[l]) * (1.0 + scale) + shift
        x = x + gate * token_mixer(h, positions, w_in[l], pool_w[l], pool_scale[l], cq_norm_g[l], ckv_norm_g[l], w_uq[l], w_ukv[l], w_oa[l], w_ob[l], w_oc[l], w_out[l])
        shift, scale, gate = adaln(c, ada_ffn_w[l], ada_ffn_b[l])
        h = rmsnorm(x, norm_ffn_g[l]) * (1.0 + scale) + shift
        x = x + gate * channel_mixer(h, router_w[l], router_bias[l], exp_w1[l], exp_w3[l], exp_w2[l], sh_w1[l], sh_w3[l], sh_w2[l])
    return rmsnorm(x, final_g)
```

```cpp
#define MK_PER_PHASE 0
#define T1_SKEW 0
#include <hip/hip_runtime.h>
#include <cstdio>
#include <cstdint>

#define GAS __attribute__((address_space(1)))
#define LAS __attribute__((address_space(3)))
typedef unsigned short bf16;
typedef unsigned v4u __attribute__((ext_vector_type(4)));
typedef unsigned v2u __attribute__((ext_vector_type(2)));
typedef float f32x4 __attribute__((ext_vector_type(4)));
typedef float f32x2 __attribute__((ext_vector_type(2)));
typedef float f32x16 __attribute__((ext_vector_type(16)));
typedef short bf16x8 __attribute__((ext_vector_type(8)));
typedef short s16x4 __attribute__((ext_vector_type(4)));
typedef GAS unsigned gu32;
#define RLX_AGENT __ATOMIC_RELAXED, __HIP_MEMORY_SCOPE_AGENT
#define LDS_WAIT() asm volatile("s_waitcnt lgkmcnt(0)" ::: "memory")
#define VM_WAIT() asm volatile("s_waitcnt vmcnt(0)" ::: "memory")
__device__ __forceinline__ unsigned f2bf(float f) { unsigned u = __builtin_bit_cast(unsigned, f); return (u + 0x7fffu + ((u >> 16) & 1u)) >> 16; }
__device__ __forceinline__ unsigned pk2(float lo, float hi) { return f2bf(lo) | (f2bf(hi) << 16); }
__device__ __forceinline__ float bf2f(unsigned b) { return __builtin_bit_cast(float, b << 16); }
__device__ __forceinline__ float bflo(unsigned w) { return __builtin_bit_cast(float, w << 16); }
__device__ __forceinline__ float bfhi(unsigned w) { return __builtin_bit_cast(float, w & 0xffff0000u); }
__device__ __forceinline__ unsigned cvt_pk_bf16(float lo, float hi) { unsigned r; asm volatile("v_cvt_pk_bf16_f32 %0, %1, %2" : "=v"(r) : "v"(lo), "v"(hi)); return r; }
__device__ __forceinline__ float wave_sum(float v) {
#pragma unroll
    for (int o = 1; o < 64; o <<= 1) v += __shfl_xor(v, o);
    return v;
}
#ifndef FP8_T1
#define FP8_T1 1
#endif
#ifndef FP8_F2
#define FP8_F2 1
#endif
__device__ __forceinline__ unsigned pk4_fp8(float a, float b, float c, float d) {
    a = __builtin_fminf(__builtin_fmaxf(a, -448.f), 448.f); b = __builtin_fminf(__builtin_fmaxf(b, -448.f), 448.f); c = __builtin_fminf(__builtin_fmaxf(c, -448.f), 448.f); d = __builtin_fminf(__builtin_fmaxf(d, -448.f), 448.f);
    unsigned w = 0u; w = __builtin_amdgcn_cvt_pk_fp8_f32(a, b, w, false); w = __builtin_amdgcn_cvt_pk_fp8_f32(c, d, w, true); return w; }
__device__ __forceinline__ unsigned pk4_i8(float a, float b, float c, float d, float inv) {
    const int qa = (int)__builtin_rintf(__builtin_fminf(__builtin_fmaxf(a * inv, -127.f), 127.f)), qb = (int)__builtin_rintf(__builtin_fminf(__builtin_fmaxf(b * inv, -127.f), 127.f));
    const int qc = (int)__builtin_rintf(__builtin_fminf(__builtin_fmaxf(c * inv, -127.f), 127.f)), qd = (int)__builtin_rintf(__builtin_fminf(__builtin_fmaxf(d * inv, -127.f), 127.f));
    return (unsigned)(qa & 255) | ((unsigned)(qb & 255) << 8) | ((unsigned)(qc & 255) << 16) | ((unsigned)(qd & 255) << 24); }
__device__ __forceinline__ float wave_max(float v) {
#pragma unroll
    for (int o = 1; o < 64; o <<= 1) v = fmaxf(v, __shfl_xor(v, o));
    return v;
}
__device__ __forceinline__ float fsigmoid(float x) { return __builtin_amdgcn_rcpf(1.0f + __builtin_amdgcn_exp2f(-1.4426950408889634f * x)); }

namespace pg8 {
constexpr int BM = 256, BK = 64, HALF = 128, HTB = HALF * BK * 2  , STAGE_BYTES = 8 * HTB;
constexpr int ROWTAB_OFF = STAGE_BYTES + 4096;
__host__ __device__ __forceinline__ int lds_byte(int r, int c) { const int st = (r >> 4) * 2 + (c >> 5), rr = r & 15, cc = c & 31, ob = rr * 64 + cc * 2; return st * 1024 + (ob ^ (((ob >> 9) & 1) << 5)); }
__host__ __device__ __forceinline__ void stage_rc(int b, int& R, int& C) { const int st = b / 1024, sb = b % 1024, swz = sb ^ (((sb >> 9) & 1) << 5); R = (st >> 1) * 16 + swz / 64; C = (st & 1) * 32 + (swz % 64) / 2; }
__host__ __device__ __forceinline__ int perm32(int rho) { const int n = rho >> 4, i = rho & 15; return 8 * (i >> 2) + 4 * n + (i & 3); }

typedef int v8i __attribute__((ext_vector_type(8)));
typedef int v4i __attribute__((ext_vector_type(4)));
__device__ __forceinline__ v8i cat8(bf16x8 a, bf16x8 b) { const v4u x = __builtin_bit_cast(v4u, a), y = __builtin_bit_cast(v4u, b); return (v8i){(int)x.x, (int)x.y, (int)x.z, (int)x.w, (int)y.x, (int)y.y, (int)y.z, (int)y.w}; }
constexpr int F8_SCALE_ONE = 0x7f7f7f7f, F8_SCALE_W = 0x7a7a7a7a; constexpr float F8_WMUL = 32.0f;
struct Unit { int pm, pn, e, aux; };
struct Gemm { int K, lda, ldb; int skew = 0; };

struct PermNone { static constexpr bool PERM = false; static constexpr int B_PIECE = 64, B_HALF = 128; __device__ static __forceinline__ int bperm(int r) { return r; } };
struct Perm8 {
    static constexpr bool PERM = true; static constexpr int B_PIECE = 64, B_HALF = 128; __device__ static __forceinline__ int bperm(int r) { return (r & ~31) + perm32(r & 31); } };
struct Perm16 {
    static constexpr bool PERM = true; static constexpr int B_PIECE = 128, B_HALF = 8;
    __device__ static __forceinline__ int bperm(int r) { return 64 * ((r >> 5) & 3) + 16 * ((r & 15) >> 2) + 8 * (r >> 7) + 4 * ((r >> 4) & 1) + (r & 3); } };
#define PG8_USE_PERM(P) static constexpr bool PERM = pg8::P::PERM; static constexpr int B_PIECE = pg8::P::B_PIECE, B_HALF = pg8::P::B_HALF; __device__ static __forceinline__ int bperm(int r) { return pg8::P::bperm(r); }
template <class Epi, class Sched, bool GATHER, int ES = 2, bool KS = false>
__device__ __forceinline__ void gemm_phase(LAS unsigned char* lds, const unsigned char* base, const Gemm g, const Sched& S, const Epi& E) {
    const __amdgpu_buffer_rsrc_t rsrc = __builtin_amdgcn_make_buffer_rsrc((void*)base, 0, 0xffffffff, 0x00020000);
    int tid_ = threadIdx.x; asm volatile("" : "+v"(tid_));
    const int tid = tid_, wid = __builtin_amdgcn_readfirstlane(tid >> 6), lane = tid & 63, wr = wid >> 2, wc = wid & 3, fr = lane & 15, fq = lane >> 4;
    const int K = g.K, nt = K * ES / 128;
    int R0, C0;
    stage_rc(tid * 16, R0, C0); C0 *= 2;
    const int Rb0 = Epi::bperm(R0);
    const unsigned voffB = (unsigned)(Rb0 * g.ldb * ES + C0);
    const unsigned cvA0 = (unsigned)(R0 * g.lda * ES + C0);
    LAS unsigned* rowtab = (LAS unsigned*)(lds + ROWTAB_OFF);
    const unsigned pstepA = 64u * g.lda * ES, pstepB = (unsigned)Epi::B_PIECE * g.ldb * ES;
    const unsigned hstepA = GATHER ? 0u : (unsigned)HALF * g.lda * ES;
    const unsigned kstep = (unsigned)(BK * 2);
    const unsigned hstepB = (unsigned)Epi::B_HALF * g.ldb * ES;
    const unsigned ldsw = (unsigned)wid * 1024u;
    const int aoff = lds_byte(wr * 64 + fr, fq * 8), boff = lds_byte(wc * 32 + fr, fq * 8);
#define PG8_SA(b, h) (((b) * 2 + (h)) * HTB)
#define PG8_SB(b, h) ((4 + (b) * 2 + (h)) * HTB)
#define PG8_STAGEB(bufoff, goff) do { _Pragma("unroll") for (int _i = 0; _i < 2; ++_i) \
        __builtin_amdgcn_raw_ptr_buffer_load_lds(rsrc, (LAS void*)(lds + (bufoff) + ldsw + _i * 8192), 16, voffB, (goff) + _i * pstepB, 0, 0); } while (0)
#define PG8_STAGEA(bufoff, goff, PAR, h) do { _Pragma("unroll") for (int _i = 0; _i < 2; ++_i) { \
        if constexpr (GATHER) __builtin_amdgcn_raw_ptr_buffer_load_lds(rsrc, (LAS void*)(lds + (bufoff) + ldsw + _i * 8192), 16, rowtab[(PAR) * 256 + R0 + 64 * _i + HALF * (h)] + (unsigned)C0, (goff), 0, 0); \
        else __builtin_amdgcn_raw_ptr_buffer_load_lds(rsrc, (LAS void*)(lds + (bufoff) + ldsw + _i * 8192), 16, cvA0, (goff) + (h) * hstepA + _i * pstepA, 0, 0); } } while (0)
#define PG8_LDA(dst, b, h) do { _Pragma("unroll") for (int m = 0; m < 4; ++m) _Pragma("unroll") for (int k = 0; k < 2; ++k) dst[m][k] = *(const LAS bf16x8*)(lds + PG8_SA(b, h) + aoff + m * 2048 + k * 1024); } while (0)
#define PG8_LDB(dst, b, h) do { _Pragma("unroll") for (int n = 0; n < 2; ++n) _Pragma("unroll") for (int k = 0; k < 2; ++k) dst[n][k] = *(const LAS bf16x8*)(lds + PG8_SB(b, h) + boff + n * 2048 + k * 1024); } while (0)
#define PG8_MMA(ai, bj, At, Bt) do { __builtin_amdgcn_s_setprio(1); _Pragma("unroll") for (int m = 0; m < 4; ++m) _Pragma("unroll") for (int n = 0; n < 2; ++n) _Pragma("unroll") for (int k = 0; k < 2; ++k) { \
        if constexpr (ES == 2) acc[ai][bj][m][n] = __builtin_amdgcn_mfma_f32_16x16x32_bf16(Bt[n][k], At[m][k], acc[ai][bj][m][n], 0, 0, 0); \
        else acc[ai][bj][m][n] = __builtin_bit_cast(f32x4, __builtin_amdgcn_mfma_i32_16x16x64_i8(__builtin_bit_cast(pg8::v4i, Bt[n][k]), __builtin_bit_cast(pg8::v4i, At[m][k]), __builtin_bit_cast(pg8::v4i, acc[ai][bj][m][n]), 0, 0, 0)); } \
        __builtin_amdgcn_s_setprio(0); } while (0)
#define PG8_WAIT_V(n) asm volatile("s_waitcnt vmcnt(" #n ")" ::: "memory")
#define PG8_WAIT_L(n) asm volatile("s_waitcnt lgkmcnt(" #n ")" ::: "memory")
#define PG8_BAR __builtin_amdgcn_s_barrier()
#define PG8_SCHED __builtin_amdgcn_sched_barrier(0)
    Unit cur, nxt; int ui = 0;
    if (!S.next(0, cur)) return;
    if (g.skew > 0) { for (int i = 0; i < (int)(blockIdx.x & 7) * g.skew; ++i) __builtin_amdgcn_s_sleep(16); }

    f32x4 acc[2][2][4][2];
#pragma unroll
    for (int a = 0; a < 2; ++a)
#pragma unroll
        for (int b = 0; b < 2; ++b)
#pragma unroll
            for (int m = 0; m < 4; ++m)
#pragma unroll
                for (int n = 0; n < 2; ++n) acc[a][b][m][n] = (f32x4){0.f, 0.f, 0.f, 0.f};
    bf16x8 At[4][2], B0[2][2], B1[2][2];
    unsigned cA = S.a_off(cur), cB = S.b_off(cur);
    asm volatile("" : "+s"(cA), "+s"(cB));
    int par = 0;
    LAS float* kstab = (LAS float*)(lds + ROWTAB_OFF + 2048); int kpar = 0;
    if constexpr (KS) { if (tid < 256) { const f32x2 s = S.kscale(cur, tid); kstab[tid] = fminf(s.x * __builtin_amdgcn_rcpf(s.y), 1000.0f); } }
    if constexpr (GATHER) {
        if (tid < 256) rowtab[tid] = S.a_rowoff(cur, tid);
        asm volatile("s_waitcnt vmcnt(0) lgkmcnt(0)" ::: "memory"); __builtin_amdgcn_s_barrier(); asm volatile("" ::: "memory");
    }
    PG8_STAGEB(PG8_SB(0, 0), cB); PG8_STAGEB(PG8_SB(0, 1), cB + hstepB); PG8_STAGEA(PG8_SA(0, 0), cA, par, 0); PG8_STAGEA(PG8_SA(0, 1), cA, par, 1);
    if (wr == 1) PG8_BAR;
    PG8_WAIT_V(2); PG8_BAR;
    PG8_STAGEB(PG8_SB(1, 0), cB + kstep); PG8_STAGEA(PG8_SA(1, 0), cA + kstep, par, 0); PG8_STAGEB(PG8_SB(1, 1), cB + hstepB + kstep);
    PG8_WAIT_V(6); PG8_BAR;
    for (;;) {
        const bool has_next = S.next(ui + 1, nxt);
        const unsigned nA = has_next ? S.a_off(nxt) : cA, nB = has_next ? S.b_off(nxt) : cB;
        if constexpr (GATHER) {
            if (has_next) {
                if (tid < 256) { const unsigned ro = S.a_rowoff(nxt, tid); rowtab[(par ^ 1) * 256 + tid] = ro; }
                asm volatile("s_waitcnt vmcnt(0) lgkmcnt(0)" ::: "memory");
            }
        }
        if constexpr (KS) {
            if (has_next) { if (tid < 256) { const f32x2 s = S.kscale(nxt, tid); kstab[(kpar ^ 1) * 256 + tid] = fminf(s.x * __builtin_amdgcn_rcpf(s.y), 1000.0f); } }
        }
#pragma unroll 1
        for (int t = 0; t < nt; t += 2) {
            const bool last = (t == nt - 2);
            const unsigned a1 = cA + (unsigned)(t + 1) * kstep;
            const unsigned a2 = last ? nA : cA + (unsigned)(t + 2) * kstep, b2 = last ? nB : cB + (unsigned)(t + 2) * kstep;
            const unsigned a3 = a2 + kstep, b3 = b2 + kstep;
            const int xpar = (GATHER && last && has_next) ? (par ^ 1) : par;
            PG8_LDB(B0, 0, 0); PG8_LDB(B1, 0, 1); PG8_SCHED; PG8_LDA(At, 0, 0); PG8_STAGEA(PG8_SA(1, 1), a1, par, 1);
            PG8_WAIT_V(8); PG8_WAIT_L(0); PG8_BAR; PG8_MMA(0, 0, At, B0); PG8_MMA(0, 1, At, B1); PG8_BAR; PG8_SCHED;
            PG8_LDA(At, 0, 1); PG8_STAGEB(PG8_SB(0, 0), b2); PG8_STAGEB(PG8_SB(0, 1), b2 + hstepB); PG8_STAGEA(PG8_SA(0, 0), a2, xpar, 0);
            PG8_WAIT_V(8); PG8_WAIT_L(0); PG8_BAR; PG8_MMA(1, 0, At, B0); PG8_MMA(1, 1, At, B1); PG8_BAR; PG8_SCHED;
            if constexpr (KS) {
                int t3 = threadIdx.x; asm volatile("" : "+v"(t3)); const LAS float* kp = kstab + kpar * 256 + wr * 64 + (t3 & 15); float rs[8];
#pragma unroll
                for (int i = 0; i < 8; ++i) rs[i] = kp[(i >> 2) * 128 + (i & 3) * 16];
#pragma unroll
                for (int a = 0; a < 2; ++a)
#pragma unroll
                    for (int b = 0; b < 2; ++b)
#pragma unroll
                        for (int m = 0; m < 4; ++m)
#pragma unroll
                            for (int n = 0; n < 2; ++n) { const v4i iv = __builtin_bit_cast(v4i, acc[a][b][m][n]); const float r = rs[a * 4 + m];
                                acc[a][b][m][n] = __builtin_bit_cast(f32x4, (v4i){(int)((float)iv[0] * r), (int)((float)iv[1] * r), (int)((float)iv[2] * r), (int)((float)iv[3] * r)}); }
            }
            PG8_LDB(B0, 1, 0); PG8_LDB(B1, 1, 1); PG8_SCHED; PG8_LDA(At, 1, 0); PG8_STAGEA(PG8_SA(0, 1), a2, xpar, 1);
            PG8_WAIT_V(8); PG8_WAIT_L(0); PG8_BAR; PG8_MMA(0, 0, At, B0); PG8_MMA(0, 1, At, B1); PG8_BAR; PG8_SCHED;
            PG8_LDA(At, 1, 1); PG8_STAGEB(PG8_SB(1, 0), b3); PG8_STAGEB(PG8_SB(1, 1), b3 + hstepB); PG8_STAGEA(PG8_SA(1, 0), a3, xpar, 0);
            PG8_WAIT_V(8); PG8_WAIT_L(0); PG8_BAR; PG8_MMA(1, 0, At, B0); PG8_MMA(1, 1, At, B1); PG8_BAR; PG8_SCHED;
        }
        if (wr == 0) PG8_BAR;
        if constexpr (ES == 1) {
#pragma unroll
            for (int a = 0; a < 2; ++a)
#pragma unroll
                for (int b = 0; b < 2; ++b)
#pragma unroll
                    for (int m = 0; m < 4; ++m)
#pragma unroll
                        for (int n = 0; n < 2; ++n) { const v4i iv = __builtin_bit_cast(v4i, acc[a][b][m][n]); acc[a][b][m][n] = (f32x4){(float)iv[0], (float)iv[1], (float)iv[2], (float)iv[3]}; }
        }
        { int t2 = threadIdx.x; asm volatile("" : "+v"(t2)); E(acc, cur, wr, wc, t2 & 15, (t2 & 63) >> 4); }
        if (!has_next) break;
#pragma unroll
        for (int a = 0; a < 2; ++a)
#pragma unroll
            for (int b = 0; b < 2; ++b)
#pragma unroll
                for (int m = 0; m < 4; ++m)
#pragma unroll
                    for (int n = 0; n < 2; ++n) acc[a][b][m][n] = (f32x4){0.f, 0.f, 0.f, 0.f};
        cur = nxt; cA = nA; cB = nB; ++ui;
        if constexpr (GATHER) par ^= 1;
        if constexpr (KS) kpar ^= 1;
        if (wr == 1) PG8_BAR;
    }
    PG8_WAIT_V(0);
    PG8_BAR;
#undef PG8_SA
#undef PG8_SB
#undef PG8_STAGEA
#undef PG8_STAGEB
#undef PG8_LDA
#undef PG8_LDB
#undef PG8_MMA
#undef PG8_WAIT_V
#undef PG8_WAIT_L
#undef PG8_BAR
#undef PG8_SCHED
}
}

constexpr int DM = 1024, NB = 8, SEQ = 4096, NTOK = NB * SEQ, NLAYER = 2;
constexpr int NIN = 6560, NINP = 6656;
constexpr int NWAVES = 8, NTHR = 512;
constexpr float EPSV = 1e-6f, LOG2E = 1.4426950408889634f;
constexpr float QA_SCALE = 0.125f * LOG2E;
constexpr float QC_SCALE = 0.10206207261596575f * LOG2E;
constexpr int LISTCAP = 16384, NLIST = 128;
constexpr int ACT_SH_ROW = 294912;

constexpr size_t MiB = 1u << 20;
constexpr size_t WS_ZERO = 0, ZERO_BYTES = 2 * MiB;
constexpr int CW_TMO = 0, CW_BAR = 4096, CW_GCNT = 8192;
constexpr size_t WS_ADA = 64 * 1024;
constexpr size_t WS_GVT = 1 * MiB, WS_GS2T = WS_GVT + 64 * 1024;
constexpr size_t WS_MISC = 2 * MiB;
constexpr size_t WS_ROPEC = WS_MISC, WS_ROPES = WS_MISC + 2 * MiB, WS_KRR = WS_MISC + 4 * MiB, WS_LSE = WS_MISC + 6 * MiB, WS_WK = WS_MISC + 8 * MiB;
constexpr size_t WS_SSQ = WS_MISC + 9 * MiB, WS_SSKV = WS_MISC + 10 * MiB + 512 * 1024;
constexpr size_t WS_SA = WS_MISC + 8 * MiB, WS_SA2 = WS_SA + 128 * 1024, WS_SWIN = WS_SA + 256 * 1024, WS_SSH13 = WS_SA + 288 * 1024, WS_SW13 = WS_SA + 320 * 1024;
constexpr size_t WS_SW2 = WS_SA + 448 * 1024, WS_SSH2 = WS_SW2 + 256 * 1024;
constexpr size_t WS_SACT = WS_KRR;
static_assert(WS_SSH2 + 4096 <= WS_SSQ && WS_SACT + 327680 * 8 <= WS_WK, "scale tables");
constexpr size_t WS_W = 14 * MiB;
constexpr size_t WO_WIN = 0, WO_WUQ = WO_WIN + (size_t)NINP * 1024 * 2, WO_WKV = WO_WUQ + 768 * 384 * 2, WO_WOA = WO_WKV + 1024 * 256 * 2, WO_WPB = WO_WOA + 1024 * 256 * 2,
                 WO_WOC = WO_WPB + 1024 * 512 * 2, WO_WOUT = WO_WOC + 1024 * 512 * 2, WO_SH13 = WO_WOUT + 1024 * 1024 * 2, WO_SH2 = WO_SH13 + 512 * 1024 * 2,
                 WO_RTH = WO_SH2 + 1024 * 256 * 2, WO_RTL = WO_RTH + 64 * 1024 * 2, WO_END = WO_RTL + 64 * 1024 * 2;
static_assert(WO_END <= 21 * MiB, "weight region");
constexpr size_t WS_X = 35 * MiB;
constexpr size_t WS_H = 163 * MiB;
constexpr size_t WS_Q = 99 * MiB, WS_H2 = 99 * MiB;
constexpr size_t WS_QKV = 195 * MiB;
constexpr size_t WS_G = 339 * MiB;
constexpr size_t WS_UB = 435 * MiB;
constexpr size_t WS_CQ = 467 * MiB;
constexpr size_t WS_CKV = 499 * MiB;
constexpr size_t WS_KV = 515 * MiB;
constexpr size_t WS_POOL = 579 * MiB;
constexpr size_t WS_WEXP13 = 131 * MiB, WS_WEXP2 = 163 * MiB;
constexpr size_t WS_ACT = 195 * MiB;
constexpr size_t WS_YH = 355 * MiB;
constexpr size_t WS_HIN = WS_H;
constexpr size_t WS_LISTS = 611 * MiB;
constexpr size_t WS_END = 627 * MiB;
constexpr size_t WS_SY = 99 * MiB;
constexpr size_t WS_XMX = WS_UB + 4 * MiB;
constexpr size_t WS_XSS = WS_UB;

constexpr int RING_BYTES = 131072;
constexpr int LDSCTL_OFF = RING_BYTES, MISC_OFF = LDSCTL_OFF + 320, MOE_OFF = LDSCTL_OFF + 1024;
static_assert(pg8::ROWTAB_OFF == LDSCTL_OFF + 4096 && pg8::ROWTAB_OFF + 2048 <= 147456, "gathered-A row table sits in the LDS control area");
constexpr int LDS_BYTES = 147456;

#define XB_TMO      128
#define XB_XCNT(j)  (256  + 64 * (j))
#define XB_XSUB(j)  (1280 + 64 * (j))
#define XB_XGEN(j)  (2304 + 64 * (j))
#define XB_TOP      3328
#define XB_TOPGEN   3392
#define XCD_BAR_WORDS 3456
#define XB_SPIN_CAP (1u << 18)

__device__ __forceinline__ unsigned xb_ld(unsigned* p)              { return __hip_atomic_load(p, __ATOMIC_RELAXED, __HIP_MEMORY_SCOPE_AGENT); }
__device__ __forceinline__ unsigned xb_add(unsigned* p, unsigned v) { return __hip_atomic_fetch_add(p, v, __ATOMIC_RELAXED, __HIP_MEMORY_SCOPE_AGENT); }
__device__ __forceinline__ unsigned xb_xcc_id() { return (unsigned)__builtin_amdgcn_s_getreg((3 << 11) | 20) & 0xFu; }
#define XB_SPIN(cond, bar) do { unsigned _sp = 0; while (cond) { __builtin_amdgcn_s_sleep(1); \
    if ((++_sp & 255u) == 0u) { if (xb_ld(&(bar)[XB_TMO])) break; if (_sp > XB_SPIN_CAP) { atomicAdd(&(bar)[XB_TMO], 1u); break; } } } } while (0)

struct XcdBarrier {
    unsigned* bar; unsigned x;
    volatile LAS unsigned* st;
};

__device__ __forceinline__ XcdBarrier xcd_barrier_post(unsigned* bar, volatile LAS unsigned* st) {
    XcdBarrier b; b.bar = bar; b.x = xb_xcc_id(); b.st = st;
    if (threadIdx.x == 0) (void)xb_add(&bar[XB_XCNT(b.x)], 1u);
    return b;
}
__device__ __forceinline__ void xcd_barrier_complete(unsigned* bar, unsigned x, unsigned& nloc, unsigned& nx) {
    const unsigned G = gridDim.x * gridDim.y * gridDim.z;
    unsigned sum, cnt, mine, sp = 0u;
    for (;;) {
        sum = 0u; cnt = 0u; mine = 0u;
#pragma unroll
        for (unsigned j = 0; j < 16; ++j) { const unsigned c = xb_ld(&bar[XB_XCNT(j)]); sum += c; cnt += (c > 0u) ? 1u : 0u; mine = (j == x) ? c : mine; }
        if (sum == G) break;
        __builtin_amdgcn_s_sleep(1);
        if ((++sp & 255u) == 0u) { if (xb_ld(&bar[XB_TMO])) break; if (sp > XB_SPIN_CAP) { atomicAdd(&bar[XB_TMO], 1u); break; } }
    }
    nloc = mine > 0u ? mine : 1u; nx = cnt > 0u ? cnt : 1u;
}

__device__ __forceinline__ void xcd_barrier(const XcdBarrier& b) {
    asm volatile("s_waitcnt vmcnt(0)" ::: "memory");
    __syncthreads();
    if (threadIdx.x == 0) {
        unsigned* bar = b.bar;
        __builtin_amdgcn_s_waitcnt(0);
        unsigned nloc = b.st[0], nx = b.st[1];
        if (nloc == 0u) { xcd_barrier_complete(bar, b.x, nloc, nx); b.st[0] = nloc; b.st[1] = nx; }
        const unsigned old = xb_add(&bar[XB_XSUB(b.x)], 1u);
        const unsigned gen = old / nloc;
        if (old + 1u == (gen + 1u) * nloc) {
            __builtin_amdgcn_fence(__ATOMIC_RELEASE, "agent");
            asm volatile("s_waitcnt vmcnt(0)" ::: "memory");
            const unsigned og = xb_add(&bar[XB_TOP], 1u);
            const unsigned tg = og / nx;
            if (og + 1u == (tg + 1u) * nx) xb_add(&bar[XB_TOPGEN], 1u);
            else XB_SPIN(xb_ld(&bar[XB_TOPGEN]) == tg, bar);
            __builtin_amdgcn_fence(__ATOMIC_ACQUIRE, "agent");
            xb_add(&bar[XB_XGEN(b.x)], 1u);
            asm volatile("s_waitcnt vmcnt(0)" ::: "memory");
        } else {
            XB_SPIN(xb_ld(&bar[XB_XGEN(b.x)]) == gen, bar);
            __builtin_amdgcn_fence(__ATOMIC_ACQUIRE, "agent");
            asm volatile("s_waitcnt vmcnt(0)" ::: "memory");
        }
    }
    __syncthreads();
}


struct Args { const float* in[29]; const int* pos; float* out; unsigned char* ws; int ph_lo, ph_hi; };

struct Frame {
    LAS unsigned char* lds;
    unsigned* ctl; unsigned char* ws;
    int tid, lane, wave, G, bid;
};

__device__ __forceinline__ const float* ada_acc(const Frame& F, int j, int b) { return (const float*)(F.ws + WS_ADA) + ((size_t)j * NB + b) * 3072; }
__device__ __forceinline__ const float* ada_bias(const Args& A, int j) { return ((j & 1) ? A.in[18] : A.in[4]) + (size_t)(j >> 1) * 3072; }

template <int MODE>
__device__ __forceinline__ void tr_item_t(const float* src, int lds_n, int k0, int scol0, const float* kscale, bf16* dst, bf16* dst_lo, int ldd, int drow0, LAS float* scr, int lane, float mul = 1.0f) {
    const int lk = lane >> 3, ln4 = (lane & 7) * 4;
    f32x4 v[8];
#pragma unroll
    for (int i = 0; i < 8; ++i) { v[i] = (f32x4){0.f, 0.f, 0.f, 0.f};
        if (scol0 >= 0) { v[i] = *(const f32x4*)(src + (size_t)(k0 + 8 * i + lk) * lds_n + scol0 + ln4); if (kscale) v[i] = v[i] * kscale[k0 + 8 * i + lk]; } }
#pragma unroll
    for (int i = 0; i < 8; ++i)
#pragma unroll
        for (int c = 0; c < 4; ++c) scr[(ln4 + c) * 65 + 8 * i + lk] = v[i][c];
    LDS_WAIT(); asm volatile("" ::: "memory");
    const int rn = lane & 7, kc = lane >> 3;
#pragma unroll
    for (int j = 0; j < 4; ++j) { const LAS float* s = scr + (rn + 8 * j) * 65 + 8 * kc; float f[8];
#pragma unroll
        for (int q = 0; q < 8; ++q) f[q] = s[q];
        if (MODE == 2) { v2u o; o.x = pk4_fp8(f[0] * mul, f[1] * mul, f[2] * mul, f[3] * mul); o.y = pk4_fp8(f[4] * mul, f[5] * mul, f[6] * mul, f[7] * mul);
            *(v2u*)((unsigned char*)dst + (size_t)(drow0 + rn + 8 * j) * ldd + k0 + 8 * kc) = o; }
        else if (MODE == 0) { v4u o; o.x = pk2(f[0], f[1]); o.y = pk2(f[2], f[3]); o.z = pk2(f[4], f[5]); o.w = pk2(f[6], f[7]);
            *(v4u*)(dst + (size_t)(drow0 + rn + 8 * j) * ldd + k0 + 8 * kc) = o; }
        else { unsigned h[8]; float lo[8];
#pragma unroll
            for (int q = 0; q < 8; ++q) { h[q] = f2bf(f[q]); lo[q] = f[q] - bf2f(h[q]); }
            v4u o; o.x = h[0] | (h[1] << 16); o.y = h[2] | (h[3] << 16); o.z = h[4] | (h[5] << 16); o.w = h[6] | (h[7] << 16);
            *(v4u*)(dst + (size_t)(drow0 + rn + 8 * j) * ldd + k0 + 8 * kc) = o;
            v4u p; p.x = pk2(lo[0], lo[1]); p.y = pk2(lo[2], lo[3]); p.z = pk2(lo[4], lo[5]); p.w = pk2(lo[6], lo[7]);
            *(v4u*)(dst_lo + (size_t)(drow0 + rn + 8 * j) * ldd + k0 + 8 * kc) = p; } }
    LDS_WAIT(); asm volatile("" ::: "memory");
}
__device__ __forceinline__ void tr_item(const float* src, int lds_n, int k0, int scol0, const float* kscale, bf16* dst, int ldd, int drow0, LAS float* scr, int lane) {
    tr_item_t<0>(src, lds_n, k0, scol0, kscale, dst, nullptr, ldd, drow0, scr, lane); }
__device__ __forceinline__ void tr_item_fp8(const float* src, int lds_n, int k0, int scol0, unsigned char* dst, int ldd, int drow0, LAS float* scr, int lane, float mul) {
    tr_item_t<2>(src, lds_n, k0, scol0, nullptr, (bf16*)dst, nullptr, ldd, drow0, scr, lane, mul); }
__device__ __forceinline__ void tr_item_hilo(const float* src, int lds_n, int k0, int scol0, bf16* dhi, bf16* dlo, int ldd, int drow0, LAS float* scr, int lane) {
    tr_item_t<1>(src, lds_n, k0, scol0, nullptr, dhi, dlo, ldd, drow0, scr, lane); }

__device__ __forceinline__ void tr_cols_i8_wg(const float* src, int lds_n, int scol0, unsigned char* dst, int ldd, int drow0, float* scale_out, LAS float* scr, LAS float* CM, int wave, int lane) {
    const int lk = lane >> 3, ln4 = (lane & 7) * 4, kw = wave * 128;
    f32x4 v[16];
#pragma unroll
    for (int i = 0; i < 16; ++i) { v[i] = (f32x4){0.f, 0.f, 0.f, 0.f}; if (scol0 >= 0) v[i] = *(const f32x4*)(src + (size_t)(kw + 8 * i + lk) * lds_n + scol0 + ln4); }
    f32x4 mx = (f32x4){0.f, 0.f, 0.f, 0.f};
#pragma unroll
    for (int i = 0; i < 16; ++i) { mx[0] = fmaxf(mx[0], fabsf(v[i][0])); mx[1] = fmaxf(mx[1], fabsf(v[i][1])); mx[2] = fmaxf(mx[2], fabsf(v[i][2])); mx[3] = fmaxf(mx[3], fabsf(v[i][3])); }
#pragma unroll
    for (int o = 8; o < 64; o <<= 1) { mx[0] = fmaxf(mx[0], __shfl_xor(mx[0], o)); mx[1] = fmaxf(mx[1], __shfl_xor(mx[1], o)); mx[2] = fmaxf(mx[2], __shfl_xor(mx[2], o)); mx[3] = fmaxf(mx[3], __shfl_xor(mx[3], o)); }
    __syncthreads();
    if (lk == 0) *(LAS f32x4*)(CM + wave * 32 + ln4) = mx;
    __syncthreads();
    f32x4 m = *(const LAS f32x4*)(CM + ln4);
#pragma unroll
    for (int w = 1; w < 8; ++w) { const f32x4 t = *(const LAS f32x4*)(CM + w * 32 + ln4); m[0] = fmaxf(m[0], t[0]); m[1] = fmaxf(m[1], t[1]); m[2] = fmaxf(m[2], t[2]); m[3] = fmaxf(m[3], t[3]); }
    f32x4 inv;
#pragma unroll
    for (int cc = 0; cc < 4; ++cc) { const float mm = fmaxf(m[cc], 1e-30f); inv[cc] = (scol0 >= 0) ? 127.0f / mm : 0.f; }
    if (wave == 0 && lk == 0) *(f32x4*)(scale_out + drow0 + ln4) = (scol0 >= 0) ? (f32x4){fmaxf(m[0], 1e-30f), fmaxf(m[1], 1e-30f), fmaxf(m[2], 1e-30f), fmaxf(m[3], 1e-30f)} * (1.0f / 127.0f) : (f32x4){1.f, 1.f, 1.f, 1.f};
    const int rn = lane & 7, kc = lane >> 3;
#pragma unroll
    for (int h = 0; h < 2; ++h) {
#pragma unroll
        for (int i = 0; i < 8; ++i)
#pragma unroll
            for (int cc = 0; cc < 4; ++cc) scr[(ln4 + cc) * 65 + 8 * i + lk] = v[8 * h + i][cc] * inv[cc];
        LDS_WAIT(); asm volatile("" ::: "memory");
#pragma unroll
        for (int j = 0; j < 4; ++j) { const LAS float* s = scr + (rn + 8 * j) * 65 + 8 * kc;
            v2u o; o.x = pk4_i8(s[0], s[1], s[2], s[3], 1.0f); o.y = pk4_i8(s[4], s[5], s[6], s[7], 1.0f);
            *(v2u*)(dst + (size_t)(drow0 + rn + 8 * j) * ldd + kw + 64 * h + 8 * kc) = o; }
        LDS_WAIT(); asm volatile("" ::: "memory");
    }
}

__device__ __forceinline__ void tr_cols_i8_k256(const float* src, int lds_n, int scol0, unsigned char* dst, int drow0, float* scale_out, LAS float* scr, int lane) {
    const int lk = lane >> 3, ln4 = (lane & 7) * 4;
    f32x4 v[32];
#pragma unroll
    for (int i = 0; i < 32; ++i) v[i] = *(const f32x4*)(src + (size_t)(8 * i + lk) * lds_n + scol0 + ln4);
    f32x4 mx = (f32x4){0.f, 0.f, 0.f, 0.f};
#pragma unroll
    for (int i = 0; i < 32; ++i) { mx[0] = fmaxf(mx[0], fabsf(v[i][0])); mx[1] = fmaxf(mx[1], fabsf(v[i][1])); mx[2] = fmaxf(mx[2], fabsf(v[i][2])); mx[3] = fmaxf(mx[3], fabsf(v[i][3])); }
#pragma unroll
    for (int o = 8; o < 64; o <<= 1) { mx[0] = fmaxf(mx[0], __shfl_xor(mx[0], o)); mx[1] = fmaxf(mx[1], __shfl_xor(mx[1], o)); mx[2] = fmaxf(mx[2], __shfl_xor(mx[2], o)); mx[3] = fmaxf(mx[3], __shfl_xor(mx[3], o)); }
    f32x4 inv;
#pragma unroll
    for (int cc = 0; cc < 4; ++cc) { mx[cc] = fmaxf(mx[cc], 1e-30f); inv[cc] = 127.0f / mx[cc]; }
    if (lk == 0) *(f32x4*)(scale_out + drow0 + ln4) = mx * (1.0f / 127.0f);
    const int rn = lane & 7, kc = lane >> 3;
#pragma unroll
    for (int h = 0; h < 4; ++h) {
#pragma unroll
        for (int i = 0; i < 8; ++i)
#pragma unroll
            for (int cc = 0; cc < 4; ++cc) scr[(ln4 + cc) * 65 + 8 * i + lk] = v[8 * h + i][cc] * inv[cc];
        LDS_WAIT(); asm volatile("" ::: "memory");
#pragma unroll
        for (int j = 0; j < 4; ++j) { const LAS float* s = scr + (rn + 8 * j) * 65 + 8 * kc;
            v2u o; o.x = pk4_i8(s[0], s[1], s[2], s[3], 1.0f); o.y = pk4_i8(s[4], s[5], s[6], s[7], 1.0f);
            *(v2u*)(dst + (size_t)(drow0 + rn + 8 * j) * 256 + 64 * h + 8 * kc) = o; }
        LDS_WAIT(); asm volatile("" ::: "memory");
    }
}

__device__ __forceinline__ void sincos_d(float angf, float& s, float& c) {
    const double a = (double)angf;
    const double q = __builtin_rint(a * 0.63661977236758134308);
    double r = __builtin_fma(-q, 1.57079632679489655800e+00, a);
    r = __builtin_fma(-q, 6.12323399573676603587e-17, r);
    const double r2 = r * r;
    double sp = -2.50521083854417187751e-08;
    sp = __builtin_fma(sp, r2, 2.75573192239858906526e-06);
    sp = __builtin_fma(sp, r2, -1.98412698412698412698e-04);
    sp = __builtin_fma(sp, r2, 8.33333333333333333333e-03);
    sp = __builtin_fma(sp, r2, -1.66666666666666666667e-01);
    const double sr = __builtin_fma(sp * r2, r, r);
    double cp = 2.08767569878680989792e-09;
    cp = __builtin_fma(cp, r2, -2.75573192239858906526e-07);
    cp = __builtin_fma(cp, r2, 2.48015873015873015873e-05);
    cp = __builtin_fma(cp, r2, -1.38888888888888888889e-03);
    cp = __builtin_fma(cp, r2, 4.16666666666666666667e-02);
    cp = __builtin_fma(cp, r2, -0.5);
    const double cr = __builtin_fma(cp, r2, 1.0);
    const int qi = (int)q & 3;
    const double ss = (qi == 0) ? sr : (qi == 1) ? cr : (qi == 2) ? -sr : -cr;
    const double cc = (qi == 0) ? cr : (qi == 1) ? -sr : (qi == 2) ? -cr : sr;
    s = (float)ss; c = (float)cc;
}

__constant__ float ROPE_FREQ[16] = {1.0f, 0.5623413324356079f, 0.3162277638912201f, 0.17782793939113617f, 0.10000000149011612f, 0.05623413249850273f, 0.03162277489900589f, 0.017782794311642647f,
    0.009999999776482582f, 0.005623413249850273f, 0.003162277629598975f, 0.0017782794311642647f, 0.0010000000474974513f, 0.000562341301701963f, 0.0003162277571391314f, 0.00017782794020604342f};
__device__ __forceinline__ void p0_phase(const Frame& F, const Args& A) {
    LAS float* sc = (LAS float*)F.lds;
    const float* c = A.in[1];
    for (int i = F.tid; i < NB * DM; i += NTHR) { const float v = c[i]; sc[i] = v / (1.0f + __expf(-v)); }
    __syncthreads();
    float* ada = (float*)(F.ws + WS_ADA);
    for (int item = F.bid; item < 4 * 48; item += F.G) {
        const int j = item / 48, n = (item % 48) * 64 + (F.tid & 63), b = F.tid >> 6;
        const float* w = ((j & 1) ? A.in[17] : A.in[3]) + (size_t)(j >> 1) * DM * 3072 + n;
        float a0 = 0.f, a1 = 0.f, a2 = 0.f, a3 = 0.f;
        for (int k = 0; k < DM; k += 4) {
            a0 += sc[b * DM + k] * w[(size_t)k * 3072]; a1 += sc[b * DM + k + 1] * w[(size_t)(k + 1) * 3072];
            a2 += sc[b * DM + k + 2] * w[(size_t)(k + 2) * 3072]; a3 += sc[b * DM + k + 3] * w[(size_t)(k + 3) * 3072]; }
        ada[((size_t)j * NB + b) * 3072 + n] = (a0 + a1) + (a2 + a3);
    }
    float* rc = (float*)(F.ws + WS_ROPEC); float* rs = (float*)(F.ws + WS_ROPES);
    for (int idx = F.bid * NTHR + F.tid; idx < NTOK * 16; idx += F.G * NTHR) {
        const int tok = idx >> 4, i = idx & 15;
        const float freq = ROPE_FREQ[i];
        const float ang = (float)A.pos[tok] * freq;
        float s, cc; sincos_d(ang, s, cc); rc[idx] = cc; rs[idx] = s;
    }
}

__device__ __forceinline__ int map_win(int n) {
    return n < 3200 ? n : n < 3232 ? 3456 + (n - 3200) : n < 3328 ? -1 : n < 3584 ? 3200 + (n - 3328) : 3488 + (n - 3584);
}
__device__ __forceinline__ void norm_tables(const Frame& F, const Args& A, int j, const float* g, int b0, int nb, LAS float* GS, LAS float* SH) {
    const float* bias = ada_bias(A, j);
    for (int i = F.tid; i < nb * DM; i += NTHR) { const int b = i >> 10, k = i & 1023; const float* acc = ada_acc(F, j, b0 + b);
        GS[i] = g[k] * (1.0f + acc[1024 + k] + bias[1024 + k]); SH[i] = acc[k] + bias[k]; }
}
__device__ __forceinline__ void ada_tables(const Frame& F, const Args& A) {
    float* GV = (float*)(F.ws + WS_GVT); float* GS2 = (float*)(F.ws + WS_GS2T);
    for (int i = F.bid * NTHR + F.tid; i < NLAYER * NB * DM; i += F.G * NTHR) { const int l = i >> 13, b = (i >> 10) & 7, k = i & 1023;
        GV[i] = ada_acc(F, l * 2, b)[2048 + k] + ada_bias(A, l * 2)[2048 + k];
        GS2[i] = A.in[19][l * DM + k] * (1.0f + ada_acc(F, l * 2 + 1, b)[1024 + k] + ada_bias(A, l * 2 + 1)[1024 + k]); }
}
__device__ __forceinline__ void norm_rows(const Frame& F, const Args& A, const float* x, int j, const float* g, unsigned char* H) {
    LAS float* GS = (LAS float*)F.lds; LAS float* SH = GS + NB * DM;
    __syncthreads();
    norm_tables(F, A, j, g, 0, NB, GS, SH);
    __syncthreads();
    const int gw = F.bid * NWAVES + F.wave, NGW = F.G * NWAVES;
    for (int m0 = gw * 4; m0 < NTOK; m0 += NGW * 4) {
        f32x4 v[4][4];
#pragma unroll
        for (int r = 0; r < 4; ++r) { const f32x4* xr = (const f32x4*)(x + (size_t)(m0 + r) * DM) + F.lane;
#pragma unroll
            for (int q = 0; q < 4; ++q) v[r][q] = xr[64 * q]; }
#pragma unroll
        for (int r = 0; r < 4; ++r) { const int m = m0 + r, b = m >> 12; float s = 0.f;
#pragma unroll
            for (int q = 0; q < 4; ++q) s += (v[r][q].x * v[r][q].x + v[r][q].y * v[r][q].y) + (v[r][q].z * v[r][q].z + v[r][q].w * v[r][q].w);
            const float rstd = 1.0f / sqrtf(wave_sum(s) * (1.0f / DM) + EPSV);
            f32x4 h[4]; float am = 0.f;
#pragma unroll
            for (int q = 0; q < 4; ++q) { const int col = 4 * F.lane + 256 * q;
                h[q] = (v[r][q] * rstd) * *(LAS const f32x4*)(GS + b * DM + col) + *(LAS const f32x4*)(SH + b * DM + col);
                am = fmaxf(am, fmaxf(fmaxf(fabsf(h[q].x), fabsf(h[q].y)), fmaxf(fabsf(h[q].z), fabsf(h[q].w)))); }
            if (FP8_T1) { am = fmaxf(wave_max(am), 1e-20f); const float inv = 127.0f / am; if (F.lane == 0) ((float*)(F.ws + WS_SA))[m] = am * (1.0f / 127.0f);
                unsigned* o4 = (unsigned*)(H + (size_t)m * DM) + F.lane;
#pragma unroll
                for (int q = 0; q < 4; ++q) o4[64 * q] = pk4_i8(h[q].x, h[q].y, h[q].z, h[q].w, inv); }
            else {
#pragma unroll
                for (int q = 0; q < 4; ++q) ((unsigned long long*)(H + (size_t)m * DM * 2) + F.lane)[64 * q] = (unsigned long long)pk2(h[q].x, h[q].y) | ((unsigned long long)pk2(h[q].z, h[q].w) << 32); } }
    }
}
__device__ __forceinline__ void convert_layer_weights(const Frame& F, const Args& A, int layer) {
    bf16* Wb = (bf16*)(F.ws + WS_W);
    LAS float* scr = (LAS float*)(F.lds + F.wave * 16384);
    const int gw = F.bid * NWAVES + F.wave, NGW = F.G * NWAVES;
    const float* w_in = A.in[6] + (size_t)layer * DM * NIN;
    const float* w_uq = A.in[11] + (size_t)layer * 384 * 768;   const float* cq_g = A.in[9] + layer * 384;
    const float* w_ukv = A.in[12] + (size_t)layer * 256 * 1024; const float* ckv_g = A.in[10] + layer * 256;
    const float* w_oa = A.in[13] + (size_t)layer * 256 * 1024;
    const float* w_ob = A.in[14] + (size_t)layer * 512 * 1024;
    const float* w_oc = A.in[15] + (size_t)layer * 512 * 1024;
    const float* w_out = A.in[16] + (size_t)layer * 1024 * 1024;
    const float* rt_w = A.in[20] + (size_t)layer * 1024 * 64;
    const float* sh1 = A.in[25] + (size_t)layer * 1024 * 256; const float* sh3 = A.in[26] + (size_t)layer * 1024 * 256; const float* sh2 = A.in[27] + (size_t)layer * 256 * 1024;
    constexpr int I_WIN = FP8_T1 ? 0 : 208 * 16, I_WUQ = 24 * 6, I_WKV = 32 * 4, I_WOA = 32 * 4, I_WOC = 32 * 8, I_WOUT = 32 * 16, I_SH13 = FP8_F2 ? 0 : 16 * 16, I_SH2 = 32, I_RT = 2 * 16;
    constexpr int NITEMS = I_WIN + I_WUQ + I_WKV + I_WOA + I_WOC + I_WOUT + I_SH13 + I_SH2 + I_RT;
    { LAS float* CM = (LAS float*)(F.lds + 12288);
      for (int it = F.bid; it < (FP8_T1 ? 208 : 0) + (FP8_F2 ? 16 : 0); it += F.G) {
        if (FP8_T1 && it < 208) tr_cols_i8_wg(w_in, NIN, map_win(it * 32), (unsigned char*)Wb + WO_WIN, 1024, it * 32, (float*)(F.ws + WS_SWIN), scr, CM, F.wave, F.lane);
        else { const int n0 = (it - (FP8_T1 ? 208 : 0)) * 32, hh = n0 >> 8, rr = n0 & 255;
            tr_cols_i8_wg(rr < 128 ? sh1 : sh3, 256, hh * 128 + (rr & 127), (unsigned char*)Wb + WO_SH13, 1024, n0, (float*)(F.ws + WS_SSH13), scr, CM, F.wave, F.lane); } }
      __syncthreads(); }
    for (int it = gw; it < NITEMS; it += NGW) {
        int r = it;
        if (r < I_WIN) { const int kb = r / 208, nb = r % 208; tr_item(w_in, NIN, kb * 64, map_win(nb * 32), nullptr, (bf16*)((char*)Wb + WO_WIN), 1024, nb * 32, scr, F.lane); continue; } r -= I_WIN;
        if (r < I_WUQ) { const int kb = r / 24, nb = r % 24; tr_item(w_uq, 768, kb * 64, nb * 32, cq_g, (bf16*)((char*)Wb + WO_WUQ), 384, nb * 32, scr, F.lane); continue; } r -= I_WUQ;
        if (r < I_WKV) { const int kb = r / 32, nb = r % 32; tr_item(w_ukv, 1024, kb * 64, nb * 32, ckv_g, (bf16*)((char*)Wb + WO_WKV), 256, nb * 32, scr, F.lane); continue; } r -= I_WKV;
        if (r < I_WOA) { const int kb = r / 32, nb = r % 32; tr_item(w_oa, 1024, kb * 64, nb * 32, nullptr, (bf16*)((char*)Wb + WO_WOA), 256, nb * 32, scr, F.lane); continue; } r -= I_WOA;
        if (r < I_WOC) { const int kb = r / 32, nb = r % 32; tr_item(w_oc, 1024, kb * 64, nb * 32, nullptr, (bf16*)((char*)Wb + WO_WOC), 512, nb * 32, scr, F.lane); continue; } r -= I_WOC;
        if (r < I_WOUT) { const int kb = r / 32, nb = r % 32; tr_item(w_out, 1024, kb * 64, nb * 32, nullptr, (bf16*)((char*)Wb + WO_WOUT), 1024, nb * 32, scr, F.lane); continue; } r -= I_WOUT;
        if (r < I_SH13) { const int kb = r / 16, nb = r % 16, n0 = nb * 32, hh = n0 >> 8, rr = n0 & 255;
            tr_item(rr < 128 ? sh1 : sh3, 256, kb * 64, hh * 128 + (rr & 127), nullptr, (bf16*)((char*)Wb + WO_SH13), 1024, n0, scr, F.lane); continue; } r -= I_SH13;
        if (r < I_SH2) { tr_cols_i8_k256(sh2, 1024, r * 32, (unsigned char*)Wb + WO_SH2, r * 32, (float*)(F.ws + WS_SSH2), scr, F.lane); continue; } r -= I_SH2;
        { const int kb = r / 2, nb = r % 2; tr_item_hilo(rt_w, 64, kb * 64, nb * 32, (bf16*)((char*)Wb + WO_RTH), (bf16*)((char*)Wb + WO_RTL), 1024, nb * 32, scr, F.lane); }
    }
    { const float* pw = A.in[7] + (size_t)layer * 4 * 128 * 128; const float* ps = A.in[8] + layer * 512; bf16* WPB = (bf16*)((char*)Wb + WO_WPB);
      for (int it = gw; it < 4 * 16 * 16; it += NGW) {
        const int g = it >> 8, c8 = (it >> 4) & 15, n = (it & 15) * 64 + F.lane;
        float pv[8][2];
#pragma unroll
        for (int q = 0; q < 8; ++q)
#pragma unroll
            for (int h = 0; h < 2; ++h) pv[q][h] = pw[((size_t)g * 128 + c8 * 8 + q) * 128 + h * 64 + F.lane] * ps[g * 128 + h * 64 + F.lane];
        float acc[8];
#pragma unroll
        for (int q = 0; q < 8; ++q) acc[q] = 0.f;
#pragma unroll
        for (int h = 0; h < 2; ++h)
#pragma unroll 16
            for (int dd = 0; dd < 64; ++dd) { const float wv = w_ob[(size_t)(g * 128 + h * 64 + dd) * 1024 + n];
#pragma unroll
                for (int q = 0; q < 8; ++q) acc[q] += __builtin_bit_cast(float, __builtin_amdgcn_readlane(__builtin_bit_cast(int, pv[q][h]), dd)) * wv; }
        v4u o; o.x = pk2(acc[0], acc[1]); o.y = pk2(acc[2], acc[3]); o.z = pk2(acc[4], acc[5]); o.w = pk2(acc[6], acc[7]);
        *(v4u*)(WPB + (size_t)n * 512 + g * 128 + c8 * 8) = o; } }
}

struct SchedDense {
    unsigned A, Bt; int lda, ldb; int nM, nN, nwg, G, c, es;
    __device__ __forceinline__ void init(size_t A_, size_t Bt_, int lda_, int ldb_, int M, int N, int G_, int c_, int es_ = 2) { A = (unsigned)A_; Bt = (unsigned)Bt_; lda = lda_; ldb = ldb_; es = es_; nM = M / 256; nN = N / 256; nwg = nM * nN; G = G_; c = c_; }
    __device__ __forceinline__ bool next(int i, pg8::Unit& u) const {
        const long L = (long)i * G + c; if (L >= nwg) return false;
        int wgid = (int)L; { const int q = nwg / 8, r = nwg % 8, xcd = wgid % 8, off = wgid / 8; wgid = (xcd < r ? xcd * (q + 1) : r * (q + 1) + (xcd - r) * q) + off; }
        const int nig = 8 * nN, gid = wgid / nig, fm = gid * 8, gsz = (nM - fm) < 8 ? (nM - fm) : 8;
        u.pm = fm + ((wgid % nig) % gsz); u.pn = (wgid % nig) / gsz; u.e = 0; u.aux = 0; return true;
    }
    __device__ __forceinline__ unsigned a_off(const pg8::Unit& u) const { return A + (unsigned)u.pm * 256u * lda * es; }
    __device__ __forceinline__ unsigned b_off(const pg8::Unit& u) const { return Bt + (unsigned)u.pn * 256u * ldb * es; }
    __device__ __forceinline__ unsigned a_rowoff(const pg8::Unit&, int) const { return 0u; }
};

#define OPAQUE_V(v) asm volatile("" : "+v"(v))
struct EpiWin {
    PG8_USE_PERM(Perm8)
    bf16 *QKV, *UB, *CQ, *CKV, *GT; float *SSQ, *SSKV; int dry; const float *SA, *SW;
    __device__ __forceinline__ void operator()(f32x4 (&acc)[2][2][4][2], const pg8::Unit& u, int wr, int wc, int fr, int fq) const {
        if (dry) { float s = 0.f;
#pragma unroll
            for (int ai = 0; ai < 2; ++ai)
#pragma unroll
                for (int m = 0; m < 4; ++m) s += acc[ai][0][m][0][0] + acc[ai][1][m][1][3];
            if (s == 1.2345e-33f) SSQ[0] = 1.f; return; }
        const int pn = u.pn, rowU = u.pm * 256 + wr * 64;
        bf16* base; int pitch, colt, mode = 0; float scl = 1.f; float* ss = nullptr; int ssb = 2, sspitch = 12, ssslot = 0;
        if (pn < 9) { base = QKV; pitch = 2304; colt = pn * 256; if (pn < 3) scl = QA_SCALE; }
        else if (pn < 11) { base = UB; pitch = 512; colt = (pn - 9) * 256; }
        else if (pn < 13) { base = CQ; pitch = 512; colt = (pn - 11) * 256; ss = SSQ; ssb = (pn == 11) ? 2 : 1; ssslot = (pn == 11) ? 0 : 8; }
        else if (pn == 13) { base = CKV; pitch = 256; colt = 0; ss = SSKV; sspitch = 8; }
        else { base = GT; pitch = 3072; colt = (pn - 14) * 256; mode = 1; }
        const unsigned esz = (mode == 1) ? 1u : 2u;
        unsigned lo = (unsigned)(fr * pitch + 8 * fq) * esz; OPAQUE_V(lo);
        unsigned lr4 = (unsigned)fr * 4u; OPAQUE_V(lr4); unsigned lc4 = (unsigned)(8 * fq) * 4u; OPAQUE_V(lc4);
        f32x4 sw[2][2];
#pragma unroll
        for (int bj = 0; bj < 2; ++bj) { const char* sp = (const char*)(SW + pn * 256 + bj * 128 + wc * 32) + lc4; sw[bj][0] = SA ? *(const f32x4*)sp : (f32x4){1.f, 1.f, 1.f, 1.f}; sw[bj][1] = SA ? *(const f32x4*)(sp + 16) : (f32x4){1.f, 1.f, 1.f, 1.f}; }
        char* ub = (char*)base + ((size_t)rowU * pitch + colt + wc * 32) * esz;
        unsigned ll4 = (unsigned)(fq * 16 + fr) * 4u; OPAQUE_V(ll4);
        float sah[2];
#pragma unroll
        for (int ai = 0; ai < 2; ++ai) sah[ai] = SA ? *(const float*)((const char*)(SA + rowU + ai * 128) + ll4) : 1.f;
#pragma unroll
        for (int ai = 0; ai < 2; ++ai)
#pragma unroll
            for (int bj = 0; bj < 2; ++bj)
#pragma unroll
                for (int m = 0; m < 4; ++m) { acc[ai][bj][m][0] = acc[ai][bj][m][0] * sw[bj][0]; acc[ai][bj][m][1] = acc[ai][bj][m][1] * sw[bj][1]; }
#pragma unroll
        for (int ai = 0; ai < 2; ++ai)
#pragma unroll
            for (int m = 0; m < 4; ++m) { char* rb = ub + (size_t)(ai * 128 + m * 16) * pitch * esz; float sq[2] = {0.f, 0.f};
                const float sa = __shfl(sah[ai], m * 16 + fr);
#pragma unroll
                for (int bj = 0; bj < 2; ++bj) { f32x4 v0 = acc[ai][bj][m][0] * sa, v1 = acc[ai][bj][m][1] * sa;
                    sq[bj] = (v0[0] * v0[0] + v0[1] * v0[1]) + (v0[2] * v0[2] + v0[3] * v0[3]) + (v1[0] * v1[0] + v1[1] * v1[1]) + (v1[2] * v1[2] + v1[3] * v1[3]);
                    if (mode == 1) {
                        unsigned q0[4], q1[4];
#pragma unroll
                        for (int q = 0; q < 4; ++q) { q0[q] = (unsigned)fmaxf(fsigmoid(v0[q]) * 255.0f + 0.5f, 1.0f); q1[q] = (unsigned)fmaxf(fsigmoid(v1[q]) * 255.0f + 0.5f, 1.0f); }
                        v2u w8; w8.x = q0[0] | (q0[1] << 8) | (q0[2] << 16) | (q0[3] << 24); w8.y = q1[0] | (q1[1] << 8) | (q1[2] << 16) | (q1[3] << 24);
                        *(v2u*)(rb + bj * 128 + lo) = w8; continue; }
                    v0 = v0 * scl; v1 = v1 * scl;
                    v4u w; w.x = cvt_pk_bf16(v0[0], v0[1]); w.y = cvt_pk_bf16(v0[2], v0[3]); w.z = cvt_pk_bf16(v1[0], v1[1]); w.w = cvt_pk_bf16(v1[2], v1[3]);
                    *(v4u*)(rb + bj * 256 + lo) = w; }
                if (ss) {
#pragma unroll
                    for (int bj = 0; bj < 2; ++bj) { float s = sq[bj]; s += __shfl_xor(s, 16); s += __shfl_xor(s, 32);
                        if (fq == 0 && bj < ssb) ss[(size_t)(rowU + ai * 128 + m * 16 + fr) * sspitch + ssslot + 4 * bj + wc] = s; } } }
    }
};
struct EpiQ {
    PG8_USE_PERM(Perm8)
    bf16* Q; const float* SSQ; const float *RC, *RS;
    __device__ __forceinline__ void operator()(const f32x4 (&acc)[2][2][4][2], const pg8::Unit& u, int wr, int wc, int fr, int fq) const {
        const int rowU = u.pm * 256 + wr * 64;
        unsigned lo = (unsigned)(fr * 768 + 8 * fq) * 2u; OPAQUE_V(lo);
        unsigned lr = (unsigned)fr * 48u; OPAQUE_V(lr);
        unsigned lt = (unsigned)(fr * 16 + 8 * (fq & 1)) * 4u; OPAQUE_V(lt);
        char* ub = (char*)Q + ((size_t)rowU * 768 + u.pn * 256 + wc * 32) * 2;
        float rsh[2];
        { unsigned ll = (unsigned)(fq * 16 + fr) * 48u; OPAQUE_V(ll); f32x4 pa[2], pb[2], pc[2];
#pragma unroll
          for (int ai = 0; ai < 2; ++ai) { const f32x4* sp = (const f32x4*)((const char*)(SSQ + (size_t)(rowU + ai * 128) * 12) + ll); pa[ai] = sp[0]; pb[ai] = sp[1]; pc[ai] = sp[2]; }
#pragma unroll
          for (int ai = 0; ai < 2; ++ai) { const float ssum = (((pa[ai][0] + pa[ai][1]) + (pa[ai][2] + pa[ai][3])) + ((pb[ai][0] + pb[ai][1]) + (pb[ai][2] + pb[ai][3]))) + ((pc[ai][0] + pc[ai][1]) + (pc[ai][2] + pc[ai][3]));
              rsh[ai] = QC_SCALE / sqrtf(ssum * (1.0f / 384.0f) + EPSV); } }
        const int g32a = u.pn * 8 + wc, ropebj = (g32a % 3 == 2) ? 0 : ((g32a + 4) % 3 == 2) ? 1 : -1;
#pragma unroll
        for (int ai = 0; ai < 2; ++ai)
#pragma unroll
        for (int mh = 0; mh < 2; ++mh) {
            f32x4 tc0[2], tc1[2], ts0[2], ts1[2];
            if (ropebj >= 0) {
#pragma unroll
                for (int mm = 0; mm < 2; ++mm) { const int rU = rowU + ai * 128 + (mh * 2 + mm) * 16; const char* tc = (const char*)(RC + (size_t)rU * 16) + lt; const char* ts = (const char*)(RS + (size_t)rU * 16) + lt;
                    tc0[mm] = *(const f32x4*)tc; tc1[mm] = *(const f32x4*)(tc + 16); ts0[mm] = *(const f32x4*)ts; ts1[mm] = *(const f32x4*)(ts + 16); }
            }
#pragma unroll
            for (int mm = 0; mm < 2; ++mm) { const int m = mh * 2 + mm; char* rb = ub + (size_t)(ai * 128 + m * 16) * 768 * 2;
                const float rs = __shfl(rsh[ai], m * 16 + fr);
#pragma unroll
                for (int bj = 0; bj < 2; ++bj) { f32x4 v0 = acc[ai][bj][m][0] * rs, v1 = acc[ai][bj][m][1] * rs;
                    if (bj == ropebj) {
                        const f32x4 c0 = tc0[mm], c1 = tc1[mm], s0 = ts0[mm], s1 = ts1[mm];
                        f32x4 p0, p1;
#pragma unroll
                        for (int q = 0; q < 4; ++q) { p0[q] = __shfl_xor(v0[q], 32); p1[q] = __shfl_xor(v1[q], 32); }
                        if (fq < 2) { v0 = v0 * c0 - p0 * s0; v1 = v1 * c1 - p1 * s1; } else { v0 = v0 * c0 + p0 * s0; v1 = v1 * c1 + p1 * s1; }
                    }
                    v4u w; w.x = cvt_pk_bf16(v0[0], v0[1]); w.y = cvt_pk_bf16(v0[2], v0[3]); w.z = cvt_pk_bf16(v1[0], v1[1]); w.w = cvt_pk_bf16(v1[2], v1[3]);
                    *(v4u*)(rb + bj * 256 + lo) = w; } }
            asm volatile("" ::: "memory"); }
    }
};
struct EpiKV {
    PG8_USE_PERM(Perm8)
    bf16* KV; const float* SSKV;
    __device__ __forceinline__ void operator()(const f32x4 (&acc)[2][2][4][2], const pg8::Unit& u, int wr, int wc, int fr, int fq) const {
        const int rowU = u.pm * 256 + wr * 64;
        unsigned lo = (unsigned)(fr * 1024 + 8 * fq) * 2u; OPAQUE_V(lo);
        unsigned lr = (unsigned)fr * 32u; OPAQUE_V(lr);
        char* ub = (char*)KV + ((size_t)rowU * 1024 + u.pn * 256 + wc * 32) * 2;
        float rsh[2];
        { unsigned ll = (unsigned)(fq * 16 + fr) * 32u; OPAQUE_V(ll); f32x4 pa[2], pb[2];
#pragma unroll
          for (int ai = 0; ai < 2; ++ai) { const f32x4* sp = (const f32x4*)((const char*)(SSKV + (size_t)(rowU + ai * 128) * 8) + ll); pa[ai] = sp[0]; pb[ai] = sp[1]; }
#pragma unroll
          for (int ai = 0; ai < 2; ++ai) { const float ssum = ((pa[ai][0] + pa[ai][1]) + (pa[ai][2] + pa[ai][3])) + ((pb[ai][0] + pb[ai][1]) + (pb[ai][2] + pb[ai][3])); rsh[ai] = 1.0f / sqrtf(ssum * (1.0f / 256.0f) + EPSV); } }
#pragma unroll
        for (int ai = 0; ai < 2; ++ai)
#pragma unroll
            for (int m = 0; m < 4; ++m) { char* rb = ub + (size_t)(ai * 128 + m * 16) * 1024 * 2;
                const float rs = __shfl(rsh[ai], m * 16 + fr);
#pragma unroll
                for (int bj = 0; bj < 2; ++bj) { const f32x4 v0 = acc[ai][bj][m][0] * rs, v1 = acc[ai][bj][m][1] * rs;
                    v4u w; w.x = cvt_pk_bf16(v0[0], v0[1]); w.y = cvt_pk_bf16(v0[2], v0[3]); w.z = cvt_pk_bf16(v1[0], v1[1]); w.w = cvt_pk_bf16(v1[2], v1[3]);
                    *(v4u*)(rb + bj * 256 + lo) = w; }
                if (m & 1) asm volatile("" ::: "memory"); }
    }
};
template <int MODE> struct EpiGate {
    PG8_USE_PERM(Perm8)
    bf16* MIX; const bf16* GT;
    __device__ __forceinline__ void operator()(const f32x4 (&acc)[2][2][4][2], const pg8::Unit& u, int wr, int wc, int fr, int fq) const {
        const int rowU = u.pm * 256 + wr * 64, colU = u.pn * 256 + wc * 32;
        unsigned lg = (unsigned)(fr * 3072 + 8 * fq) * 2u; OPAQUE_V(lg);
        unsigned lm = (unsigned)(fr * 1024 + 8 * fq) * 2u; OPAQUE_V(lm);
        const char* ug = (const char*)GT + ((size_t)rowU * 3072 + colU) * 2; char* um = (char*)MIX + ((size_t)rowU * 1024 + colU) * 2;
#pragma unroll
        for (int ai = 0; ai < 2; ++ai)
#pragma unroll
            for (int m = 0; m < 4; ++m) { const char* rg = ug + (size_t)(ai * 128 + m * 16) * 3072 * 2; char* rm = um + (size_t)(ai * 128 + m * 16) * 1024 * 2;
#pragma unroll
                for (int bj = 0; bj < 2; ++bj) {
                    const v4u gw = *(const v4u*)(rg + bj * 256 + lg);
                    f32x4 v0 = acc[ai][bj][m][0], v1 = acc[ai][bj][m][1];
                    v0[0] *= bflo(gw.x); v0[1] *= bfhi(gw.x); v0[2] *= bflo(gw.y); v0[3] *= bfhi(gw.y); v1[0] *= bflo(gw.z); v1[1] *= bfhi(gw.z); v1[2] *= bflo(gw.w); v1[3] *= bfhi(gw.w);
                    char* mp = rm + bj * 256 + lm;
                    if (MODE == 1) { const v4u ow = *(const v4u*)mp;
                        v0[0] += bflo(ow.x); v0[1] += bfhi(ow.x); v0[2] += bflo(ow.y); v0[3] += bfhi(ow.y); v1[0] += bflo(ow.z); v1[1] += bfhi(ow.z); v1[2] += bflo(ow.w); v1[3] += bfhi(ow.w); }
                    v4u w; w.x = cvt_pk_bf16(v0[0], v0[1]); w.y = cvt_pk_bf16(v0[2], v0[3]); w.z = cvt_pk_bf16(v1[0], v1[1]); w.w = cvt_pk_bf16(v1[2], v1[3]);
                    *(v4u*)mp = w; }
                if (m & 1) asm volatile("" ::: "memory"); }
    }
};
struct EpiRes {
    PG8_USE_PERM(Perm8)
    const float* xsrc32; const bf16* xsrc16; bf16* xout; const float* GVt; const float* GS2t; float* XSS; float* XMX;
    __device__ __forceinline__ void operator()(f32x4 (&acc)[2][2][4][2], const pg8::Unit& u, int wr, int wc, int fr, int fq) const {
        const int rowU = u.pm * 256 + wr * 64, colU = u.pn * 256 + wc * 32; const int b = (u.pm * 256) >> 12;
        unsigned lo = (unsigned)(fr * DM + 8 * fq) * 2u; OPAQUE_V(lo);
        unsigned lc = (unsigned)(8 * fq) * 4u; OPAQUE_V(lc);
        const char* ga = (const char*)(GVt + (size_t)b * 1024 + colU);
        f32x4 gs2[2][2];
        { f32x4 gv[2][2];
#pragma unroll
          for (int bj = 0; bj < 2; ++bj)
#pragma unroll
              for (int n = 0; n < 2; ++n) { const int co = (bj * 128 + n * 4) * 4; gv[bj][n] = *(const f32x4*)(ga + co + lc); }
#pragma unroll
          for (int ai = 0; ai < 2; ++ai)
#pragma unroll
              for (int bj = 0; bj < 2; ++bj)
#pragma unroll
                  for (int m = 0; m < 4; ++m) { acc[ai][bj][m][0] = acc[ai][bj][m][0] * gv[bj][0]; acc[ai][bj][m][1] = acc[ai][bj][m][1] * gv[bj][1]; } }
#pragma unroll
        for (int bj = 0; bj < 2; ++bj)
#pragma unroll
            for (int n = 0; n < 2; ++n) { const int co = (bj * 128 + n * 4) * 4;
                gs2[bj][n] = *(const f32x4*)((const char*)(GS2t + (size_t)b * 1024 + colU) + co + lc); }
        const char* us32 = (const char*)xsrc32 + ((size_t)rowU * DM + colU) * 4; const char* us16 = (const char*)xsrc16 + ((size_t)rowU * DM + colU) * 2; char* uo = (char*)xout + ((size_t)rowU * DM + colU) * 2;
#pragma unroll
        for (int ai = 0; ai < 2; ++ai)
#pragma unroll
        for (int mh = 0; mh < 2; ++mh) {
            f32x4 X0[2][2], X1[2][2];
            if (xsrc32) {
#pragma unroll
                for (int mm = 0; mm < 2; ++mm)
#pragma unroll
                    for (int bj = 0; bj < 2; ++bj) { const char* p = us32 + ((size_t)(ai * 128 + (mh * 2 + mm) * 16) * DM + bj * 128) * 4 + 2u * lo; X0[mm][bj] = *(const f32x4*)p; X1[mm][bj] = *(const f32x4*)(p + 16); }
            } else { v4u xw[2][2];
#pragma unroll
                for (int mm = 0; mm < 2; ++mm)
#pragma unroll
                    for (int bj = 0; bj < 2; ++bj) xw[mm][bj] = *(const v4u*)(us16 + ((size_t)(ai * 128 + (mh * 2 + mm) * 16) * DM + bj * 128) * 2 + lo);
#pragma unroll
                for (int mm = 0; mm < 2; ++mm)
#pragma unroll
                    for (int bj = 0; bj < 2; ++bj) { const v4u w = xw[mm][bj]; X0[mm][bj] = (f32x4){bflo(w.x), bfhi(w.x), bflo(w.y), bfhi(w.y)}; X1[mm][bj] = (f32x4){bflo(w.z), bfhi(w.z), bflo(w.w), bfhi(w.w)}; }
            }
#pragma unroll
            for (int mm = 0; mm < 2; ++mm) { const int m = mh * 2 + mm; const size_t ro = (size_t)(ai * 128 + m * 16) * DM;
#pragma unroll
                for (int bj = 0; bj < 2; ++bj) { f32x4 x0 = X0[mm][bj], x1 = X1[mm][bj];
                    x0 = x0 + acc[ai][bj][m][0]; x1 = x1 + acc[ai][bj][m][1];
                    v4u o; o.x = cvt_pk_bf16(x0[0], x0[1]); o.y = cvt_pk_bf16(x0[2], x0[3]); o.z = cvt_pk_bf16(x1[0], x1[1]); o.w = cvt_pk_bf16(x1[2], x1[3]);
                    *(v4u*)(uo + (ro + bj * 128) * 2 + lo) = o;
                    float sq = ((x0[0] * x0[0] + x0[1] * x0[1]) + (x0[2] * x0[2] + x0[3] * x0[3])) + ((x1[0] * x1[0] + x1[1] * x1[1]) + (x1[2] * x1[2] + x1[3] * x1[3]));
                    const f32x4 t0 = x0 * gs2[bj][0], t1 = x1 * gs2[bj][1];
                    float mxv = fmaxf(fmaxf(fmaxf(fabsf(t0[0]), fabsf(t0[1])), fmaxf(fabsf(t0[2]), fabsf(t0[3]))), fmaxf(fmaxf(fabsf(t1[0]), fabsf(t1[1])), fmaxf(fabsf(t1[2]), fabsf(t1[3]))));
                    sq += __shfl_xor(sq, 16); sq += __shfl_xor(sq, 32); mxv = fmaxf(mxv, __shfl_xor(mxv, 16)); mxv = fmaxf(mxv, __shfl_xor(mxv, 32));
                    if (fq == 0) { XSS[(size_t)(rowU + ai * 128 + m * 16 + fr) * 32 + u.pn * 8 + bj * 4 + wc] = sq; XMX[(size_t)(rowU + ai * 128 + m * 16 + fr) * 32 + u.pn * 8 + bj * 4 + wc] = mxv; } } }
            asm volatile("" ::: "memory"); }
    }
};

struct T5Seg { unsigned a_off, b_off; int lda, ldb; };
__device__ __forceinline__ void gemm_t5_phase(LAS unsigned char* lds, const unsigned char* base, const T5Seg s0, const T5Seg s1, const T5Seg s2, const SchedDense& S, const unsigned char* GT, bf16* MIX) {
#define U8F(w, i) ((float)(((w) >> (8 * (i))) & 255u))
    using namespace pg8;
    const __amdgpu_buffer_rsrc_t rsrc = __builtin_amdgcn_make_buffer_rsrc((void*)base, 0, 0xffffffff, 0x00020000);
    int tid_ = threadIdx.x; asm volatile("" : "+v"(tid_));
    const int tid = tid_, wid = __builtin_amdgcn_readfirstlane(tid >> 6), lane = tid & 63, wr = wid >> 2, wc = wid & 3, fr = lane & 15, fq = lane >> 4;
    constexpr int NT = 20;
    int R0, C0; stage_rc(tid * 16, R0, C0); C0 *= 2;
    const int Rb0 = Perm8::bperm(R0);
    const unsigned vA256 = (unsigned)(R0 * 256 * 2 + C0), vA512 = (unsigned)(R0 * 512 * 2 + C0), vB256 = (unsigned)(Rb0 * 256 * 2 + C0), vB512 = (unsigned)(Rb0 * 512 * 2 + C0);
    const unsigned kstep = 128u;
    const unsigned ldsw = (unsigned)wid * 1024u;
    const int aoff = lds_byte(wr * 64 + fr, fq * 8), boff = lds_byte(wc * 32 + fr, fq * 8);
#define T5_SA(b, h) (((b) * 2 + (h)) * HTB)
#define T5_SB(b, h) ((4 + (b) * 2 + (h)) * HTB)
#define T5_SEG(T) ((T) < 4 ? 0 : (T) < 12 ? 1 : 2)
#define T5_AOFF(u, T) ((T) < 4 ? s0.a_off + (unsigned)(u).pm * 256u * 256u * 2u + (unsigned)(T) * kstep : (T) < 12 ? s1.a_off + (unsigned)(u).pm * 256u * 512u * 2u + (unsigned)((T) - 4) * kstep : s2.a_off + (unsigned)(u).pm * 256u * 512u * 2u + (unsigned)((T) - 12) * kstep)
#define T5_BOFF(u, T) ((T) < 4 ? s0.b_off + (unsigned)(u).pn * 256u * 256u * 2u + (unsigned)(T) * kstep : (T) < 12 ? s1.b_off + (unsigned)(u).pn * 256u * 512u * 2u + (unsigned)((T) - 4) * kstep : s2.b_off + (unsigned)(u).pn * 256u * 512u * 2u + (unsigned)((T) - 12) * kstep)
#define T5_LD(T) ((T) < 4 ? 256u : 512u)
#define T5_STAGEB(bufoff, u, T) do { const unsigned ld_ = T5_LD(T), go_ = T5_BOFF(u, T), vo_ = (T) < 4 ? vB256 : vB512; _Pragma("unroll") for (int _i = 0; _i < 2; ++_i) \
        __builtin_amdgcn_raw_ptr_buffer_load_lds(rsrc, (LAS void*)(lds + (bufoff) + ldsw + _i * 8192), 16, vo_, go_ + _i * 64u * ld_ * 2u, 0, 0); } while (0)
#define T5_STAGEB1(bufoff, u, T) do { const unsigned ld_ = T5_LD(T), go_ = T5_BOFF(u, T) + 128u * ld_ * 2u, vo_ = (T) < 4 ? vB256 : vB512; _Pragma("unroll") for (int _i = 0; _i < 2; ++_i) \
        __builtin_amdgcn_raw_ptr_buffer_load_lds(rsrc, (LAS void*)(lds + (bufoff) + ldsw + _i * 8192), 16, vo_, go_ + _i * 64u * ld_ * 2u, 0, 0); } while (0)
#define T5_STAGEA(bufoff, u, T, h) do { const unsigned ld_ = T5_LD(T), go_ = T5_AOFF(u, T) + (h) * 128u * ld_ * 2u, vo_ = (T) < 4 ? vA256 : vA512; _Pragma("unroll") for (int _i = 0; _i < 2; ++_i) \
        __builtin_amdgcn_raw_ptr_buffer_load_lds(rsrc, (LAS void*)(lds + (bufoff) + ldsw + _i * 8192), 16, vo_, go_ + _i * 64u * ld_ * 2u, 0, 0); } while (0)
#define T5_LDA(dst, b, h) do { _Pragma("unroll") for (int m = 0; m < 4; ++m) _Pragma("unroll") for (int k = 0; k < 2; ++k) dst[m][k] = *(const LAS bf16x8*)(lds + T5_SA(b, h) + aoff + m * 2048 + k * 1024); } while (0)
#define T5_LDB(dst, b, h) do { _Pragma("unroll") for (int n = 0; n < 2; ++n) _Pragma("unroll") for (int k = 0; k < 2; ++k) dst[n][k] = *(const LAS bf16x8*)(lds + T5_SB(b, h) + boff + n * 2048 + k * 1024); } while (0)
#define T5_MMA(ai, bj, At, Bt) do { __builtin_amdgcn_s_setprio(1); _Pragma("unroll") for (int m = 0; m < 4; ++m) _Pragma("unroll") for (int n = 0; n < 2; ++n) _Pragma("unroll") for (int k = 0; k < 2; ++k) \
        acc[ai][bj][m][n] = __builtin_amdgcn_mfma_f32_16x16x32_bf16(Bt[n][k], At[m][k], acc[ai][bj][m][n], 0, 0, 0); __builtin_amdgcn_s_setprio(0); } while (0)
#define T5_WAIT_V(n) asm volatile("s_waitcnt vmcnt(" #n ")" ::: "memory")
#define T5_WAIT_L(n) asm volatile("s_waitcnt lgkmcnt(" #n ")" ::: "memory")
#define T5_BAR __builtin_amdgcn_s_barrier()
#define T5_SCHED __builtin_amdgcn_sched_barrier(0)
    Unit cur, nxt; int ui = 0;
    if (!S.next(0, cur)) return;
    f32x4 acc[2][2][4][2];
#pragma unroll
    for (int a = 0; a < 2; ++a)
#pragma unroll
        for (int b = 0; b < 2; ++b)
#pragma unroll
            for (int m = 0; m < 4; ++m)
#pragma unroll
                for (int n = 0; n < 2; ++n) acc[a][b][m][n] = (f32x4){0.f, 0.f, 0.f, 0.f};
    bf16x8 At[4][2], B0[2][2], B1[2][2];
    T5_STAGEB(T5_SB(0, 0), cur, 0); T5_STAGEB1(T5_SB(0, 1), cur, 0); T5_STAGEA(T5_SA(0, 0), cur, 0, 0); T5_STAGEA(T5_SA(0, 1), cur, 0, 1);
    if (wr == 1) T5_BAR;
    T5_WAIT_V(2); T5_BAR;
    T5_STAGEB(T5_SB(1, 0), cur, 1); T5_STAGEA(T5_SA(1, 0), cur, 1, 0); T5_STAGEB1(T5_SB(1, 1), cur, 1);
    T5_WAIT_V(6); T5_BAR;
    for (;;) {
        const bool has_next = S.next(ui + 1, nxt);
        const Unit nu = has_next ? nxt : cur;
#pragma unroll 1
        for (int t = 0; t < NT; t += 2) {
            const bool last = (t == NT - 2);
            if (t == 4 || t == 12) {
                const int gp = (t == 4) ? 0 : 1;
                unsigned lg = (unsigned)(fr * 3072 + 8 * fq); asm volatile("" : "+v"(lg));
                const char* ug = (const char*)GT + ((size_t)(cur.pm * 256 + wr * 64) * 3072 + gp * 1024 + cur.pn * 256 + wc * 32);
#pragma unroll
                for (int ai = 0; ai < 2; ++ai) { v2u ga[4][2], gb[4][2];
#pragma unroll
                    for (int m = 0; m < 4; ++m)
#pragma unroll
                        for (int bj = 0; bj < 2; ++bj) { const char* p = ug + (size_t)(ai * 128 + m * 16) * 3072 + bj * 128 + lg; ga[m][bj] = *(const v2u*)p; gb[m][bj] = *(const v2u*)(p + 1024); }
#pragma unroll
                    for (int m = 0; m < 4; ++m)
#pragma unroll
                        for (int bj = 0; bj < 2; ++bj) { const v2u a = ga[m][bj], b = gb[m][bj];
                            f32x4& v0 = acc[ai][bj][m][0]; f32x4& v1 = acc[ai][bj][m][1];
                            v0[0] *= U8F(a.x, 0) * __builtin_amdgcn_rcpf(U8F(b.x, 0)); v0[1] *= U8F(a.x, 1) * __builtin_amdgcn_rcpf(U8F(b.x, 1)); v0[2] *= U8F(a.x, 2) * __builtin_amdgcn_rcpf(U8F(b.x, 2)); v0[3] *= U8F(a.x, 3) * __builtin_amdgcn_rcpf(U8F(b.x, 3));
                            v1[0] *= U8F(a.y, 0) * __builtin_amdgcn_rcpf(U8F(b.y, 0)); v1[1] *= U8F(a.y, 1) * __builtin_amdgcn_rcpf(U8F(b.y, 1)); v1[2] *= U8F(a.y, 2) * __builtin_amdgcn_rcpf(U8F(b.y, 2)); v1[3] *= U8F(a.y, 3) * __builtin_amdgcn_rcpf(U8F(b.y, 3)); }
                    asm volatile("" ::: "memory"); }
            }
            T5_LDB(B0, 0, 0); T5_LDB(B1, 0, 1); T5_SCHED; T5_LDA(At, 0, 0); T5_STAGEA(T5_SA(1, 1), cur, t + 1, 1);
            T5_WAIT_V(8); T5_WAIT_L(0); T5_BAR; T5_MMA(0, 0, At, B0); T5_MMA(0, 1, At, B1); T5_BAR; T5_SCHED;
            T5_LDA(At, 0, 1);
            if (last) { T5_STAGEB(T5_SB(0, 0), nu, 0); T5_STAGEB1(T5_SB(0, 1), nu, 0); T5_STAGEA(T5_SA(0, 0), nu, 0, 0); }
            else { T5_STAGEB(T5_SB(0, 0), cur, t + 2); T5_STAGEB1(T5_SB(0, 1), cur, t + 2); T5_STAGEA(T5_SA(0, 0), cur, t + 2, 0); }
            T5_WAIT_V(8); T5_WAIT_L(0); T5_BAR; T5_MMA(1, 0, At, B0); T5_MMA(1, 1, At, B1); T5_BAR; T5_SCHED;
            T5_LDB(B0, 1, 0); T5_LDB(B1, 1, 1); T5_SCHED; T5_LDA(At, 1, 0);
            if (last) T5_STAGEA(T5_SA(0, 1), nu, 0, 1); else T5_STAGEA(T5_SA(0, 1), cur, t + 2, 1);
            T5_WAIT_V(8); T5_WAIT_L(0); T5_BAR; T5_MMA(0, 0, At, B0); T5_MMA(0, 1, At, B1); T5_BAR; T5_SCHED;
            T5_LDA(At, 1, 1);
            if (last) { T5_STAGEB(T5_SB(1, 0), nu, 1); T5_STAGEB1(T5_SB(1, 1), nu, 1); T5_STAGEA(T5_SA(1, 0), nu, 1, 0); }
            else { T5_STAGEB(T5_SB(1, 0), cur, t + 3); T5_STAGEB1(T5_SB(1, 1), cur, t + 3); T5_STAGEA(T5_SA(1, 0), cur, t + 3, 0); }
            T5_WAIT_V(8); T5_WAIT_L(0); T5_BAR; T5_MMA(1, 0, At, B0); T5_MMA(1, 1, At, B1); T5_BAR; T5_SCHED;
        }
        if (wr == 0) T5_BAR;
        {
            int t2 = threadIdx.x; asm volatile("" : "+v"(t2)); const int fr2 = t2 & 15, fq2 = (t2 & 63) >> 4;
            unsigned lg = (unsigned)(fr2 * 3072 + 8 * fq2); asm volatile("" : "+v"(lg));
            unsigned lm = (unsigned)(fr2 * 1024 + 8 * fq2) * 2u; asm volatile("" : "+v"(lm));
            const char* ug = (const char*)GT + ((size_t)(cur.pm * 256 + wr * 64) * 3072 + 2048 + cur.pn * 256 + wc * 32);
            char* um = (char*)MIX + ((size_t)(cur.pm * 256 + wr * 64) * 1024 + cur.pn * 256 + wc * 32) * 2;
#pragma unroll
            for (int ai = 0; ai < 2; ++ai) { v2u gc[4][2];
#pragma unroll
                for (int m = 0; m < 4; ++m)
#pragma unroll
                    for (int bj = 0; bj < 2; ++bj) gc[m][bj] = *(const v2u*)(ug + (size_t)(ai * 128 + m * 16) * 3072 + bj * 128 + lg);
#pragma unroll
                for (int m = 0; m < 4; ++m)
#pragma unroll
                    for (int bj = 0; bj < 2; ++bj) { const v2u gw = gc[m][bj]; f32x4 v0 = acc[ai][bj][m][0] * (1.0f / 255.0f), v1 = acc[ai][bj][m][1] * (1.0f / 255.0f);
                        v0[0] *= U8F(gw.x, 0); v0[1] *= U8F(gw.x, 1); v0[2] *= U8F(gw.x, 2); v0[3] *= U8F(gw.x, 3); v1[0] *= U8F(gw.y, 0); v1[1] *= U8F(gw.y, 1); v1[2] *= U8F(gw.y, 2); v1[3] *= U8F(gw.y, 3);
                        v4u w; w.x = cvt_pk_bf16(v0[0], v0[1]); w.y = cvt_pk_bf16(v0[2], v0[3]); w.z = cvt_pk_bf16(v1[0], v1[1]); w.w = cvt_pk_bf16(v1[2], v1[3]);
                        *(v4u*)(um + (size_t)(ai * 128 + m * 16) * 1024 * 2 + bj * 256 + lm) = w; }
                asm volatile("" ::: "memory"); }
        }
        if (!has_next) break;
#pragma unroll
        for (int a = 0; a < 2; ++a)
#pragma unroll
            for (int b = 0; b < 2; ++b)
#pragma unroll
                for (int m = 0; m < 4; ++m)
#pragma unroll
                    for (int n = 0; n < 2; ++n) acc[a][b][m][n] = (f32x4){0.f, 0.f, 0.f, 0.f};
        cur = nxt; ++ui;
        if (wr == 1) T5_BAR;
    }
    T5_WAIT_V(0);
    T5_BAR;
#undef U8F
#undef T5_SA
#undef T5_SB
#undef T5_SEG
#undef T5_AOFF
#undef T5_BOFF
#undef T5_LD
#undef T5_STAGEB
#undef T5_STAGEB1
#undef T5_STAGEA
#undef T5_LDA
#undef T5_LDB
#undef T5_MMA
#undef T5_WAIT_V
#undef T5_WAIT_L
#undef T5_BAR
#undef T5_SCHED
}

struct AttnCfg {
    const bf16* Qp; long qpitch;
    const bf16* Kp; long kpitch;
    const bf16* K2p; long k2pitch;
    const bf16* Vp; long vpitch;
    bf16* Op; long opitch;
    float* lsep; long lsepitch;
    int q0, kt_lo, kt_hi, band;
};
__device__ __forceinline__ int crow(int r, int hi) { return (r & 3) + 8 * (r >> 2) + 4 * hi; }
typedef short v4i16_t __attribute__((ext_vector_type(4)));
__device__ __forceinline__ s16x4 vtr(LAS const unsigned char* p) { return __builtin_bit_cast(s16x4, __builtin_amdgcn_ds_read_tr16_b64_v4i16((LAS v4i16_t*)p)); }

template <int DQK>
__device__ __forceinline__ void attn_tile(const AttnCfg& cf, LAS unsigned char* lds, int buf, int kt, int qw_lo, int r32, int hi, int lane, unsigned klane, unsigned vlane,
                                          const bf16x8 (&qf)[DQK / 16], f32x16& o0, f32x16& o1, f32x16& negm, float& mref, float& lrun) {
    constexpr int KST = (DQK == 96) ? 208 : 144, KBUF = 64 * 208, VBUF = 8192, VOFF = 2 * KBUF, ND = DQK / 16; constexpr float THR = 8.0f;
    const int kbase = 64 * kt;
        const bool active = (kbase <= qw_lo + 31) && (cf.band == 0 || kbase + 63 >= qw_lo - cf.band);
        if (active) {
            LAS const unsigned char* Kb = lds + buf * KBUF + klane;
            f32x16 p0, p1;
#pragma unroll
            for (int d0 = 0; d0 < ND; ++d0) {
                const bf16x8 ka0 = *(LAS const bf16x8*)(Kb + d0 * 32), ka1 = *(LAS const bf16x8*)(Kb + 32 * KST + d0 * 32);
                p0 = __builtin_amdgcn_mfma_f32_32x32x16_bf16(ka0, qf[d0], d0 == 0 ? negm : p0, 0, 0, 0);
                p1 = __builtin_amdgcn_mfma_f32_32x32x16_bf16(ka1, qf[d0], d0 == 0 ? negm : p1, 0, 0, 0);
            }
            const bool need_mask = (kbase + 63 > qw_lo) || (cf.band != 0 && kbase < qw_lo + 31 - cf.band);
            if (need_mask) {
                const int q = qw_lo + r32; const int lo = (cf.band != 0) ? q - cf.band : -0x40000000;
#pragma unroll
                for (int r = 0; r < 16; ++r) { const int k0 = kbase + crow(r, hi), k1 = k0 + 32;
                    if (k0 > q || k0 < lo) p0[r] = -1e30f;
                    if (k1 > q || k1 < lo) p1[r] = -1e30f; }
            }
            float mx = fmaxf(fmaxf(p0[0], p0[1]), p1[0]);
#pragma unroll
            for (int r = 2; r < 16; r += 2) mx = fmaxf(fmaxf(mx, p0[r]), p0[r + 1]);
#pragma unroll
            for (int r = 1; r < 15; r += 2) mx = fmaxf(fmaxf(mx, p1[r]), p1[r + 1]);
            mx = fmaxf(mx, p1[15]);
            { auto rr = __builtin_amdgcn_permlane32_swap(__float_as_uint(mx), __float_as_uint(mx), false, false); mx = fmaxf(__uint_as_float(rr[0]), __uint_as_float(rr[1])); }
            if (__builtin_expect(__any(mx > THR), 0)) {
                const float dl = fmaxf(mx, 0.f), alpha = __builtin_amdgcn_exp2f(-dl);
                mref += dl; lrun *= alpha;
#pragma unroll
                for (int r = 0; r < 16; ++r) { p0[r] -= dl; p1[r] -= dl; o0[r] *= alpha; o1[r] *= alpha; negm[r] = -mref; }
            }
            float rs0 = 0.f, rs1 = 0.f;
#pragma unroll
            for (int r = 0; r < 16; ++r) { p0[r] = __builtin_amdgcn_exp2f(p0[r]); p1[r] = __builtin_amdgcn_exp2f(p1[r]); rs0 += p0[r]; rs1 += p1[r]; }
            lrun += rs0 + rs1;
            v4u pw[4];
#pragma unroll
            for (int s = 0; s < 2; ++s) {
                pw[s] = (v4u){cvt_pk_bf16(p0[8 * s + 0], p0[8 * s + 1]), cvt_pk_bf16(p0[8 * s + 2], p0[8 * s + 3]), cvt_pk_bf16(p0[8 * s + 4], p0[8 * s + 5]), cvt_pk_bf16(p0[8 * s + 6], p0[8 * s + 7])};
                pw[2 + s] = (v4u){cvt_pk_bf16(p1[8 * s + 0], p1[8 * s + 1]), cvt_pk_bf16(p1[8 * s + 2], p1[8 * s + 3]), cvt_pk_bf16(p1[8 * s + 4], p1[8 * s + 5]), cvt_pk_bf16(p1[8 * s + 6], p1[8 * s + 7])};
            }
            LAS const unsigned char* Vb = lds + VOFF + buf * VBUF + vlane;
#pragma unroll
            for (int ks = 0; ks < 4; ++ks) {
                const bf16x8 pb = __builtin_bit_cast(bf16x8, pw[ks]);
#pragma unroll
                for (int d = 0; d < 2; ++d) {
                    const s16x4 lo4 = vtr(Vb + d * 4096 + ks * 1024), hi4 = vtr(Vb + d * 4096 + ks * 1024 + 512);
                    const bf16x8 vf = (bf16x8){lo4[0], lo4[1], lo4[2], lo4[3], hi4[0], hi4[1], hi4[2], hi4[3]};
                    if (d == 0) o0 = __builtin_amdgcn_mfma_f32_32x32x16_bf16(vf, pb, o0, 0, 0, 0); else o1 = __builtin_amdgcn_mfma_f32_32x32x16_bf16(vf, pb, o1, 0, 0, 0);
                }
            }
        }
}

template <int DQK>
__device__ __forceinline__ void attn_unit(const AttnCfg& cf, LAS unsigned char* lds) {
    constexpr int KST = (DQK == 96) ? 208 : 144;
    constexpr int KBUF = 64 * 208, VBUF = 8192, VOFF = 2 * KBUF;
    constexpr int ND = DQK / 16;
    int tid_ = threadIdx.x; asm volatile("" : "+v"(tid_));
    const int tid = tid_, lane = tid & 63, r32 = lane & 31, hi = lane >> 5; const int wid = __builtin_amdgcn_readfirstlane(tid >> 6);
    const int qw_lo = cf.q0 + 32 * wid;
    bf16x8 qf[ND];
    { const bf16* qrow = cf.Qp + (long)(qw_lo + r32) * cf.qpitch;
#pragma unroll
      for (int d0 = 0; d0 < ND; ++d0) qf[d0] = *(const bf16x8*)(qrow + 16 * d0 + 8 * hi); }
    const int skey = tid >> 3, sch = tid & 7;
    const int s2key = tid >> 2, s2ch = tid & 3;
    const unsigned kdst = skey * KST + sch * 16, k2dst = s2key * KST + 128 + s2ch * 16, vdst = (sch >> 2) * 4096 + skey * 64 + (sch & 3) * 16;
    v4u kregA, k2regA, vregA, kregB, k2regB, vregB;
#define ATT_LOAD(S, kt) do { const long kr_ = (long)(64 * (kt) + skey); kreg##S = *(const v4u*)(cf.Kp + kr_ * cf.kpitch + sch * 8); vreg##S = *(const v4u*)(cf.Vp + kr_ * cf.vpitch + sch * 8); \
        if (DQK == 96 && tid < 256) k2reg##S = *(const v4u*)(cf.K2p + (long)(64 * (kt) + s2key) * cf.k2pitch + s2ch * 8); } while (0)
#define ATT_STORE(S, buf) do { *(LAS v4u*)(lds + (buf) * KBUF + kdst) = kreg##S; *(LAS v4u*)(lds + VOFF + (buf) * VBUF + vdst) = vreg##S; \
        if (DQK == 96 && tid < 256) *(LAS v4u*)(lds + (buf) * KBUF + k2dst) = k2reg##S; } while (0)
    f32x16 o0, o1, negm;
#pragma unroll
    for (int r = 0; r < 16; ++r) { o0[r] = 0.f; o1[r] = 0.f; negm[r] = 0.f; }
    float mref = 0.f, lrun = 0.f;
    constexpr float THR = 8.0f;
    const unsigned klane = r32 * KST + hi * 16;
    const unsigned vlane = (4 * hi + ((lane & 15) >> 2)) * 64 + ((lane >> 4) & 1) * 32 + (lane & 3) * 8;
    ATT_LOAD(A, cf.kt_lo); ATT_STORE(A, 0);
    if (cf.kt_lo + 1 < cf.kt_hi) ATT_LOAD(A, cf.kt_lo + 1);
    __syncthreads();
#define ATT_STEP(SN, SS) do { const int buf = (kt - cf.kt_lo) & 1; \
        if (kt + 2 < cf.kt_hi) ATT_LOAD(SN, kt + 2); \
        attn_tile<DQK>(cf, lds, buf, kt, qw_lo, r32, hi, lane, klane, vlane, qf, o0, o1, negm, mref, lrun); \
        if (kt + 1 < cf.kt_hi) ATT_STORE(SS, buf ^ 1); \
        __syncthreads(); } while (0)
    for (int kt = cf.kt_lo; kt < cf.kt_hi; kt += 2) {
        ATT_STEP(B, A);
        if (kt + 1 < cf.kt_hi) { ++kt; ATT_STEP(A, B); --kt; }
    }
#undef ATT_STEP
#undef ATT_LOAD
#undef ATT_STORE
    float ltot; { auto rr = __builtin_amdgcn_permlane32_swap(__float_as_uint(lrun), __float_as_uint(lrun), false, false); ltot = __uint_as_float(rr[0]) + __uint_as_float(rr[1]); }
    const float inv = 1.0f / ltot;
    bf16* orow = cf.Op + (long)(qw_lo + r32) * cf.opitch;
#pragma unroll
    for (int g = 0; g < 4; ++g) {
        v2u w0, w1;
        w0.x = cvt_pk_bf16(o0[4 * g] * inv, o0[4 * g + 1] * inv); w0.y = cvt_pk_bf16(o0[4 * g + 2] * inv, o0[4 * g + 3] * inv);
        w1.x = cvt_pk_bf16(o1[4 * g] * inv, o1[4 * g + 1] * inv); w1.y = cvt_pk_bf16(o1[4 * g + 2] * inv, o1[4 * g + 3] * inv);
        *(v2u*)(orow + 8 * g + 4 * hi) = w0; *(v2u*)(orow + 32 + 8 * g + 4 * hi) = w1;
    }
    if (cf.lsep != nullptr && hi == 0) cf.lsep[(long)(qw_lo + r32) * cf.lsepitch] = mref + __builtin_amdgcn_logf(ltot);
}

__device__ __forceinline__ void n2_route_phase(const Frame& F, const Args& A, int layer, const bf16* x) {
    LAS float* GS = (LAS float*)F.lds; LAS float* SH = GS + 1024;
    LAS float* LG = SH + 1024 + F.wave * 1024;
    LAS unsigned* CNT = (LAS unsigned*)(F.lds + 8192 + 8 * 4096); LAS unsigned* BASE = CNT + 64;
    LAS unsigned* ENT = BASE + 64; LAS float* ENTW = (LAS float*)(ENT + 1024);
    const int j = layer * 2 + 1; const float* g = A.in[19] + layer * DM;
    const bf16* RTH = (const bf16*)(F.ws + WS_W + WO_RTH); const bf16* RTL = (const bf16*)(F.ws + WS_W + WO_RTL);
    const float* rbias = A.in[21] + layer * 64; const float* XSS = (const float*)(F.ws + WS_XSS); const float* XMX = (const float*)(F.ws + WS_XMX); float* SA2 = (float*)(F.ws + WS_SA2);
    LAS float* SHM = (LAS float*)(F.lds + 8192 + 8 * 4096 + 16384);
    unsigned char* H2 = F.ws + WS_H2; v2u* LISTS = (v2u*)(F.ws + WS_LISTS);
    unsigned* gcnt = F.ctl + CW_GCNT + layer * NLIST;
    const int tk = F.lane & 15, kq = F.lane >> 4;
    for (int tile = F.bid; tile < NTOK / 128; tile += F.G) {
        const int tok0 = tile * 128, b = tok0 >> 12, half = tok0 >> 14;
        __syncthreads();
        norm_tables(F, A, j, g, b, 1, GS, SH);
        if (F.tid < 64) CNT[F.tid] = 0u;
        __syncthreads();
        { float sm = fmaxf(fabsf(SH[F.tid]), fabsf(SH[F.tid + 512])); sm = wave_max(sm); if (F.lane == 0) SHM[F.wave] = sm; }
        __syncthreads();
        float shmax = SHM[0];
#pragma unroll
        for (int w = 1; w < 8; ++w) shmax = fmaxf(shmax, SHM[w]);
        const int tok = tok0 + F.wave * 16 + tk; const bf16* xr = x + (size_t)tok * DM + 8 * kq;
        float ss; { const f32x4* sp = (const f32x4*)(XSS + (size_t)tok * 32 + 8 * kq); const f32x4 s0 = sp[0], s1 = sp[1]; ss = ((s0[0] + s0[1]) + (s0[2] + s0[3])) + ((s1[0] + s1[1]) + (s1[2] + s1[3])); }
        ss += __shfl_xor(ss, 16); ss += __shfl_xor(ss, 32);
        const float rstd = 1.0f / sqrtf(ss * (1.0f / DM) + EPSV);
        float xm; { const f32x4* mp = (const f32x4*)(XMX + (size_t)tok * 32 + 8 * kq); const f32x4 m0 = mp[0], m1 = mp[1]; xm = fmaxf(fmaxf(fmaxf(m0[0], m0[1]), fmaxf(m0[2], m0[3])), fmaxf(fmaxf(m1[0], m1[1]), fmaxf(m1[2], m1[3]))); }
        xm = fmaxf(xm, __shfl_xor(xm, 16)); xm = fmaxf(xm, __shfl_xor(xm, 32));
        const float hmax = fmaxf(rstd * xm + shmax, 1e-20f), hinv = 127.0f / hmax;
        if (kq == 0) SA2[tok] = hmax * (1.0f / 127.0f);
        f32x4 lg[4];
#pragma unroll
        for (int ge = 0; ge < 4; ++ge) lg[ge] = (f32x4){0.f, 0.f, 0.f, 0.f};
        for (int kk0 = 0; kk0 < 32; kk0 += 4) {
            f32x4 xa[4], xc[4]; v4u xw[4];
#pragma unroll
            for (int u = 0; u < 4; ++u) xw[u] = *(const v4u*)(xr + 32 * (kk0 + u));
#pragma unroll
            for (int u = 0; u < 4; ++u) { xa[u] = (f32x4){bflo(xw[u].x), bfhi(xw[u].x), bflo(xw[u].y), bfhi(xw[u].y)}; xc[u] = (f32x4){bflo(xw[u].z), bfhi(xw[u].z), bflo(xw[u].w), bfhi(xw[u].w)}; }
#pragma unroll
            for (int u = 0; u < 4; ++u) {
                const int k0 = 32 * (kk0 + u) + 8 * kq;
                const f32x4 g0 = *(LAS const f32x4*)(GS + k0), g1 = *(LAS const f32x4*)(GS + k0 + 4), s0 = *(LAS const f32x4*)(SH + k0), s1 = *(LAS const f32x4*)(SH + k0 + 4);
                const f32x4 h0 = (xa[u] * rstd) * g0 + s0, h1 = (xc[u] * rstd) * g1 + s1;
                unsigned hb[8]; float lo[8];
#pragma unroll
                for (int q = 0; q < 4; ++q) { hb[q] = f2bf(h0[q]); lo[q] = h0[q] - bf2f(hb[q]); hb[4 + q] = f2bf(h1[q]); lo[4 + q] = h1[q] - bf2f(hb[4 + q]); }
                v4u hw; hw.x = hb[0] | (hb[1] << 16); hw.y = hb[2] | (hb[3] << 16); hw.z = hb[4] | (hb[5] << 16); hw.w = hb[6] | (hb[7] << 16);
                if (FP8_F2) { v2u h8; h8.x = pk4_i8(h0[0], h0[1], h0[2], h0[3], hinv); h8.y = pk4_i8(h1[0], h1[1], h1[2], h1[3], hinv); *(v2u*)(H2 + (size_t)tok * DM + k0) = h8; }
                else *(v4u*)(H2 + ((size_t)tok * DM + k0) * 2) = hw;
                v4u lw; lw.x = pk2(lo[0], lo[1]); lw.y = pk2(lo[2], lo[3]); lw.z = pk2(lo[4], lo[5]); lw.w = pk2(lo[6], lo[7]);
                const bf16x8 ahi = __builtin_bit_cast(bf16x8, hw), alo = __builtin_bit_cast(bf16x8, lw);
#pragma unroll
                for (int ge = 0; ge < 4; ++ge) {
                    const bf16x8 bh = *(const bf16x8*)(RTH + (size_t)(16 * ge + tk) * DM + k0), bl = *(const bf16x8*)(RTL + (size_t)(16 * ge + tk) * DM + k0);
                    lg[ge] = __builtin_amdgcn_mfma_f32_16x16x32_bf16(ahi, bh, lg[ge], 0, 0, 0);
                    lg[ge] = __builtin_amdgcn_mfma_f32_16x16x32_bf16(alo, bh, lg[ge], 0, 0, 0);
                    lg[ge] = __builtin_amdgcn_mfma_f32_16x16x32_bf16(ahi, bl, lg[ge], 0, 0, 0);
                }
            }
        }
#pragma unroll
        for (int ge = 0; ge < 4; ++ge)
#pragma unroll
            for (int r = 0; r < 4; ++r) { const int e = 16 * ge + tk; LG[(4 * kq + r) * 64 + e] = fsigmoid(lg[ge][r]) + rbias[e]; }
        LDS_WAIT(); asm volatile("" ::: "memory");
        {
            const int tq = F.lane >> 2, part = F.lane & 3, qb = F.lane & ~3;
            const LAS float* sel = LG + tq * 64 + part * 16;
            float v[16];
#pragma unroll
            for (int i = 0; i < 16; ++i) v[i] = sel[i];
            float gl[2];
#pragma unroll
            for (int gI = 0; gI < 2; ++gI) { float m1 = -3e38f, m2 = -3e38f;
#pragma unroll
                for (int q = 0; q < 8; ++q) { const float x = v[gI * 8 + q]; if (x > m1) { m2 = m1; m1 = x; } else if (x > m2) m2 = x; }
                gl[gI] = m1 + m2; }
            float gsc[8];
#pragma unroll
            for (int p = 0; p < 4; ++p) { gsc[2 * p] = __shfl(gl[0], qb + p); gsc[2 * p + 1] = __shfl(gl[1], qb + p); }
            unsigned gmask = 0u;
#pragma unroll
            for (int gI = 0; gI < 8; ++gI) { int rank = 0;
#pragma unroll
                for (int q = 0; q < 8; ++q) rank += (gsc[q] > gsc[gI] || (gsc[q] == gsc[gI] && q < gI)) ? 1 : 0;
                if (rank < 4) gmask |= 1u << gI; }
#pragma unroll
            for (int i = 0; i < 16; ++i) if (!((gmask >> (2 * part + (i >> 3))) & 1u)) v[i] = -3e38f;
            unsigned taken = 0u; float wsum = 0.f; int es[8]; float sc[8];
#pragma unroll
            for (int k = 0; k < 8; ++k) { float best = -3.2e38f; int bi = 0;
#pragma unroll
                for (int i = 0; i < 16; ++i) { const bool free_ = !((taken >> i) & 1u); if (free_ && v[i] > best) { best = v[i]; bi = i; } }
                int be = part * 16 + bi;
#pragma unroll
                for (int off = 1; off <= 2; off <<= 1) { const float ob = __shfl_xor(best, off); const int oe = __shfl_xor(be, off); if (ob > best || (ob == best && oe < be)) { best = ob; be = oe; } }
                if ((be >> 4) == part) taken |= 1u << (be & 15);
                es[k] = be; sc[k] = best - rbias[be]; wsum += sc[k]; }
            const float wn = 2.5f / wsum;
#pragma unroll
            for (int k = 0; k < 8; ++k) if ((k & 3) == part) { const unsigned pos = atomicAdd((unsigned*)(CNT + es[k]), 1u); const int ei = (F.wave * 16 + tq) * 8 + k; ENT[ei] = (unsigned)es[k] | (pos << 8); ENTW[ei] = sc[k] * wn; }
        }
        __syncthreads();
        if (F.tid < 64) BASE[F.tid] = CNT[F.tid] ? atomicAdd(gcnt + half * 64 + F.tid, CNT[F.tid]) : 0u;
        __syncthreads();
        for (int ei = F.tid; ei < 1024; ei += NTHR) { const unsigned en = ENT[ei]; const unsigned e = en & 255u, pos = en >> 8; const unsigned slot = (unsigned)(tok0 + (ei >> 3)) * 8u + (unsigned)(ei & 7);
            LISTS[(size_t)(half * 64 + e) * LISTCAP + BASE[e] + pos] = (v2u){slot, __float_as_uint(ENTW[ei])}; }
    }
}
__device__ __forceinline__ void n2_convert_experts(const Frame& F, const Args& A, int layer) {
    LAS float* scr = (LAS float*)(F.lds + F.wave * 16384);
    const int gw = F.bid * NWAVES + F.wave, NGW = F.G * NWAVES;
    const float* w1 = A.in[22] + (size_t)layer * 64 * 1024 * 256; const float* w3 = A.in[23] + (size_t)layer * 64 * 1024 * 256; const float* w2 = A.in[24] + (size_t)layer * 64 * 256 * 1024;
    unsigned char* W13 = F.ws + WS_WEXP13; bf16* W2 = (bf16*)(F.ws + WS_WEXP2);
    if (FP8_F2) { LAS float* CM = (LAS float*)(F.lds + 12288);
        for (int it = F.bid; it < 64 * 16; it += F.G) { const int e = it >> 4, n0 = (it & 15) * 32, hh = n0 >> 8, rr = n0 & 255;
            tr_cols_i8_wg((rr < 128 ? w1 : w3) + (size_t)e * 1024 * 256, 256, hh * 128 + (rr & 127), W13 + (size_t)e * 512 * 1024, 1024, n0, (float*)(F.ws + WS_SW13) + e * 512, scr, CM, F.wave, F.lane); }
        __syncthreads(); }
    for (int it = gw; it < 64 * 32; it += NGW) { const int e = it >> 5, nb = it & 31;
        tr_cols_i8_k256(w2 + (size_t)e * 256 * 1024, 1024, nb * 32, (unsigned char*)W2 + (size_t)e * 1024 * 256, nb * 32, (float*)(F.ws + WS_SW2) + e * 1024, scr, F.lane); }
}

__device__ __forceinline__ void moe_tables(const Frame& F, int layer) {
    LAS int* PRE = (LAS int*)(F.lds + MOE_OFF); LAS int* CNT = PRE + 132;
    __syncthreads();
    if (F.tid < NLIST) CNT[F.tid] = (int)__hip_atomic_load(F.ctl + CW_GCNT + layer * NLIST + F.tid, RLX_AGENT);
    __syncthreads();
    if (F.tid == 0) { int s = 0; for (int l = 0; l < NLIST; ++l) { PRE[l] = s; s += (CNT[l] + 255) >> 8; } PRE[NLIST] = s; }
    __syncthreads();
}
__device__ __forceinline__ int moe_find_list(LAS const int* PRE, int pair, int lane) {
    int t_ = threadIdx.x; asm volatile("" : "+v"(t_)); lane = t_ & 63;
    const unsigned long long b0 = __ballot(PRE[1 + lane] <= pair), b1 = __ballot(PRE[65 + lane] <= pair);
    return __popcll(b0) + __popcll(b1);
}
struct SchedMoe1 {
    static constexpr unsigned ESZ = FP8_F2 ? 1u : 2u;
    unsigned H2, W13, SH13; const v2u* LISTS; LAS const int* PRE; LAS const int* CNT; int G, c, T2, lane;
    __device__ __forceinline__ bool next(int i, pg8::Unit& u) const {
        const int idx = i * G + c; if (idx >= T2 + 256) return false;
        if (idx < T2) { const int pair = idx >> 1; const int l = moe_find_list(PRE, pair, lane); u.e = l; u.pm = __builtin_amdgcn_readfirstlane(pair - PRE[l]); u.pn = idx & 1; u.aux = pair * 256; }
        else { const int s = idx - T2; u.e = -1; u.pm = s >> 1; u.pn = s & 1; u.aux = ACT_SH_ROW + (s >> 1) * 256; }
        return true;
    }
    __device__ __forceinline__ unsigned a_off(const pg8::Unit&) const { return H2; }
    __device__ __forceinline__ unsigned b_off(const pg8::Unit& u) const { return u.e < 0 ? SH13 + (unsigned)u.pn * 256u * 1024u * ESZ : W13 + ((unsigned)(u.e & 63) * 512u + (unsigned)u.pn * 256u) * 1024u * ESZ; }
    __device__ __forceinline__ unsigned a_rowoff(const pg8::Unit& u, int r) const {
        if (u.e < 0) return (unsigned)(u.pm * 256 + r) * 1024u * ESZ;
        int pos = u.pm * 256 + r; const int cn = __builtin_amdgcn_readfirstlane(CNT[u.e]); pos = pos < cn ? pos : cn - 1;
        return (LISTS[(size_t)u.e * LISTCAP + pos].x >> 3) * 1024u * ESZ;
    }
};
struct EpiAct {
    PG8_USE_PERM(Perm8)
    unsigned char* ACT; float* SACT; LAS float* RMAX; const v2u* LISTS; LAS const int* CNT; const float *SA2, *SW13, *SSH13;
    __device__ __forceinline__ void operator()(const f32x4 (&acc)[2][2][4][2], const pg8::Unit& u, int wr, int wc, int fr, int fq) const {
        unsigned lo = (unsigned)(fr * 256 + 8 * fq); OPAQUE_V(lo);
        unsigned lf = (unsigned)fr; OPAQUE_V(lf); unsigned lc4 = (unsigned)(8 * fq) * 4u; OPAQUE_V(lc4);
        unsigned char* ub = ACT + ((size_t)(u.aux + wr * 64) * 256 + u.pn * 128 + wc * 32);
        float sa[8]; f32x4 sw[2][2];
        {
            const float* swp = (u.e < 0 ? SSH13 : SW13 + (size_t)(u.e & 63) * 512) + u.pn * 256 + wc * 32;
#pragma unroll
            for (int bj = 0; bj < 2; ++bj) { const char* sp = (const char*)(swp + bj * 128) + lc4; sw[bj][0] = *(const f32x4*)sp; sw[bj][1] = *(const f32x4*)(sp + 16); }
            if (u.e < 0) {
#pragma unroll
                for (int i = 0; i < 8; ++i) sa[i] = SA2[u.pm * 256 + wr * 64 + (i >> 2) * 128 + (i & 3) * 16 + (int)lf];
            } else {
                const int cn = __builtin_amdgcn_readfirstlane(CNT[u.e]); const v2u* lst = LISTS + (size_t)u.e * LISTCAP; unsigned tk[8];
#pragma unroll
                for (int i = 0; i < 8; ++i) { int pos = u.pm * 256 + wr * 64 + (i >> 2) * 128 + (i & 3) * 16 + (int)lf; pos = pos < cn ? pos : cn - 1; tk[i] = lst[pos].x >> 3; }
#pragma unroll
                for (int i = 0; i < 8; ++i) sa[i] = SA2[tk[i]];
            }
        }
        f32x4 v0[8], v1[8];
#pragma unroll
        for (int i = 0; i < 8; ++i) { const int ai = i >> 2, m = i & 3; const float s = sa[i]; float am = 0.f;
#pragma unroll
            for (int q = 0; q < 4; ++q) { const float a0 = acc[ai][0][m][0][q] * (sw[0][0][q] * s), a1 = acc[ai][0][m][1][q] * (sw[0][1][q] * s);
                v0[i][q] = a0 * fsigmoid(a0) * (acc[ai][1][m][0][q] * (sw[1][0][q] * s)); v1[i][q] = a1 * fsigmoid(a1) * (acc[ai][1][m][1][q] * (sw[1][1][q] * s));
                am = fmaxf(am, fmaxf(fabsf(v0[i][q]), fabsf(v1[i][q]))); }
            am = fmaxf(am, __shfl_xor(am, 16)); am = fmaxf(am, __shfl_xor(am, 32));
            if (fq == 0) RMAX[(ai * 128 + wr * 64 + m * 16 + (int)lf) * 4 + wc] = am; }
        asm volatile("s_waitcnt lgkmcnt(0)" ::: "memory"); __builtin_amdgcn_s_barrier(); asm volatile("" ::: "memory");
#pragma unroll
        for (int i = 0; i < 8; ++i) { const int ai = i >> 2, m = i & 3; const int row = ai * 128 + wr * 64 + m * 16 + (int)lf;
            const f32x4 mx = *(const LAS f32x4*)(RMAX + row * 4); const float am = fmaxf(fmaxf(fmaxf(mx[0], mx[1]), fmaxf(mx[2], mx[3])), 1e-4f), inv = 127.0f / am;
            v2u w; w.x = pk4_i8(v0[i][0], v0[i][1], v0[i][2], v0[i][3], inv); w.y = pk4_i8(v1[i][0], v1[i][1], v1[i][2], v1[i][3], inv);
            *(v2u*)(ub + (size_t)(ai * 128 + m * 16) * 256 + lo) = w;
            if (wc == 0 && fq == 0) SACT[(size_t)(u.aux + row) * 2 + u.pn] = am * (1.0f / 127.0f); }
    }
};
constexpr float Y_MUL = 16.0f, Y_INV = 0.0625f;
struct SchedMoe2 {
    unsigned ACT, W2, SH2; LAS const int* PRE; int G, c, T4, lane; const float* SACT;
    __device__ __forceinline__ bool next(int i, pg8::Unit& u) const {
        const int idx = i * G + c; if (idx >= T4 + 512) return false;
        if (idx < T4) { const int pair = idx >> 2; const int l = moe_find_list(PRE, pair, lane); u.e = l; u.pm = __builtin_amdgcn_readfirstlane(pair - PRE[l]); u.pn = idx & 3; u.aux = pair * 256; }
        else { const int s = idx - T4; u.e = -1; u.pm = s >> 2; u.pn = s & 3; u.aux = ACT_SH_ROW + (s >> 2) * 256; }
        return true;
    }
    __device__ __forceinline__ unsigned a_off(const pg8::Unit& u) const { return ACT + (unsigned)u.aux * 256u; }
    __device__ __forceinline__ unsigned b_off(const pg8::Unit& u) const { return u.e < 0 ? SH2 + (unsigned)u.pn * 256u * 256u : W2 + ((unsigned)(u.e & 63) * 1024u + (unsigned)u.pn * 256u) * 256u; }
    __device__ __forceinline__ unsigned a_rowoff(const pg8::Unit&, int) const { return 0u; }
    __device__ __forceinline__ f32x2 kscale(const pg8::Unit& u, int r) const { return *(const f32x2*)(SACT + (size_t)(u.aux + r) * 2); }
};
struct EpiY {
    PG8_USE_PERM(Perm16)
    unsigned char* YH; bf16* SY; const v2u* LISTS; LAS const int* CNT; int mode; const float *SACT, *SW2, *SSH2;
    __device__ __forceinline__ void operator()(const f32x4 (&acc)[2][2][4][2], const pg8::Unit& u, int wr, int wc, int fr, int fq) const {
        if (mode == 1) { float s = 0.f;
#pragma unroll
            for (int ai = 0; ai < 2; ++ai)
#pragma unroll
                for (int m = 0; m < 4; ++m) s += acc[ai][0][m][0][0] + acc[ai][1][m][1][3];
            if (s == 1.2345e-33f) SY[0] = 1; return; }
        unsigned lf = (unsigned)fr; OPAQUE_V(lf);
        unsigned lc = (unsigned)(16 * fq); OPAQUE_V(lc);
        f32x4 sw[2][2]; float sf[8];
        { const char* sp = (const char*)((u.e < 0 ? SSH2 : SW2 + (size_t)(u.e & 63) * 1024) + u.pn * 256 + wc * 64) + lc * 4u;
#pragma unroll
          for (int bj = 0; bj < 2; ++bj)
#pragma unroll
              for (int n = 0; n < 2; ++n) sw[bj][n] = *(const f32x4*)(sp + (bj * 8 + n * 4) * 4);
#pragma unroll
          for (int i = 0; i < 8; ++i) { const f32x2 s = *(const f32x2*)(SACT + (size_t)(u.aux + wr * 64 + (i >> 2) * 128 + (i & 3) * 16 + (int)lf) * 2); sf[i] = fmaxf(s.y, s.x * 1e-3f); } }
        if (u.e < 0) {
            unsigned lo = (unsigned)(fr * 1024 + 16 * fq) * 2u; OPAQUE_V(lo);
            char* ub = (char*)SY + ((size_t)(u.pm * 256 + wr * 64) * 1024 + u.pn * 256 + wc * 64) * 2;
#pragma unroll
            for (int ai = 0; ai < 2; ++ai)
#pragma unroll
                for (int m = 0; m < 4; ++m)
#pragma unroll
                    for (int bj = 0; bj < 2; ++bj) { const f32x4 v0 = acc[ai][bj][m][0] * (sw[bj][0] * sf[ai * 4 + m]), v1 = acc[ai][bj][m][1] * (sw[bj][1] * sf[ai * 4 + m]);
                        v4u o; o.x = cvt_pk_bf16(v0[0], v0[1]); o.y = cvt_pk_bf16(v0[2], v0[3]); o.z = cvt_pk_bf16(v1[0], v1[1]); o.w = cvt_pk_bf16(v1[2], v1[3]);
                        *(v4u*)(ub + (size_t)(ai * 128 + m * 16) * 2048 + bj * 16 + lo) = o; }
            return;
        }
        const int cn = __builtin_amdgcn_readfirstlane(CNT[u.e]); const int posU = u.pm * 256 + wr * 64;
        const v2u* lst = LISTS + (size_t)u.e * LISTCAP + posU; unsigned char* ub = YH + (size_t)(u.pn * 256 + wc * 64);
        v2u ent[8];
#pragma unroll
        for (int i = 0; i < 8; ++i) { const int ro = (i >> 2) * 128 + (i & 3) * 16 + (int)lf; ent[i] = (posU + ro < cn) ? lst[ro] : (v2u){0xffffffffu, 0u}; }
#pragma unroll
        for (int ai = 0; ai < 2; ++ai)
#pragma unroll
            for (int m = 0; m < 4; ++m) { const v2u en = ent[ai * 4 + m];
                if (en.x != 0xffffffffu) { const float w = __uint_as_float(en.y) * Y_MUL * sf[ai * 4 + m];
                    const f32x4 a0 = acc[ai][0][m][0] * (sw[0][0] * w), a1 = acc[ai][0][m][1] * (sw[0][1] * w), b0 = acc[ai][1][m][0] * (sw[1][0] * w), b1 = acc[ai][1][m][1] * (sw[1][1] * w);
                    v4u o; o.x = pk4_fp8(a0[0], a0[1], a0[2], a0[3]); o.y = pk4_fp8(a1[0], a1[1], a1[2], a1[3]); o.z = pk4_fp8(b0[0], b0[1], b0[2], b0[3]); o.w = pk4_fp8(b1[0], b1[1], b1[2], b1[3]);
                    *(v4u*)(ub + (size_t)en.x * 1024 + lc) = o; } }
    }
};
__device__ __forceinline__ f32x4 fp8x4_to_f32(unsigned w) {
    const f32x2 lo = __builtin_amdgcn_cvt_pk_f32_fp8(w, false), hi = __builtin_amdgcn_cvt_pk_f32_fp8(w, true); return (f32x4){lo[0], lo[1], hi[0], hi[1]}; }
__device__ __forceinline__ void combine_phase(const Frame& F, const Args& A, int layer, bf16* x, float* out) {
    const bool last = (layer == NLAYER - 1);
    LAS float* GATE = (LAS float*)F.lds; LAS float* GS = GATE + NB * DM; LAS float* SH = GS + NB * DM;
    __syncthreads();
    { const int j = layer * 2 + 1; const float* bias = ada_bias(A, j);
      for (int i = F.tid; i < NB * DM; i += NTHR) { const int b = i >> 10, k = i & 1023; GATE[i] = ada_acc(F, j, b)[2048 + k] + bias[2048 + k]; } }
    if (!last) norm_tables(F, A, (layer + 1) * 2, A.in[5] + (layer + 1) * DM, 0, NB, GS, SH);
    else for (int i = F.tid; i < DM; i += NTHR) GS[i] = A.in[28][i];
    __syncthreads();
    const unsigned char* YH = F.ws + WS_YH; const bf16* SY = (const bf16*)(F.ws + WS_SY); unsigned char* H = F.ws + WS_HIN;
    const int gw = F.bid * NWAVES + F.wave, NGW = F.G * NWAVES; const int c0 = 16 * F.lane;
    for (int tok = gw; tok < NTOK; tok += NGW) {
        const int b = tok >> 12;
        bf16* xr = x + (size_t)tok * DM + c0;
        f32x4 xv[4]; v4u yv[8], sv[2], xw[2];
        xw[0] = *(const v4u*)xr; xw[1] = *(const v4u*)(xr + 8);
        sv[0] = *(const v4u*)(SY + (size_t)tok * DM + c0); sv[1] = *(const v4u*)(SY + (size_t)tok * DM + c0 + 8);
#pragma unroll
        for (int k = 0; k < 8; ++k) yv[k] = *(const v4u*)(YH + ((size_t)tok * 8 + k) * 1024 + c0);
        float ssq = 0.f;
#pragma unroll
        for (int q = 0; q < 4; ++q) { const unsigned x0 = xw[q >> 1][(q & 1) * 2], x1 = xw[q >> 1][(q & 1) * 2 + 1]; xv[q] = (f32x4){bflo(x0), bfhi(x0), bflo(x1), bfhi(x1)}; }
#pragma unroll
        for (int q = 0; q < 4; ++q) { f32x4 s = (f32x4){0.f, 0.f, 0.f, 0.f};
#pragma unroll
            for (int k = 0; k < 8; ++k) s += fp8x4_to_f32(yv[k][q]);
            const unsigned w0 = sv[q >> 1][(q & 1) * 2], w1 = sv[q >> 1][(q & 1) * 2 + 1];
            s = s * Y_INV + (f32x4){bflo(w0), bfhi(w0), bflo(w1), bfhi(w1)};
            xv[q] = xv[q] + *(LAS const f32x4*)(GATE + b * DM + c0 + 4 * q) * s;
            ssq += (xv[q].x * xv[q].x + xv[q].y * xv[q].y) + (xv[q].z * xv[q].z + xv[q].w * xv[q].w); }
        const float rstd = 1.0f / sqrtf(wave_sum(ssq) * (1.0f / DM) + EPSV);
        if (last) {
#pragma unroll
            for (int q = 0; q < 4; ++q) *(f32x4*)(out + (size_t)tok * DM + c0 + 4 * q) = (xv[q] * rstd) * *(LAS const f32x4*)(GS + c0 + 4 * q);
        } else {
            f32x4 hh[4];
            { v4u o0, o1; o0.x = cvt_pk_bf16(xv[0][0], xv[0][1]); o0.y = cvt_pk_bf16(xv[0][2], xv[0][3]); o0.z = cvt_pk_bf16(xv[1][0], xv[1][1]); o0.w = cvt_pk_bf16(xv[1][2], xv[1][3]);
              o1.x = cvt_pk_bf16(xv[2][0], xv[2][1]); o1.y = cvt_pk_bf16(xv[2][2], xv[2][3]); o1.z = cvt_pk_bf16(xv[3][0], xv[3][1]); o1.w = cvt_pk_bf16(xv[3][2], xv[3][3]);
              *(v4u*)xr = o0; *(v4u*)(xr + 8) = o1; }
#pragma unroll
            for (int q = 0; q < 4; ++q) {
                hh[q] = (xv[q] * rstd) * *(LAS const f32x4*)(GS + b * DM + c0 + 4 * q) + *(LAS const f32x4*)(SH + b * DM + c0 + 4 * q); }
            if (FP8_T1) { float am = 0.f;
#pragma unroll
                for (int q = 0; q < 4; ++q) am = fmaxf(am, fmaxf(fmaxf(fabsf(hh[q][0]), fabsf(hh[q][1])), fmaxf(fabsf(hh[q][2]), fabsf(hh[q][3]))));
                am = fmaxf(wave_max(am), 1e-20f); const float inv = 127.0f / am; if (F.lane == 0) ((float*)(F.ws + WS_SA))[tok] = am * (1.0f / 127.0f);
                v4u o; o.x = pk4_i8(hh[0][0], hh[0][1], hh[0][2], hh[0][3], inv); o.y = pk4_i8(hh[1][0], hh[1][1], hh[1][2], hh[1][3], inv); o.z = pk4_i8(hh[2][0], hh[2][1], hh[2][2], hh[2][3], inv); o.w = pk4_i8(hh[3][0], hh[3][1], hh[3][2], hh[3][3], inv);
                *(v4u*)(H + (size_t)tok * DM + c0) = o; }
            else { v4u o0, o1; o0.x = pk2(hh[0][0], hh[0][1]); o0.y = pk2(hh[0][2], hh[0][3]); o0.z = pk2(hh[1][0], hh[1][1]); o0.w = pk2(hh[1][2], hh[1][3]);
                o1.x = pk2(hh[2][0], hh[2][1]); o1.y = pk2(hh[2][2], hh[2][3]); o1.z = pk2(hh[3][0], hh[3][1]); o1.w = pk2(hh[3][2], hh[3][3]);
                *(v4u*)(H + ((size_t)tok * DM + c0) * 2) = o0; *(v4u*)(H + ((size_t)tok * DM + c0) * 2 + 16) = o1; }
        }
    }
}

__device__ __forceinline__ void krr_job(const Frame& F) {
    const bf16* __restrict__ CQ = (const bf16*)(F.ws + WS_CQ); bf16* __restrict__ KRR = (bf16*)(F.ws + WS_KRR); const float* __restrict__ rc = (const float*)(F.ws + WS_ROPEC); const float* __restrict__ rs = (const float*)(F.ws + WS_ROPES);
    for (int idx = F.bid * NTHR + F.tid; idx < NTOK * 2; idx += F.G * NTHR) { const int tok = idx >> 1, i8 = (idx & 1) * 8;
        const v4u a = *(const v4u*)(CQ + (size_t)tok * 512 + 384 + i8), b = *(const v4u*)(CQ + (size_t)tok * 512 + 400 + i8);
        const f32x4 c0 = *(const f32x4*)(rc + (size_t)tok * 16 + i8), c1 = *(const f32x4*)(rc + (size_t)tok * 16 + i8 + 4), s0 = *(const f32x4*)(rs + (size_t)tok * 16 + i8), s1 = *(const f32x4*)(rs + (size_t)tok * 16 + i8 + 4);
        const float x1[8] = {bflo(a.x), bfhi(a.x), bflo(a.y), bfhi(a.y), bflo(a.z), bfhi(a.z), bflo(a.w), bfhi(a.w)}, x2[8] = {bflo(b.x), bfhi(b.x), bflo(b.y), bfhi(b.y), bflo(b.z), bfhi(b.z), bflo(b.w), bfhi(b.w)};
        const float c[8] = {c0[0], c0[1], c0[2], c0[3], c1[0], c1[1], c1[2], c1[3]}, s[8] = {s0[0], s0[1], s0[2], s0[3], s1[0], s1[1], s1[2], s1[3]};
        float o1[8], o2[8];
#pragma unroll
        for (int q = 0; q < 8; ++q) { o1[q] = x1[q] * c[q] - x2[q] * s[q]; o2[q] = x2[q] * c[q] + x1[q] * s[q]; }
        v4u w1, w2; w1.x = pk2(o1[0], o1[1]); w1.y = pk2(o1[2], o1[3]); w1.z = pk2(o1[4], o1[5]); w1.w = pk2(o1[6], o1[7]); w2.x = pk2(o2[0], o2[1]); w2.y = pk2(o2[2], o2[3]); w2.z = pk2(o2[4], o2[5]); w2.w = pk2(o2[6], o2[7]);
        *(v4u*)(KRR + (size_t)tok * 32 + i8) = w1; *(v4u*)(KRR + (size_t)tok * 32 + 16 + i8) = w2; }
}
#define POOL_ADD(s, v, sg) do { s[0] += sg bflo(v.x); s[1] += sg bfhi(v.x); s[2] += sg bflo(v.y); s[3] += sg bfhi(v.y); s[4] += sg bflo(v.z); s[5] += sg bfhi(v.z); s[6] += sg bflo(v.w); s[7] += sg bfhi(v.w); } while (0)
__device__ __forceinline__ void pool_job(const Frame& F) {
    const bf16* __restrict__ UB = (const bf16*)(F.ws + WS_UB); bf16* __restrict__ PO = (bf16*)(F.ws + WS_POOL);
    for (int idx = F.bid * NTHR + F.tid; idx < (NTOK / 4) * 64; idx += F.G * NTHR) { const int t0 = (idx >> 6) * 4, c8 = idx & 63, g = c8 >> 4, w = 2 << g, ts = t0 & (SEQ - 1);
        const bf16* up = UB + (size_t)t0 * 512 + c8 * 8;
        v4u r[19];
#pragma unroll
        for (int k = 0; k < 19; ++k) { r[k] = (v4u){0u, 0u, 0u, 0u}; if (k >= 16 - w && ts - 15 + k >= 0) r[k] = *(const v4u*)(up + (k - 15) * 512); }
        float s[8];
#pragma unroll
        for (int q = 0; q < 8; ++q) s[q] = 0.f;
#pragma unroll
        for (int k = 0; k < 16; ++k) POOL_ADD(s, r[k], +);
#pragma unroll
        for (int i = 0; i < 4; ++i) {
            if (i > 0) { const v4u nw = r[15 + i]; const v4u od = (g == 0) ? r[13 + i] : (g == 1) ? r[11 + i] : (g == 2) ? r[7 + i] : r[i - 1]; POOL_ADD(s, nw, +); POOL_ADD(s, od, -); }
            const int n = (ts + i + 1 < w) ? ts + i + 1 : w; const float inv = 1.0f / (float)n; const v4u u = r[15 + i];
            v4u o; o.x = pk2(s[0] * inv - bflo(u.x), s[1] * inv - bfhi(u.x)); o.y = pk2(s[2] * inv - bflo(u.y), s[3] * inv - bfhi(u.y)); o.z = pk2(s[4] * inv - bflo(u.z), s[5] * inv - bfhi(u.z)); o.w = pk2(s[6] * inv - bflo(u.w), s[7] * inv - bfhi(u.w));
            *(v4u*)(PO + (size_t)(t0 + i) * 512 + c8 * 8) = o; }
    }
}
#undef POOL_ADD
__device__ __forceinline__ void dil_combine_job(const Frame& F) {
    const bf16* __restrict__ OD = (const bf16*)(F.ws + WS_QKV); const float* __restrict__ LSE = (const float*)(F.ws + WS_LSE); bf16* __restrict__ YA = (bf16*)(F.ws + WS_CKV);
    const int S = F.G * NTHR;
    for (int idx0 = F.bid * NTHR + F.tid; idx0 < NTOK * 32; idx0 += 4 * S) {
        float l[4][3]; v4u a[4], b[4], c[4];
#pragma unroll
        for (int u = 0; u < 4; ++u) { const int idx = idx0 + u * S; if (idx < NTOK * 32) { const int tok = idx >> 5, hh = (idx >> 3) & 3, d8 = idx & 7;
            l[u][0] = LSE[(size_t)tok * 12 + hh]; l[u][1] = LSE[(size_t)tok * 12 + 4 + hh]; l[u][2] = LSE[(size_t)tok * 12 + 8 + hh];
            a[u] = *(const v4u*)(OD + (size_t)tok * 2304 + hh * 64 + d8 * 8); b[u] = *(const v4u*)(OD + (size_t)tok * 2304 + (4 + hh) * 64 + d8 * 8); c[u] = *(const v4u*)(OD + (size_t)tok * 2304 + (8 + hh) * 64 + d8 * 8); } }
#pragma unroll
        for (int u = 0; u < 4; ++u) { const int idx = idx0 + u * S; if (idx < NTOK * 32) { const int tok = idx >> 5, hh = (idx >> 3) & 3, d8 = idx & 7;
            const float mx = fmaxf(l[u][0], fmaxf(l[u][1], l[u][2])); float w0 = __builtin_amdgcn_exp2f(l[u][0] - mx), w1 = __builtin_amdgcn_exp2f(l[u][1] - mx), w2 = __builtin_amdgcn_exp2f(l[u][2] - mx);
            const float inv = 1.0f / (w0 + w1 + w2); w0 *= inv; w1 *= inv; w2 *= inv;
            const v4u A = a[u], B = b[u], C = c[u]; v4u o;
            o.x = pk2(w0 * bflo(A.x) + w1 * bflo(B.x) + w2 * bflo(C.x), w0 * bfhi(A.x) + w1 * bfhi(B.x) + w2 * bfhi(C.x));
            o.y = pk2(w0 * bflo(A.y) + w1 * bflo(B.y) + w2 * bflo(C.y), w0 * bfhi(A.y) + w1 * bfhi(B.y) + w2 * bfhi(C.y));
            o.z = pk2(w0 * bflo(A.z) + w1 * bflo(B.z) + w2 * bflo(C.z), w0 * bfhi(A.z) + w1 * bfhi(B.z) + w2 * bfhi(C.z));
            o.w = pk2(w0 * bflo(A.w) + w1 * bflo(B.w) + w2 * bflo(C.w), w0 * bfhi(A.w) + w1 * bfhi(B.w) + w2 * bfhi(C.w));
            *(v4u*)(YA + (size_t)tok * 256 + hh * 64 + d8 * 8) = o; } }
    }
}
__device__ __forceinline__ void final_norm(const Frame& F, const Args& A, float* x) {
    const int gw = F.bid * NWAVES + F.wave, NGW = F.G * NWAVES; const float* g = A.in[28];
    for (int m = gw; m < NTOK; m += NGW) { f32x4* xr = (f32x4*)(x + (size_t)m * DM) + F.lane; f32x4 v[4]; float s = 0.f;
#pragma unroll
        for (int q = 0; q < 4; ++q) { v[q] = xr[64 * q]; s += (v[q].x * v[q].x + v[q].y * v[q].y) + (v[q].z * v[q].z + v[q].w * v[q].w); }
        const float rstd = 1.0f / sqrtf(wave_sum(s) * (1.0f / DM) + EPSV);
#pragma unroll
        for (int q = 0; q < 4; ++q) xr[64 * q] = (v[q] * rstd) * *(const f32x4*)(g + 4 * F.lane + 256 * q); }
}

__device__ __forceinline__ void dilated_units(const Frame& F, bf16* o_redirect, float* lse_redirect) {
    bf16* QKV = (bf16*)(F.ws + WS_QKV); float* LSE = (float*)(F.ws + WS_LSE);
    for (int u = F.bid; u < 1536; u += F.G) {
        const int g = u >> 9, v = u & 511; int b, r, h, qb, d;
        if (g == 0) { d = 1; b = v >> 6; h = (v >> 4) & 3; qb = v & 15; r = 0; }
        else if (g == 1) { d = 4; b = v >> 6; r = (v >> 4) & 3; h = (v >> 2) & 3; qb = v & 3; }
        else { d = 16; b = v >> 6; r = (v >> 2) & 15; h = v & 3; qb = 0; }
        const int hd = g * 4 + h; const size_t tok0 = (size_t)b * SEQ + r;
        AttnCfg cf; const long pitch = (long)d * 2304;
        cf.Qp = QKV + tok0 * 2304 + hd * 64; cf.qpitch = pitch; cf.Kp = QKV + tok0 * 2304 + 768 + hd * 64; cf.kpitch = pitch; cf.K2p = nullptr; cf.k2pitch = 0;
        cf.Vp = QKV + tok0 * 2304 + 1536 + hd * 64; cf.vpitch = pitch; cf.Op = QKV + tok0 * 2304 + hd * 64; cf.opitch = pitch;
        cf.lsep = LSE + tok0 * 12 + hd; cf.lsepitch = (long)d * 12;
        if (o_redirect) { cf.Op = o_redirect + tok0 * 768 + hd * 64; cf.opitch = (long)d * 768; cf.lsep = lse_redirect + tok0 * 12 + hd; }
        cf.q0 = qb * 256; cf.kt_lo = qb == 0 ? 0 : (qb * 256 - 128) / 64; cf.kt_hi = (qb * 256 + 256) / 64; cf.band = 128;
        attn_unit<64>(cf, F.lds);
    }
}
__device__ __forceinline__ void mla_units(const Frame& F) {
    const bf16* Q = (const bf16*)(F.ws + WS_Q); const bf16* KV = (const bf16*)(F.ws + WS_KV); const bf16* KRR = (const bf16*)(F.ws + WS_KRR); bf16* YC = (bf16*)(F.ws + WS_UB);
    for (int p = F.bid; p < 512; p += F.G) {
        const int bh = p >> 3, s = p & 7, b = bh >> 3, h = bh & 7;
        for (int half = 0; half < 2; ++half) { const int qb = half ? 15 - s : s; const size_t tok0 = (size_t)b * SEQ;
            AttnCfg cf;
            cf.Qp = Q + tok0 * 768 + h * 96; cf.qpitch = 768; cf.Kp = KV + tok0 * 1024 + h * 128; cf.kpitch = 1024; cf.K2p = KRR + tok0 * 32; cf.k2pitch = 32;
            cf.Vp = KV + tok0 * 1024 + h * 128 + 64; cf.vpitch = 1024; cf.Op = YC + tok0 * 512 + h * 64; cf.opitch = 512; cf.lsep = nullptr; cf.lsepitch = 0;
            cf.q0 = qb * 256; cf.kt_lo = 0; cf.kt_hi = (qb * 256 + 256) / 64; cf.band = 0;
            attn_unit<96>(cf, F.lds); }
    }
}

constexpr int PH_PER_LAYER = 9, N_PHASES = 2 + NLAYER * PH_PER_LAYER;
#ifndef ONLY_PH
#define ONLY_PH -1
#endif
#ifndef T1_SKEW
#define T1_SKEW 3
#endif
#ifndef PROBE_DUP
#define PROBE_DUP -1
#endif
__global__ void __launch_bounds__(NTHR, 2) fwd_kernel(Args args) {
    extern __shared__ __attribute__((aligned(16))) unsigned char lds_raw[];
    Frame F;
    F.lds = (LAS unsigned char*)lds_raw;
    F.tid = threadIdx.x; F.lane = F.tid & 63; F.wave = __builtin_amdgcn_readfirstlane(F.tid >> 6); F.G = gridDim.x; F.bid = blockIdx.x;
    F.ws = args.ws; F.ctl = (unsigned*)(args.ws + WS_ZERO);
    volatile LAS unsigned* MISC = (volatile LAS unsigned*)(F.lds + MISC_OFF);
    for (int u = F.tid; u < (LDS_BYTES - LDSCTL_OFF) / 4; u += NTHR) ((LAS unsigned*)(F.lds + LDSCTL_OFF))[u] = 0u;
    __syncthreads();
    const int lo = args.ph_lo, hi = args.ph_hi;
    const bool multi = (hi - lo) > 1;
    XcdBarrier bar; bar.bar = F.ctl + CW_BAR; bar.x = 0; bar.st = nullptr;
    if (multi) bar = xcd_barrier_post(F.ctl + CW_BAR, MISC + 8);
#define EN(j) (ONLY_PH < 0 || ONLY_PH == (j))
#define REP(k) for (int rep_ = 0; rep_ < ((PROBE_DUP == (k)) ? 2 : 1); ++rep_)
#define PHASE_BEGIN() do { int t_ = threadIdx.x; asm volatile("" : "+v"(t_)); F.tid = t_; F.lane = t_ & 63; unsigned char* w_ = args.ws; asm volatile("" : "+s"(w_)); F.ws = w_; F.ctl = (unsigned*)w_; } while (0)
#define IN(k) (lo <= (k) && (k) < hi)
#define SEAM(k) do { if (IN(k) && IN((k) + 1)) xcd_barrier(bar); } while (0)
#define Wb ((bf16*)(F.ws + WS_W))
    float* const dout = args.out; bf16* const xres = (bf16*)(args.ws + WS_X);
    if (EN(0) && IN(0)) { PHASE_BEGIN(); REP(0) { p0_phase(F, args); __syncthreads(); } REP(10) { convert_layer_weights(F, args, 0); __syncthreads(); } } SEAM(0);
    if (EN(1) && IN(1)) { PHASE_BEGIN(); ada_tables(F, args); REP(1) { norm_rows(F, args, args.in[0], 0, args.in[5], F.ws + WS_HIN); __syncthreads(); } } SEAM(1);
    for (int layer = 0; layer < NLAYER; ++layer) {
        const int pb = 2 + layer * PH_PER_LAYER;
        if (EN(2) && IN(pb + 0)) { PHASE_BEGIN(); REP(2) {
            SchedDense S; S.init(WS_HIN, WS_W + WO_WIN, 1024, 1024, NTOK, NINP, F.G, F.bid, FP8_T1 ? 1 : 2);
            EpiWin E{(bf16*)(F.ws + WS_QKV), (bf16*)(F.ws + WS_UB), (bf16*)(F.ws + WS_CQ), (bf16*)(F.ws + WS_CKV), (bf16*)(F.ws + WS_G), (float*)(F.ws + WS_SSQ), (float*)(F.ws + WS_SSKV), 0, FP8_T1 ? (const float*)(F.ws + WS_SA) : nullptr, (const float*)(F.ws + WS_SWIN)};
            if (PROBE_DUP == 21) { EpiWin Ed = E; Ed.dry = 1; pg8::gemm_phase<EpiWin, SchedDense, false, (FP8_T1 ? 1 : 2)>(F.lds, F.ws, pg8::Gemm{1024, 1024, 1024, T1_SKEW}, S, Ed); __syncthreads(); }
            pg8::gemm_phase<EpiWin, SchedDense, false, (FP8_T1 ? 1 : 2)>(F.lds, F.ws, pg8::Gemm{1024, 1024, 1024, T1_SKEW}, S, E); }
        } SEAM(pb + 0);
        if (EN(3) && IN(pb + 1)) { PHASE_BEGIN(); REP(3) {
            { SchedDense S; S.init(WS_CQ, WS_W + WO_WUQ, 512, 384, NTOK, 768, F.G, F.bid);
              EpiQ E{(bf16*)(F.ws + WS_Q), (const float*)(F.ws + WS_SSQ), (const float*)(F.ws + WS_ROPEC), (const float*)(F.ws + WS_ROPES)};
              pg8::gemm_phase<EpiQ, SchedDense, false>(F.lds, F.ws, pg8::Gemm{384, 512, 384}, S, E); }
            { SchedDense S; S.init(WS_CKV, WS_W + WO_WKV, 256, 256, NTOK, 1024, F.G, F.bid);
              EpiKV E{(bf16*)(F.ws + WS_KV), (const float*)(F.ws + WS_SSKV)};
              pg8::gemm_phase<EpiKV, SchedDense, false>(F.lds, F.ws, pg8::Gemm{256, 256, 256}, S, E); }
            REP(32) { krr_job(F); } REP(31) { pool_job(F); }
            __syncthreads(); }
            if (PROBE_DUP == 30 && layer == 0) { dilated_units(F, (bf16*)dout, (float*)dout + 16 * MiB); __syncthreads(); }
            dilated_units(F, nullptr, nullptr);
        } SEAM(pb + 1);
        if (EN(4) && IN(pb + 2)) { PHASE_BEGIN(); REP(4) { mla_units(F); REP(41) { dil_combine_job(F); } } } SEAM(pb + 2);
        if (EN(5) && IN(pb + 3)) { PHASE_BEGIN(); REP(5) {
            SchedDense S; S.init(0, 0, 256, 256, NTOK, 1024, F.G, F.bid);
            const T5Seg s0{(unsigned)WS_CKV, (unsigned)(WS_W + WO_WOA), 256, 256}, s1{(unsigned)WS_POOL, (unsigned)(WS_W + WO_WPB), 512, 512}, s2{(unsigned)WS_UB, (unsigned)(WS_W + WO_WOC), 512, 512};
            gemm_t5_phase(F.lds, F.ws, s0, s1, s2, S, (const unsigned char*)(F.ws + WS_G), (bf16*)(F.ws + WS_KV)); }
        } SEAM(pb + 3);
        if (EN(6) && IN(pb + 4)) { PHASE_BEGIN(); for (int rep_ = 0; rep_ < ((PROBE_DUP == 6 && layer == 0) ? 2 : 1); ++rep_) {
            SchedDense S; S.init(WS_KV, WS_W + WO_WOUT, 1024, 1024, NTOK, 1024, F.G, F.bid);
            EpiRes E{layer == 0 ? args.in[0] : nullptr, xres, xres, (const float*)(F.ws + WS_GVT) + layer * NB * DM, (const float*)(F.ws + WS_GS2T) + layer * NB * DM, (float*)(F.ws + WS_XSS), (float*)(F.ws + WS_XMX)};
            pg8::gemm_phase<EpiRes, SchedDense, false>(F.lds, F.ws, pg8::Gemm{1024, 1024, 1024}, S, E); }
        } SEAM(pb + 4);
        if (EN(7) && IN(pb + 5)) { PHASE_BEGIN(); n2_route_phase(F, args, layer, xres); __syncthreads(); REP(7) { n2_convert_experts(F, args, layer); } } SEAM(pb + 5);
        if (EN(8) && IN(pb + 6)) { PHASE_BEGIN(); REP(8) {
            moe_tables(F, layer);
            LAS const int* PRE = (LAS const int*)(F.lds + MOE_OFF); LAS const int* CNT = PRE + 132;
            SchedMoe1 S{(unsigned)WS_H2, (unsigned)WS_WEXP13, (unsigned)(WS_W + WO_SH13), (const v2u*)(F.ws + WS_LISTS), PRE, CNT, F.G, F.bid, __builtin_amdgcn_readfirstlane(2 * PRE[NLIST]), F.lane};
            EpiAct E{F.ws + WS_ACT, (float*)(F.ws + WS_SACT), (LAS float*)(F.lds + LDSCTL_OFF + 8192), (const v2u*)(F.ws + WS_LISTS), CNT, (const float*)(F.ws + WS_SA2), (const float*)(F.ws + WS_SW13), (const float*)(F.ws + WS_SSH13)};
            pg8::gemm_phase<EpiAct, SchedMoe1, true, (FP8_F2 ? 1 : 2)>(F.lds, F.ws, pg8::Gemm{1024, 1024, 1024}, S, E); }
        } SEAM(pb + 6);
        if (EN(9) && IN(pb + 7)) { PHASE_BEGIN(); REP(9) {
            moe_tables(F, layer);
            LAS const int* PRE = (LAS const int*)(F.lds + MOE_OFF); LAS const int* CNT = PRE + 132;
            SchedMoe2 S{(unsigned)WS_ACT, (unsigned)WS_WEXP2, (unsigned)(WS_W + WO_SH2), PRE, F.G, F.bid, __builtin_amdgcn_readfirstlane(4 * PRE[NLIST]), F.lane, (const float*)(F.ws + WS_SACT)};
            EpiY E{F.ws + WS_YH, (bf16*)(F.ws + WS_SY), (const v2u*)(F.ws + WS_LISTS), CNT, 0, (const float*)(F.ws + WS_SACT), (const float*)(F.ws + WS_SW2), (const float*)(F.ws + WS_SSH2)};
            if (PROBE_DUP == 91) { EpiY Ed = E; Ed.mode = 1; pg8::gemm_phase<EpiY, SchedMoe2, false, 1, true>(F.lds, F.ws, pg8::Gemm{256, 256, 256}, S, Ed); __syncthreads(); }
            pg8::gemm_phase<EpiY, SchedMoe2, false, 1, true>(F.lds, F.ws, pg8::Gemm{256, 256, 256}, S, E); }
        } SEAM(pb + 7);
        if (EN(10) && IN(pb + 8)) { PHASE_BEGIN();
            combine_phase(F, args, layer, xres, dout);
            if (layer + 1 < NLAYER) { __syncthreads(); convert_layer_weights(F, args, layer + 1); }
        } SEAM(pb + 8);
    }
#undef Wb
#undef IN
#undef SEAM
#undef EN
#undef REP
#undef PHASE_BEGIN
}

#ifndef MK_PER_PHASE
#define MK_PER_PHASE 0
#endif
extern "C" void kernel_launch(void* const* d_in, const int* in_sizes, int n_in, void* d_out, int out_size, void* d_ws, size_t ws_size, hipStream_t stream) {
    static int grid = 0;
    if (grid == 0) {
        if (n_in != 29 || out_size != NTOK * DM || ws_size < WS_END) { fprintf(stderr, "kernel_launch: unexpected problem (n_in %d, out %d, ws %zu < %zu)\n", n_in, out_size, ws_size, (size_t)WS_END); grid = -1; return; }
        int dev = 0, cus = 0, per_cu = 0;
        if (hipGetDevice(&dev) != hipSuccess || hipDeviceGetAttribute(&cus, hipDeviceAttributeMultiprocessorCount, dev) != hipSuccess) { grid = -1; return; }
        if (hipFuncSetAttribute((const void*)fwd_kernel, hipFuncAttributeMaxDynamicSharedMemorySize, LDS_BYTES) != hipSuccess) { fprintf(stderr, "kernel_launch: hipFuncSetAttribute failed\n"); grid = -1; return; }
        if (hipOccupancyMaxActiveBlocksPerMultiprocessor(&per_cu, (const void*)fwd_kernel, NTHR, LDS_BYTES) != hipSuccess || per_cu < 1) { fprintf(stderr, "kernel_launch: occupancy query says %d\n", per_cu); (void)hipGetLastError(); per_cu = 1; }
        grid = cus;
    }
    if (grid < 0) return;
    (void)hipMemsetAsync((char*)d_ws + WS_ZERO, 0, ZERO_BYTES, stream);
    Args a{};
    for (int i = 0; i < 29; ++i) a.in[i] = (const float*)d_in[i];
    a.pos = (const int*)d_in[2]; a.out = (float*)d_out; a.ws = (unsigned char*)d_ws;
#if MK_PER_PHASE
    for (int p = 0; p < N_PHASES; ++p) { a.ph_lo = p; a.ph_hi = p + 1; hipLaunchKernelGGL(fwd_kernel, dim3(grid), dim3(NTHR), LDS_BYTES, stream, a); }
#else
    a.ph_lo = 0; a.ph_hi = N_PHASES; hipLaunchKernelGGL(fwd_kernel, dim3(grid), dim3(NTHR), LDS_BYTES, stream, a);
#endif
}
```

```cpp
#define MK_PER_PHASE 0
#define T1_SKEW 0
#include <hip/hip_runtime.h>
#include <cstdio>
#include <cstdint>

#define GAS __attribute__((address_space(1)))
#define LAS __attribute__((address_space(3)))
typedef unsigned short bf16;
typedef unsigned v4u __attribute__((ext_vector_type(4)));
typedef unsigned v2u __attribute__((ext_vector_type(2)));
typedef float f32x4 __attribute__((ext_vector_type(4)));
typedef float f32x2 __attribute__((ext_vector_type(2)));
typedef float f32x16 __attribute__((ext_vector_type(16)));
typedef short bf16x8 __attribute__((ext_vector_type(8)));
typedef short s16x4 __attribute__((ext_vector_type(4)));
typedef GAS unsigned gu32;
#define RLX_AGENT __ATOMIC_RELAXED, __HIP_MEMORY_SCOPE_AGENT
#define LDS_WAIT() asm volatile("s_waitcnt lgkmcnt(0)" ::: "memory")
#define VM_WAIT() asm volatile("s_waitcnt vmcnt(0)" ::: "memory")
__device__ __forceinline__ unsigned f2bf(float f) { unsigned u = __builtin_bit_cast(unsigned, f); return (u + 0x7fffu + ((u >> 16) & 1u)) >> 16; }
__device__ __forceinline__ unsigned pk2(float lo, float hi) { return f2bf(lo) | (f2bf(hi) << 16); }
__device__ __forceinline__ float bf2f(unsigned b) { return __builtin_bit_cast(float, b << 16); }
__device__ __forceinline__ float bflo(unsigned w) { return __builtin_bit_cast(float, w << 16); }
__device__ __forceinline__ float bfhi(unsigned w) { return __builtin_bit_cast(float, w & 0xffff0000u); }
__device__ __forceinline__ unsigned cvt_pk_bf16(float lo, float hi) { unsigned r; asm volatile("v_cvt_pk_bf16_f32 %0, %1, %2" : "=v"(r) : "v"(lo), "v"(hi)); return r; }
__device__ __forceinline__ float wave_sum(float v) {
#pragma unroll
    for (int o = 1; o < 64; o <<= 1) v += __shfl_xor(v, o);
    return v;
}
#ifndef FP8_T1
#define FP8_T1 1
#endif
#ifndef FP8_F2
#define FP8_F2 1
#endif
__device__ __forceinline__ unsigned pk4_fp8(float a, float b, float c, float d) {
    a = __builtin_fminf(__builtin_fmaxf(a, -448.f), 448.f); b = __builtin_fminf(__builtin_fmaxf(b, -448.f), 448.f); c = __builtin_fminf(__builtin_fmaxf(c, -448.f), 448.f); d = __builtin_fminf(__builtin_fmaxf(d, -448.f), 448.f);
    unsigned w = 0u; w = __builtin_amdgcn_cvt_pk_fp8_f32(a, b, w, false); w = __builtin_amdgcn_cvt_pk_fp8_f32(c, d, w, true); return w; }
__device__ __forceinline__ unsigned pk4_i8(float a, float b, float c, float d, float inv) {
    const float M = 12582912.0f;
    const unsigned ua = __builtin_bit_cast(unsigned, __builtin_fmaf(a, inv, M)), ub = __builtin_bit_cast(unsigned, __builtin_fmaf(b, inv, M)), uc = __builtin_bit_cast(unsigned, __builtin_fmaf(c, inv, M)), ud = __builtin_bit_cast(unsigned, __builtin_fmaf(d, inv, M));
    const unsigned lo = __builtin_amdgcn_perm(ub, ua, 0x0c0c0400u), hi = __builtin_amdgcn_perm(ud, uc, 0x0c0c0400u);
    return __builtin_amdgcn_perm(hi, lo, 0x05040100u); }
__device__ __forceinline__ float wave_max(float v) {
#pragma unroll
    for (int o = 1; o < 64; o <<= 1) v = fmaxf(v, __shfl_xor(v, o));
    return v;
}
__device__ __forceinline__ float fsigmoid(float x) { return __builtin_amdgcn_rcpf(1.0f + __builtin_amdgcn_exp2f(-1.4426950408889634f * x)); }

namespace pg8 {
constexpr int BM = 256, BK = 64, HALF = 128, HTB = HALF * BK * 2  , STAGE_BYTES = 8 * HTB;
constexpr int ROWTAB_OFF = STAGE_BYTES + 4096;
__host__ __device__ __forceinline__ int lds_byte(int r, int c) { const int st = (r >> 4) * 2 + (c >> 5), rr = r & 15, cc = c & 31, ob = rr * 64 + cc * 2; return st * 1024 + (ob ^ (((ob >> 9) & 1) << 5)); }
__host__ __device__ __forceinline__ void stage_rc(int b, int& R, int& C) { const int st = b / 1024, sb = b % 1024, swz = sb ^ (((sb >> 9) & 1) << 5); R = (st >> 1) * 16 + swz / 64; C = (st & 1) * 32 + (swz % 64) / 2; }
__host__ __device__ __forceinline__ int perm32(int rho) { const int n = rho >> 4, i = rho & 15; return 8 * (i >> 2) + 4 * n + (i & 3); }

typedef int v8i __attribute__((ext_vector_type(8)));
typedef int v4i __attribute__((ext_vector_type(4)));
__device__ __forceinline__ v8i cat8(bf16x8 a, bf16x8 b) { const v4u x = __builtin_bit_cast(v4u, a), y = __builtin_bit_cast(v4u, b); return (v8i){(int)x.x, (int)x.y, (int)x.z, (int)x.w, (int)y.x, (int)y.y, (int)y.z, (int)y.w}; }
constexpr int F8_SCALE_ONE = 0x7f7f7f7f, F8_SCALE_W = 0x7a7a7a7a; constexpr float F8_WMUL = 32.0f;
struct Unit { int pm, pn, e, aux; };
struct Gemm { int K, lda, ldb; int skew = 0; };

struct PermNone { static constexpr bool PERM = false; static constexpr int B_PIECE = 64, B_HALF = 128; __device__ static __forceinline__ int bperm(int r) { return r; } };
struct Perm8 {
    static constexpr bool PERM = true; static constexpr int B_PIECE = 64, B_HALF = 128; __device__ static __forceinline__ int bperm(int r) { return (r & ~31) + perm32(r & 31); } };
struct Perm16 {
    static constexpr bool PERM = true; static constexpr int B_PIECE = 128, B_HALF = 8;
    __device__ static __forceinline__ int bperm(int r) { return 64 * ((r >> 5) & 3) + 16 * ((r & 15) >> 2) + 8 * (r >> 7) + 4 * ((r >> 4) & 1) + (r & 3); } };
#define PG8_USE_PERM(P) static constexpr bool PERM = pg8::P::PERM; static constexpr int B_PIECE = pg8::P::B_PIECE, B_HALF = pg8::P::B_HALF; __device__ static __forceinline__ int bperm(int r) { return pg8::P::bperm(r); }
template <class Epi, class Sched, bool GATHER, int ES = 2, bool KS = false>
__device__ __forceinline__ void gemm_phase(LAS unsigned char* lds, const unsigned char* base, const Gemm g, const Sched& S, const Epi& E) {
    const __amdgpu_buffer_rsrc_t rsrc = __builtin_amdgcn_make_buffer_rsrc((void*)base, 0, 0xffffffff, 0x00020000);
    int tid_ = threadIdx.x; asm volatile("" : "+v"(tid_));
    const int tid = tid_, wid = __builtin_amdgcn_readfirstlane(tid >> 6), lane = tid & 63, wr = wid >> 2, wc = wid & 3, fr = lane & 15, fq = lane >> 4;
    const int K = g.K, nt = K * ES / 128;
    int R0, C0;
    stage_rc(tid * 16, R0, C0); C0 *= 2;
    const int Rb0 = Epi::bperm(R0);
    const unsigned voffB = (unsigned)(Rb0 * g.ldb * ES + C0);
    const unsigned cvA0 = (unsigned)(R0 * g.lda * ES + C0);
    LAS unsigned* rowtab = (LAS unsigned*)(lds + ROWTAB_OFF);
    const unsigned pstepA = 64u * g.lda * ES, pstepB = (unsigned)Epi::B_PIECE * g.ldb * ES;
    const unsigned hstepA = GATHER ? 0u : (unsigned)HALF * g.lda * ES;
    const unsigned kstep = (unsigned)(BK * 2);
    const unsigned hstepB = (unsigned)Epi::B_HALF * g.ldb * ES;
    const unsigned ldsw = (unsigned)wid * 1024u;
    const int aoff = lds_byte(wr * 64 + fr, fq * 8), boff = lds_byte(wc * 32 + fr, fq * 8);
#define PG8_SA(b, h) (((b) * 2 + (h)) * HTB)
#define PG8_SB(b, h) ((4 + (b) * 2 + (h)) * HTB)
#define PG8_STAGEB(bufoff, goff) do { _Pragma("unroll") for (int _i = 0; _i < 2; ++_i) \
        __builtin_amdgcn_raw_ptr_buffer_load_lds(rsrc, (LAS void*)(lds + (bufoff) + ldsw + _i * 8192), 16, voffB, (goff) + _i * pstepB, 0, 0); } while (0)
#define PG8_STAGEA(bufoff, goff, PAR, h) do { _Pragma("unroll") for (int _i = 0; _i < 2; ++_i) { \
        if constexpr (GATHER) __builtin_amdgcn_raw_ptr_buffer_load_lds(rsrc, (LAS void*)(lds + (bufoff) + ldsw + _i * 8192), 16, rowtab[(PAR) * 256 + R0 + 64 * _i + HALF * (h)] + (unsigned)C0, (goff), 0, 0); \
        else __builtin_amdgcn_raw_ptr_buffer_load_lds(rsrc, (LAS void*)(lds + (bufoff) + ldsw + _i * 8192), 16, cvA0, (goff) + (h) * hstepA + _i * pstepA, 0, 0); } } while (0)
#define PG8_LDA(dst, b, h) do { _Pragma("unroll") for (int m = 0; m < 4; ++m) _Pragma("unroll") for (int k = 0; k < 2; ++k) dst[m][k] = *(const LAS bf16x8*)(lds + PG8_SA(b, h) + aoff + m * 2048 + k * 1024); } while (0)
#define PG8_LDB(dst, b, h) do { _Pragma("unroll") for (int n = 0; n < 2; ++n) _Pragma("unroll") for (int k = 0; k < 2; ++k) dst[n][k] = *(const LAS bf16x8*)(lds + PG8_SB(b, h) + boff + n * 2048 + k * 1024); } while (0)
#define PG8_MMA(ai, bj, At, Bt) do { __builtin_amdgcn_s_setprio(1); _Pragma("unroll") for (int m = 0; m < 4; ++m) _Pragma("unroll") for (int n = 0; n < 2; ++n) _Pragma("unroll") for (int k = 0; k < 2; ++k) { \
        if constexpr (ES == 2) acc[ai][bj][m][n] = __builtin_amdgcn_mfma_f32_16x16x32_bf16(Bt[n][k], At[m][k], acc[ai][bj][m][n], 0, 0, 0); \
        else acc[ai][bj][m][n] = __builtin_bit_cast(f32x4, __builtin_amdgcn_mfma_i32_16x16x64_i8(__builtin_bit_cast(pg8::v4i, Bt[n][k]), __builtin_bit_cast(pg8::v4i, At[m][k]), __builtin_bit_cast(pg8::v4i, acc[ai][bj][m][n]), 0, 0, 0)); } \
        __builtin_amdgcn_s_setprio(0); } while (0)
#define PG8_WAIT_V(n) asm volatile("s_waitcnt vmcnt(" #n ")" ::: "memory")
#define PG8_WAIT_L(n) asm volatile("s_waitcnt lgkmcnt(" #n ")" ::: "memory")
#define PG8_BAR __builtin_amdgcn_s_barrier()
#define PG8_SCHED __builtin_amdgcn_sched_barrier(0)
    Unit cur, nxt; int ui = 0; int later = 0;
    if (!S.next(0, cur)) return;
    if (g.skew > 0) { for (int i = 0; i < (int)(blockIdx.x & 7) * g.skew; ++i) __builtin_amdgcn_s_sleep(16); }

    f32x4 acc[2][2][4][2];
#pragma unroll
    for (int a = 0; a < 2; ++a)
#pragma unroll
        for (int b = 0; b < 2; ++b)
#pragma unroll
            for (int m = 0; m < 4; ++m)
#pragma unroll
                for (int n = 0; n < 2; ++n) acc[a][b][m][n] = (f32x4){0.f, 0.f, 0.f, 0.f};
    bf16x8 At[4][2], B0[2][2], B1[2][2];
    unsigned cA = S.a_off(cur), cB = S.b_off(cur);
    asm volatile("" : "+s"(cA), "+s"(cB));
    int par = 0;
#define PG8_NX1(p) ((p) == 2 ? 0 : (p) + 1)
    LAS float* kstab = (LAS float*)(lds + ROWTAB_OFF + 2048); int kpar = 0;
    if constexpr (KS) { if (tid < 256) { const f32x2 s = S.kscale(cur, tid); kstab[tid] = fminf(s.x * __builtin_amdgcn_rcpf(s.y), 1000.0f); } }
    if constexpr (GATHER) {
        Unit u1; const bool h1 = S.next(1, u1);
        if (tid < 256) { rowtab[tid] = S.a_rowoff(cur, tid); if (h1) rowtab[256 + tid] = S.a_rowoff(u1, tid); }
        asm volatile("s_waitcnt vmcnt(0) lgkmcnt(0)" ::: "memory"); __builtin_amdgcn_s_barrier(); asm volatile("" ::: "memory");
    }
    PG8_STAGEB(PG8_SB(0, 0), cB); PG8_STAGEB(PG8_SB(0, 1), cB + hstepB); PG8_STAGEA(PG8_SA(0, 0), cA, par, 0); PG8_STAGEA(PG8_SA(0, 1), cA, par, 1);
    if (wr == 1) PG8_BAR;
    PG8_WAIT_V(2); PG8_BAR;
    PG8_STAGEB(PG8_SB(1, 0), cB + kstep); PG8_STAGEA(PG8_SA(1, 0), cA + kstep, par, 0); PG8_STAGEB(PG8_SB(1, 1), cB + hstepB + kstep);
    PG8_WAIT_V(6); PG8_BAR;
    for (;;) {
        const bool has_next = S.next(ui + 1, nxt);
        const unsigned nA = has_next ? S.a_off(nxt) : cA, nB = has_next ? S.b_off(nxt) : cB;
        Unit nn; bool has_nn = false;
        if constexpr (GATHER) has_nn = has_next && S.next(ui + 2, nn);
#pragma unroll 1
        for (int t = 0; t < nt; t += 2) {
            const bool last = (t == nt - 2);
            const unsigned a1 = cA + (unsigned)(t + 1) * kstep;
            const unsigned a2 = last ? nA : cA + (unsigned)(t + 2) * kstep, b2 = last ? nB : cB + (unsigned)(t + 2) * kstep;
            const unsigned a3 = a2 + kstep, b3 = b2 + kstep;
            const int xpar = (GATHER && last && has_next) ? PG8_NX1(par) : par;
            const bool relax = (t == 0) && (later != 0);
            PG8_LDB(B0, 0, 0); PG8_LDB(B1, 0, 1); PG8_SCHED; PG8_LDA(At, 0, 0); PG8_STAGEA(PG8_SA(1, 1), a1, par, 1);
            if (!relax) PG8_WAIT_V(8);
            PG8_WAIT_L(0); PG8_BAR; PG8_MMA(0, 0, At, B0); PG8_MMA(0, 1, At, B1); PG8_BAR; PG8_SCHED;
            PG8_LDA(At, 0, 1); PG8_STAGEB(PG8_SB(0, 0), b2); PG8_STAGEB(PG8_SB(0, 1), b2 + hstepB); PG8_STAGEA(PG8_SA(0, 0), a2, xpar, 0);
            if (!relax) PG8_WAIT_V(8);
            PG8_WAIT_L(0); PG8_BAR; PG8_MMA(1, 0, At, B0); PG8_MMA(1, 1, At, B1); PG8_BAR; PG8_SCHED;
            if constexpr (KS) {
                int t3 = threadIdx.x; asm volatile("" : "+v"(t3)); const LAS float* kp = kstab + kpar * 256 + wr * 64 + (t3 & 15); float rs[8];
#pragma unroll
                for (int i = 0; i < 8; ++i) rs[i] = kp[(i >> 2) * 128 + (i & 3) * 16];
#pragma unroll
                for (int a = 0; a < 2; ++a)
#pragma unroll
                    for (int b = 0; b < 2; ++b)
#pragma unroll
                        for (int m = 0; m < 4; ++m)
#pragma unroll
                            for (int n = 0; n < 2; ++n) { const v4i iv = __builtin_bit_cast(v4i, acc[a][b][m][n]); const float r = rs[a * 4 + m];
                                acc[a][b][m][n] = __builtin_bit_cast(f32x4, (v4i){(int)((float)iv[0] * r), (int)((float)iv[1] * r), (int)((float)iv[2] * r), (int)((float)iv[3] * r)}); }
            }
            PG8_LDB(B0, 1, 0); PG8_LDB(B1, 1, 1); PG8_SCHED; PG8_LDA(At, 1, 0); PG8_STAGEA(PG8_SA(0, 1), a2, xpar, 1);
            PG8_WAIT_V(8); PG8_WAIT_L(0); PG8_BAR; PG8_MMA(0, 0, At, B0); PG8_MMA(0, 1, At, B1); PG8_BAR; PG8_SCHED;
            PG8_LDA(At, 1, 1); PG8_STAGEB(PG8_SB(1, 0), b3); PG8_STAGEB(PG8_SB(1, 1), b3 + hstepB); PG8_STAGEA(PG8_SA(1, 0), a3, xpar, 0);
            PG8_WAIT_V(8); PG8_WAIT_L(0); PG8_BAR; PG8_MMA(1, 0, At, B0); PG8_MMA(1, 1, At, B1); PG8_BAR; PG8_SCHED;
        }
        if (wr == 0) PG8_BAR;
        if constexpr (ES == 1) {
#pragma unroll
            for (int a = 0; a < 2; ++a)
#pragma unroll
                for (int b = 0; b < 2; ++b)
#pragma unroll
                    for (int m = 0; m < 4; ++m)
#pragma unroll
                        for (int n = 0; n < 2; ++n) { const v4i iv = __builtin_bit_cast(v4i, acc[a][b][m][n]); acc[a][b][m][n] = (f32x4){(float)iv[0], (float)iv[1], (float)iv[2], (float)iv[3]}; }
        }
        unsigned ro2 = 0u;
        if constexpr (GATHER) { if (has_nn) { int t4 = threadIdx.x; asm volatile("" : "+v"(t4)); ro2 = S.a_rowoff(nn, t4 & 255); } }
        f32x2 ksn = (f32x2){1.f, 1.f};
        if constexpr (KS) { if (has_next) { int t4 = threadIdx.x; asm volatile("" : "+v"(t4)); ksn = S.kscale(nxt, t4 & 255); } }
        { int t2 = threadIdx.x; asm volatile("" : "+v"(t2)); E(acc, cur, wr, wc, t2 & 15, (t2 & 63) >> 4); }
        if constexpr (KS) { if (has_next) { int t4 = threadIdx.x; asm volatile("" : "+v"(t4)); const float kr = fminf(ksn.x * __builtin_amdgcn_rcpf(ksn.y), 1000.0f); if (t4 < 256) kstab[(kpar ^ 1) * 256 + t4] = kr; } }
        if constexpr (GATHER) { if (has_nn) { asm volatile("" : "+v"(ro2)); int t4 = threadIdx.x; asm volatile("" : "+v"(t4)); if (t4 < 256) rowtab[PG8_NX1(PG8_NX1(par)) * 256 + t4] = ro2; } }
        if (!has_next) break;
#pragma unroll
        for (int a = 0; a < 2; ++a)
#pragma unroll
            for (int b = 0; b < 2; ++b)
#pragma unroll
                for (int m = 0; m < 4; ++m)
#pragma unroll
                    for (int n = 0; n < 2; ++n) acc[a][b][m][n] = (f32x4){0.f, 0.f, 0.f, 0.f};
        cur = nxt; cA = nA; cB = nB; ++ui; later = 1; asm volatile("" : "+s"(later));
        if constexpr (GATHER) par = PG8_NX1(par);
        if constexpr (KS) kpar ^= 1;
        if (wr == 1) PG8_BAR;
    }
    PG8_WAIT_V(0);
    PG8_BAR;
#undef PG8_NX1
#undef PG8_SA
#undef PG8_SB
#undef PG8_STAGEA
#undef PG8_STAGEB
#undef PG8_LDA
#undef PG8_LDB
#undef PG8_MMA
#undef PG8_WAIT_V
#undef PG8_WAIT_L
#undef PG8_BAR
#undef PG8_SCHED
}
}

constexpr int DM = 1024, NB = 8, SEQ = 4096, NTOK = NB * SEQ, NLAYER = 2;
constexpr int NIN = 6560, NINP = 6656;
constexpr int NWAVES = 8, NTHR = 512;
constexpr float EPSV = 1e-6f, LOG2E = 1.4426950408889634f;
constexpr float QA_SCALE = 0.125f * LOG2E;
constexpr float QC_SCALE = 0.10206207261596575f * LOG2E;
constexpr int LISTCAP = 16384, NLIST = 128;
constexpr int ACT_SH_ROW = 294912;

constexpr size_t MiB = 1u << 20;
constexpr size_t WS_ZERO = 0, ZERO_BYTES = 2 * MiB;
constexpr int CW_TMO = 0, CW_BAR = 4096, CW_GCNT = 8192;
constexpr size_t WS_ADA = 64 * 1024;
constexpr size_t WS_GVT = 1 * MiB, WS_GS2T = WS_GVT + 64 * 1024;
constexpr size_t WS_MISC = 2 * MiB;
constexpr size_t WS_ROPEC = WS_MISC, WS_ROPES = WS_MISC + 2 * MiB, WS_KRR = WS_MISC + 4 * MiB, WS_LSE = WS_MISC + 6 * MiB, WS_WK = WS_MISC + 8 * MiB;
constexpr size_t WS_SSQ = WS_MISC + 9 * MiB, WS_SSKV = WS_MISC + 10 * MiB + 512 * 1024;
constexpr size_t WS_SA = WS_MISC + 8 * MiB, WS_SA2 = WS_SA + 128 * 1024, WS_SWIN = WS_SA + 256 * 1024, WS_SSH13 = WS_SA + 288 * 1024, WS_SW13 = WS_SA + 320 * 1024;
constexpr size_t WS_SW2 = WS_SA + 448 * 1024, WS_SSH2 = WS_SW2 + 256 * 1024;
constexpr size_t WS_SACT = WS_KRR;
static_assert(WS_SSH2 + 4096 <= WS_SSQ && WS_SACT + 327680 * 8 <= WS_WK, "scale tables");
constexpr size_t WS_W = 14 * MiB;
constexpr size_t WO_WIN = 0, WO_WUQ = WO_WIN + (size_t)NINP * 1024 * 2, WO_WKV = WO_WUQ + 768 * 384 * 2, WO_WOA = WO_WKV + 1024 * 256 * 2, WO_WPB = WO_WOA + 1024 * 256 * 2,
                 WO_WOC = WO_WPB + 1024 * 512 * 2, WO_WOUT = WO_WOC + 1024 * 512 * 2, WO_SH13 = WO_WOUT + 1024 * 1024 * 2, WO_SH2 = WO_SH13 + 512 * 1024 * 2,
                 WO_RTH = WO_SH2 + 1024 * 256 * 2, WO_RTL = WO_RTH + 64 * 1024 * 2, WO_END = WO_RTL + 64 * 1024 * 2;
static_assert(WO_END <= 21 * MiB, "weight region");
constexpr size_t WS_X = 35 * MiB;
constexpr size_t WS_H = 163 * MiB;
constexpr size_t WS_Q = 99 * MiB, WS_H2 = 99 * MiB;
constexpr size_t WS_QKV = 195 * MiB;
constexpr size_t WS_G = 339 * MiB;
constexpr size_t WS_UB = 435 * MiB;
constexpr size_t WS_CQ = 467 * MiB;
constexpr size_t WS_CKV = 499 * MiB;
constexpr size_t WS_KV = 515 * MiB;
constexpr size_t WS_POOL = 579 * MiB;
constexpr size_t WS_WEXP13 = 131 * MiB, WS_WEXP2 = 163 * MiB;
constexpr size_t WS_ACT = 195 * MiB;
constexpr size_t WS_YH = 355 * MiB;
constexpr size_t WS_HIN = WS_H;
constexpr size_t WS_LISTS = 611 * MiB;
constexpr size_t WS_END = 627 * MiB;
constexpr size_t WS_SY = 99 * MiB;
constexpr size_t WS_XMX = WS_UB + 4 * MiB;
constexpr size_t WS_XSS = WS_UB;

constexpr int RING_BYTES = 131072;
constexpr int LDSCTL_OFF = RING_BYTES, MISC_OFF = LDSCTL_OFF + 320, MOE_OFF = LDSCTL_OFF + 1024;
static_assert(pg8::ROWTAB_OFF == LDSCTL_OFF + 4096 && pg8::ROWTAB_OFF + 4096 <= LDSCTL_OFF + 8192, "gathered-A row table (3 slots; the KS factors share its last KiB, never both in one phase) sits in the LDS control area below RMAX");
constexpr int LDS_BYTES = 147456;

#define XB_TMO      128
#define XB_XCNT(j)  (256  + 64 * (j))
#define XB_XSUB(j)  (1280 + 64 * (j))
#define XB_XGEN(j)  (2304 + 64 * (j))
#define XB_TOP      3328
#define XB_TOPGEN   3392
#define XCD_BAR_WORDS 3456
#define XB_SPIN_CAP (1u << 18)

__device__ __forceinline__ unsigned xb_ld(unsigned* p)              { return __hip_atomic_load(p, __ATOMIC_RELAXED, __HIP_MEMORY_SCOPE_AGENT); }
__device__ __forceinline__ unsigned xb_add(unsigned* p, unsigned v) { return __hip_atomic_fetch_add(p, v, __ATOMIC_RELAXED, __HIP_MEMORY_SCOPE_AGENT); }
__device__ __forceinline__ unsigned xb_xcc_id() { return (unsigned)__builtin_amdgcn_s_getreg((3 << 11) | 20) & 0xFu; }
#define XB_SPIN(cond, bar) do { unsigned _sp = 0; while (cond) { __builtin_amdgcn_s_sleep(1); \
    if ((++_sp & 255u) == 0u) { if (xb_ld(&(bar)[XB_TMO])) break; if (_sp > XB_SPIN_CAP) { atomicAdd(&(bar)[XB_TMO], 1u); break; } } } } while (0)

struct XcdBarrier {
    unsigned* bar; unsigned x;
    volatile LAS unsigned* st;
};

__device__ __forceinline__ XcdBarrier xcd_barrier_post(unsigned* bar, volatile LAS unsigned* st) {
    XcdBarrier b; b.bar = bar; b.x = xb_xcc_id(); b.st = st;
    if (threadIdx.x == 0) (void)xb_add(&bar[XB_XCNT(b.x)], 1u);
    return b;
}
__device__ __forceinline__ void xcd_barrier_complete(unsigned* bar, unsigned x, unsigned& nloc, unsigned& nx) {
    const unsigned G = gridDim.x * gridDim.y * gridDim.z;
    unsigned sum, cnt, mine, sp = 0u;
    for (;;) {
        sum = 0u; cnt = 0u; mine = 0u;
#pragma unroll
        for (unsigned j = 0; j < 16; ++j) { const unsigned c = xb_ld(&bar[XB_XCNT(j)]); sum += c; cnt += (c > 0u) ? 1u : 0u; mine = (j == x) ? c : mine; }
        if (sum == G) break;
        __builtin_amdgcn_s_sleep(1);
        if ((++sp & 255u) == 0u) { if (xb_ld(&bar[XB_TMO])) break; if (sp > XB_SPIN_CAP) { atomicAdd(&bar[XB_TMO], 1u); break; } }
    }
    nloc = mine > 0u ? mine : 1u; nx = cnt > 0u ? cnt : 1u;
}

__device__ __forceinline__ void xcd_barrier(const XcdBarrier& b) {
    asm volatile("s_waitcnt vmcnt(0)" ::: "memory");
    __syncthreads();
    if (threadIdx.x == 0) {
        unsigned* bar = b.bar;
        __builtin_amdgcn_s_waitcnt(0);
        unsigned nloc = b.st[0], nx = b.st[1];
        if (nloc == 0u) { xcd_barrier_complete(bar, b.x, nloc, nx); b.st[0] = nloc; b.st[1] = nx; }
        const unsigned old = xb_add(&bar[XB_XSUB(b.x)], 1u);
        const unsigned gen = old / nloc;
        if (old + 1u == (gen + 1u) * nloc) {
            __builtin_amdgcn_fence(__ATOMIC_RELEASE, "agent");
            asm volatile("s_waitcnt vmcnt(0)" ::: "memory");
            const unsigned og = xb_add(&bar[XB_TOP], 1u);
            const unsigned tg = og / nx;
            if (og + 1u == (tg + 1u) * nx) xb_add(&bar[XB_TOPGEN], 1u);
            else XB_SPIN(xb_ld(&bar[XB_TOPGEN]) == tg, bar);
            __builtin_amdgcn_fence(__ATOMIC_ACQUIRE, "agent");
            xb_add(&bar[XB_XGEN(b.x)], 1u);
            asm volatile("s_waitcnt vmcnt(0)" ::: "memory");
        } else {
            XB_SPIN(xb_ld(&bar[XB_XGEN(b.x)]) == gen, bar);
            __builtin_amdgcn_fence(__ATOMIC_ACQUIRE, "agent");
            asm volatile("s_waitcnt vmcnt(0)" ::: "memory");
        }
    }
    __syncthreads();
}


struct Args { const float* in[29]; const int* pos; float* out; unsigned char* ws; int ph_lo, ph_hi; };

struct Frame {
    LAS unsigned char* lds;
    unsigned* ctl; unsigned char* ws;
    int tid, lane, wave, G, bid;
};

__device__ __forceinline__ const float* ada_acc(const Frame& F, int j, int b) { return (const float*)(F.ws + WS_ADA) + ((size_t)j * NB + b) * 3072; }
__device__ __forceinline__ const float* ada_bias(const Args& A, int j) { return ((j & 1) ? A.in[18] : A.in[4]) + (size_t)(j >> 1) * 3072; }

template <int MODE>
__device__ __forceinline__ void tr_item_t(const float* src, int lds_n, int k0, int scol0, const float* kscale, bf16* dst, bf16* dst_lo, int ldd, int drow0, LAS float* scr, int lane, float mul = 1.0f) {
    const int lk = lane >> 3, ln4 = (lane & 7) * 4;
    f32x4 v[8];
#pragma unroll
    for (int i = 0; i < 8; ++i) { v[i] = (f32x4){0.f, 0.f, 0.f, 0.f};
        if (scol0 >= 0) { v[i] = *(const f32x4*)(src + (size_t)(k0 + 8 * i + lk) * lds_n + scol0 + ln4); if (kscale) v[i] = v[i] * kscale[k0 + 8 * i + lk]; } }
#pragma unroll
    for (int i = 0; i < 8; ++i)
#pragma unroll
        for (int c = 0; c < 4; ++c) scr[(ln4 + c) * 65 + 8 * i + lk] = v[i][c];
    LDS_WAIT(); asm volatile("" ::: "memory");
    const int rn = lane & 7, kc = lane >> 3;
#pragma unroll
    for (int j = 0; j < 4; ++j) { const LAS float* s = scr + (rn + 8 * j) * 65 + 8 * kc; float f[8];
#pragma unroll
        for (int q = 0; q < 8; ++q) f[q] = s[q];
        if (MODE == 2) { v2u o; o.x = pk4_fp8(f[0] * mul, f[1] * mul, f[2] * mul, f[3] * mul); o.y = pk4_fp8(f[4] * mul, f[5] * mul, f[6] * mul, f[7] * mul);
            *(v2u*)((unsigned char*)dst + (size_t)(drow0 + rn + 8 * j) * ldd + k0 + 8 * kc) = o; }
        else if (MODE == 0) { v4u o; o.x = pk2(f[0], f[1]); o.y = pk2(f[2], f[3]); o.z = pk2(f[4], f[5]); o.w = pk2(f[6], f[7]);
            *(v4u*)(dst + (size_t)(drow0 + rn + 8 * j) * ldd + k0 + 8 * kc) = o; }
        else { unsigned h[8]; float lo[8];
#pragma unroll
            for (int q = 0; q < 8; ++q) { h[q] = f2bf(f[q]); lo[q] = f[q] - bf2f(h[q]); }
            v4u o; o.x = h[0] | (h[1] << 16); o.y = h[2] | (h[3] << 16); o.z = h[4] | (h[5] << 16); o.w = h[6] | (h[7] << 16);
            *(v4u*)(dst + (size_t)(drow0 + rn + 8 * j) * ldd + k0 + 8 * kc) = o;
            v4u p; p.x = pk2(lo[0], lo[1]); p.y = pk2(lo[2], lo[3]); p.z = pk2(lo[4], lo[5]); p.w = pk2(lo[6], lo[7]);
            *(v4u*)(dst_lo + (size_t)(drow0 + rn + 8 * j) * ldd + k0 + 8 * kc) = p; } }
    LDS_WAIT(); asm volatile("" ::: "memory");
}
__device__ __forceinline__ void tr_item(const float* src, int lds_n, int k0, int scol0, const float* kscale, bf16* dst, int ldd, int drow0, LAS float* scr, int lane) {
    tr_item_t<0>(src, lds_n, k0, scol0, kscale, dst, nullptr, ldd, drow0, scr, lane); }
__device__ __forceinline__ void tr_item_fp8(const float* src, int lds_n, int k0, int scol0, unsigned char* dst, int ldd, int drow0, LAS float* scr, int lane, float mul) {
    tr_item_t<2>(src, lds_n, k0, scol0, nullptr, (bf16*)dst, nullptr, ldd, drow0, scr, lane, mul); }
__device__ __forceinline__ void tr_item_hilo(const float* src, int lds_n, int k0, int scol0, bf16* dhi, bf16* dlo, int ldd, int drow0, LAS float* scr, int lane) {
    tr_item_t<1>(src, lds_n, k0, scol0, nullptr, dhi, dlo, ldd, drow0, scr, lane); }

__device__ __forceinline__ void tr_cols_i8_wg(const float* src, int lds_n, int scol0, unsigned char* dst, int ldd, int drow0, float* scale_out, LAS float* scr, LAS float* CM, int wave, int lane) {
    const int lk = lane >> 3, ln4 = (lane & 7) * 4, kw = wave * 128;
    f32x4 v[16];
#pragma unroll
    for (int i = 0; i < 16; ++i) { v[i] = (f32x4){0.f, 0.f, 0.f, 0.f}; if (scol0 >= 0) v[i] = *(const f32x4*)(src + (size_t)(kw + 8 * i + lk) * lds_n + scol0 + ln4); }
    f32x4 mx = (f32x4){0.f, 0.f, 0.f, 0.f};
#pragma unroll
    for (int i = 0; i < 16; ++i) { mx[0] = fmaxf(mx[0], fabsf(v[i][0])); mx[1] = fmaxf(mx[1], fabsf(v[i][1])); mx[2] = fmaxf(mx[2], fabsf(v[i][2])); mx[3] = fmaxf(mx[3], fabsf(v[i][3])); }
#pragma unroll
    for (int o = 8; o < 64; o <<= 1) { mx[0] = fmaxf(mx[0], __shfl_xor(mx[0], o)); mx[1] = fmaxf(mx[1], __shfl_xor(mx[1], o)); mx[2] = fmaxf(mx[2], __shfl_xor(mx[2], o)); mx[3] = fmaxf(mx[3], __shfl_xor(mx[3], o)); }
    __syncthreads();
    if (lk == 0) *(LAS f32x4*)(CM + wave * 32 + ln4) = mx;
    __syncthreads();
    f32x4 m = *(const LAS f32x4*)(CM + ln4);
#pragma unroll
    for (int w = 1; w < 8; ++w) { const f32x4 t = *(const LAS f32x4*)(CM + w * 32 + ln4); m[0] = fmaxf(m[0], t[0]); m[1] = fmaxf(m[1], t[1]); m[2] = fmaxf(m[2], t[2]); m[3] = fmaxf(m[3], t[3]); }
    f32x4 inv;
#pragma unroll
    for (int cc = 0; cc < 4; ++cc) { const float mm = fmaxf(m[cc], 1e-30f); inv[cc] = (scol0 >= 0) ? 127.0f / mm : 0.f; }
    if (wave == 0 && lk == 0) *(f32x4*)(scale_out + drow0 + ln4) = (scol0 >= 0) ? (f32x4){fmaxf(m[0], 1e-30f), fmaxf(m[1], 1e-30f), fmaxf(m[2], 1e-30f), fmaxf(m[3], 1e-30f)} * (1.0f / 127.0f) : (f32x4){1.f, 1.f, 1.f, 1.f};
    const int rn = lane & 7, kc = lane >> 3;
#pragma unroll
    for (int h = 0; h < 2; ++h) {
#pragma unroll
        for (int i = 0; i < 8; ++i)
#pragma unroll
            for (int cc = 0; cc < 4; ++cc) scr[(ln4 + cc) * 65 + 8 * i + lk] = v[8 * h + i][cc] * inv[cc];
        LDS_WAIT(); asm volatile("" ::: "memory");
#pragma unroll
        for (int j = 0; j < 4; ++j) { const LAS float* s = scr + (rn + 8 * j) * 65 + 8 * kc;
            v2u o; o.x = pk4_i8(s[0], s[1], s[2], s[3], 1.0f); o.y = pk4_i8(s[4], s[5], s[6], s[7], 1.0f);
            *(v2u*)(dst + (size_t)(drow0 + rn + 8 * j) * ldd + kw + 64 * h + 8 * kc) = o; }
        LDS_WAIT(); asm volatile("" ::: "memory");
    }
}

__device__ __forceinline__ void tr_cols_i8_k256(const float* src, int lds_n, int scol0, unsigned char* dst, int drow0, float* scale_out, LAS float* scr, int lane) {
    const int lk = lane >> 3, ln4 = (lane & 7) * 4;
    f32x4 v[32];
#pragma unroll
    for (int i = 0; i < 32; ++i) v[i] = *(const f32x4*)(src + (size_t)(8 * i + lk) * lds_n + scol0 + ln4);
    f32x4 mx = (f32x4){0.f, 0.f, 0.f, 0.f};
#pragma unroll
    for (int i = 0; i < 32; ++i) { mx[0] = fmaxf(mx[0], fabsf(v[i][0])); mx[1] = fmaxf(mx[1], fabsf(v[i][1])); mx[2] = fmaxf(mx[2], fabsf(v[i][2])); mx[3] = fmaxf(mx[3], fabsf(v[i][3])); }
#pragma unroll
    for (int o = 8; o < 64; o <<= 1) { mx[0] = fmaxf(mx[0], __shfl_xor(mx[0], o)); mx[1] = fmaxf(mx[1], __shfl_xor(mx[1], o)); mx[2] = fmaxf(mx[2], __shfl_xor(mx[2], o)); mx[3] = fmaxf(mx[3], __shfl_xor(mx[3], o)); }
    f32x4 inv;
#pragma unroll
    for (int cc = 0; cc < 4; ++cc) { mx[cc] = fmaxf(mx[cc], 1e-30f); inv[cc] = 127.0f / mx[cc]; }
    if (lk == 0) *(f32x4*)(scale_out + drow0 + ln4) = mx * (1.0f / 127.0f);
    const int rn = lane & 7, kc = lane >> 3;
#pragma unroll
    for (int h = 0; h < 4; ++h) {
#pragma unroll
        for (int i = 0; i < 8; ++i)
#pragma unroll
            for (int cc = 0; cc < 4; ++cc) scr[(ln4 + cc) * 65 + 8 * i + lk] = v[8 * h + i][cc] * inv[cc];
        LDS_WAIT(); asm volatile("" ::: "memory");
#pragma unroll
        for (int j = 0; j < 4; ++j) { const LAS float* s = scr + (rn + 8 * j) * 65 + 8 * kc;
            v2u o; o.x = pk4_i8(s[0], s[1], s[2], s[3], 1.0f); o.y = pk4_i8(s[4], s[5], s[6], s[7], 1.0f);
            *(v2u*)(dst + (size_t)(drow0 + rn + 8 * j) * 256 + 64 * h + 8 * kc) = o; }
        LDS_WAIT(); asm volatile("" ::: "memory");
    }
}

__device__ __forceinline__ void sincos_d(float angf, float& s, float& c) {
    const double a = (double)angf;
    const double q = __builtin_rint(a * 0.63661977236758134308);
    double r = __builtin_fma(-q, 1.57079632679489655800e+00, a);
    r = __builtin_fma(-q, 6.12323399573676603587e-17, r);
    const double r2 = r * r;
    double sp = -2.50521083854417187751e-08;
    sp = __builtin_fma(sp, r2, 2.75573192239858906526e-06);
    sp = __builtin_fma(sp, r2, -1.98412698412698412698e-04);
    sp = __builtin_fma(sp, r2, 8.33333333333333333333e-03);
    sp = __builtin_fma(sp, r2, -1.66666666666666666667e-01);
    const double sr = __builtin_fma(sp * r2, r, r);
    double cp = 2.08767569878680989792e-09;
    cp = __builtin_fma(cp, r2, -2.75573192239858906526e-07);
    cp = __builtin_fma(cp, r2, 2.48015873015873015873e-05);
    cp = __builtin_fma(cp, r2, -1.38888888888888888889e-03);
    cp = __builtin_fma(cp, r2, 4.16666666666666666667e-02);
    cp = __builtin_fma(cp, r2, -0.5);
    const double cr = __builtin_fma(cp, r2, 1.0);
    const int qi = (int)q & 3;
    const double ss = (qi == 0) ? sr : (qi == 1) ? cr : (qi == 2) ? -sr : -cr;
    const double cc = (qi == 0) ? cr : (qi == 1) ? -sr : (qi == 2) ? -cr : sr;
    s = (float)ss; c = (float)cc;
}

__constant__ float ROPE_FREQ[16] = {1.0f, 0.5623413324356079f, 0.3162277638912201f, 0.17782793939113617f, 0.10000000149011612f, 0.05623413249850273f, 0.03162277489900589f, 0.017782794311642647f,
    0.009999999776482582f, 0.005623413249850273f, 0.003162277629598975f, 0.0017782794311642647f, 0.0010000000474974513f, 0.000562341301701963f, 0.0003162277571391314f, 0.00017782794020604342f};
__device__ __forceinline__ void p0_phase(const Frame& F, const Args& A) {
    LAS float* sc = (LAS float*)F.lds;
    const float* c = A.in[1];
    for (int i = F.tid; i < NB * DM; i += NTHR) { const float v = c[i]; sc[i] = v / (1.0f + __expf(-v)); }
    __syncthreads();
    float* ada = (float*)(F.ws + WS_ADA);
    for (int item = F.bid; item < 4 * 48; item += F.G) {
        const int j = item / 48, n = (item % 48) * 64 + (F.tid & 63), b = F.tid >> 6;
        const float* w = ((j & 1) ? A.in[17] : A.in[3]) + (size_t)(j >> 1) * DM * 3072 + n;
        float a0 = 0.f, a1 = 0.f, a2 = 0.f, a3 = 0.f;
        for (int k = 0; k < DM; k += 4) {
            a0 += sc[b * DM + k] * w[(size_t)k * 3072]; a1 += sc[b * DM + k + 1] * w[(size_t)(k + 1) * 3072];
            a2 += sc[b * DM + k + 2] * w[(size_t)(k + 2) * 3072]; a3 += sc[b * DM + k + 3] * w[(size_t)(k + 3) * 3072]; }
        ada[((size_t)j * NB + b) * 3072 + n] = (a0 + a1) + (a2 + a3);
    }
    float* rc = (float*)(F.ws + WS_ROPEC); float* rs = (float*)(F.ws + WS_ROPES);
    for (int idx = F.bid * NTHR + F.tid; idx < NTOK * 16; idx += F.G * NTHR) {
        const int tok = idx >> 4, i = idx & 15;
        const float freq = ROPE_FREQ[i];
        const float ang = (float)A.pos[tok] * freq;
        float s, cc; sincos_d(ang, s, cc); rc[idx] = cc; rs[idx] = s;
    }
}

__device__ __forceinline__ int map_win(int n) {
    return n < 3200 ? n : n < 3232 ? 3456 + (n - 3200) : n < 3328 ? -1 : n < 3584 ? 3200 + (n - 3328) : 3488 + (n - 3584);
}
__device__ __forceinline__ void norm_tables(const Frame& F, const Args& A, int j, const float* g, int b0, int nb, LAS float* GS, LAS float* SH) {
    const float* bias = ada_bias(A, j);
    for (int i = F.tid; i < nb * DM; i += NTHR) { const int b = i >> 10, k = i & 1023; const float* acc = ada_acc(F, j, b0 + b);
        GS[i] = g[k] * (1.0f + acc[1024 + k] + bias[1024 + k]); SH[i] = acc[k] + bias[k]; }
}
__device__ __forceinline__ void ada_tables(const Frame& F, const Args& A) {
    float* GV = (float*)(F.ws + WS_GVT); float* GS2 = (float*)(F.ws + WS_GS2T);
    for (int i = F.bid * NTHR + F.tid; i < NLAYER * NB * DM; i += F.G * NTHR) { const int l = i >> 13, b = (i >> 10) & 7, k = i & 1023;
        GV[i] = ada_acc(F, l * 2, b)[2048 + k] + ada_bias(A, l * 2)[2048 + k];
        GS2[i] = A.in[19][l * DM + k] * (1.0f + ada_acc(F, l * 2 + 1, b)[1024 + k] + ada_bias(A, l * 2 + 1)[1024 + k]); }
}
__device__ __forceinline__ void norm_rows(const Frame& F, const Args& A, const float* x, int j, const float* g, unsigned char* H) {
    LAS float* GS = (LAS float*)F.lds; LAS float* SH = GS + NB * DM;
    __syncthreads();
    norm_tables(F, A, j, g, 0, NB, GS, SH);
    __syncthreads();
    const int gw = F.bid * NWAVES + F.wave, NGW = F.G * NWAVES;
    for (int m0 = gw * 4; m0 < NTOK; m0 += NGW * 4) {
        f32x4 v[4][4];
#pragma unroll
        for (int r = 0; r < 4; ++r) { const f32x4* xr = (const f32x4*)(x + (size_t)(m0 + r) * DM) + F.lane;
#pragma unroll
            for (int q = 0; q < 4; ++q) v[r][q] = xr[64 * q]; }
#pragma unroll
        for (int r = 0; r < 4; ++r) { const int m = m0 + r, b = m >> 12; float s = 0.f;
#pragma unroll
            for (int q = 0; q < 4; ++q) s += (v[r][q].x * v[r][q].x + v[r][q].y * v[r][q].y) + (v[r][q].z * v[r][q].z + v[r][q].w * v[r][q].w);
            const float rstd = 1.0f / sqrtf(wave_sum(s) * (1.0f / DM) + EPSV);
            f32x4 h[4]; float am = 0.f;
#pragma unroll
            for (int q = 0; q < 4; ++q) { const int col = 4 * F.lane + 256 * q;
                h[q] = (v[r][q] * rstd) * *(LAS const f32x4*)(GS + b * DM + col) + *(LAS const f32x4*)(SH + b * DM + col);
                am = fmaxf(am, fmaxf(fmaxf(fabsf(h[q].x), fabsf(h[q].y)), fmaxf(fabsf(h[q].z), fabsf(h[q].w)))); }
            if (FP8_T1) { am = fmaxf(wave_max(am), 1e-20f); const float inv = 127.0f / am; if (F.lane == 0) ((float*)(F.ws + WS_SA))[m] = am * (1.0f / 127.0f);
                unsigned* o4 = (unsigned*)(H + (size_t)m * DM) + F.lane;
#pragma unroll
                for (int q = 0; q < 4; ++q) o4[64 * q] = pk4_i8(h[q].x, h[q].y, h[q].z, h[q].w, inv); }
            else {
#pragma unroll
                for (int q = 0; q < 4; ++q) ((unsigned long long*)(H + (size_t)m * DM * 2) + F.lane)[64 * q] = (unsigned long long)pk2(h[q].x, h[q].y) | ((unsigned long long)pk2(h[q].z, h[q].w) << 32); } }
    }
}
__device__ __forceinline__ void convert_layer_weights(const Frame& F, const Args& A, int layer) {
    bf16* Wb = (bf16*)(F.ws + WS_W);
    LAS float* scr = (LAS float*)(F.lds + F.wave * 16384);
    const int gw = F.bid * NWAVES + F.wave, NGW = F.G * NWAVES;
    const float* w_in = A.in[6] + (size_t)layer * DM * NIN;
    const float* w_uq = A.in[11] + (size_t)layer * 384 * 768;   const float* cq_g = A.in[9] + layer * 384;
    const float* w_ukv = A.in[12] + (size_t)layer * 256 * 1024; const float* ckv_g = A.in[10] + layer * 256;
    const float* w_oa = A.in[13] + (size_t)layer * 256 * 1024;
    const float* w_ob = A.in[14] + (size_t)layer * 512 * 1024;
    const float* w_oc = A.in[15] + (size_t)layer * 512 * 1024;
    const float* w_out = A.in[16] + (size_t)layer * 1024 * 1024;
    const float* rt_w = A.in[20] + (size_t)layer * 1024 * 64;
    const float* sh1 = A.in[25] + (size_t)layer * 1024 * 256; const float* sh3 = A.in[26] + (size_t)layer * 1024 * 256; const float* sh2 = A.in[27] + (size_t)layer * 256 * 1024;
    constexpr int I_WIN = FP8_T1 ? 0 : 208 * 16, I_WUQ = 24 * 6, I_WKV = 32 * 4, I_WOA = 32 * 4, I_WOC = 32 * 8, I_WOUT = 32 * 16, I_SH13 = FP8_F2 ? 0 : 16 * 16, I_SH2 = 32, I_RT = 2 * 16;
    constexpr int NITEMS = I_WIN + I_WUQ + I_WKV + I_WOA + I_WOC + I_WOUT + I_SH13 + I_SH2 + I_RT;
    { LAS float* CM = (LAS float*)(F.lds + 12288);
      for (int it = F.bid; it < (FP8_T1 ? 208 : 0) + (FP8_F2 ? 16 : 0); it += F.G) {
        if (FP8_T1 && it < 208) tr_cols_i8_wg(w_in, NIN, map_win(it * 32), (unsigned char*)Wb + WO_WIN, 1024, it * 32, (float*)(F.ws + WS_SWIN), scr, CM, F.wave, F.lane);
        else { const int n0 = (it - (FP8_T1 ? 208 : 0)) * 32, hh = n0 >> 8, rr = n0 & 255;
            tr_cols_i8_wg(rr < 128 ? sh1 : sh3, 256, hh * 128 + (rr & 127), (unsigned char*)Wb + WO_SH13, 1024, n0, (float*)(F.ws + WS_SSH13), scr, CM, F.wave, F.lane); } }
      __syncthreads(); }
    for (int it = gw; it < NITEMS; it += NGW) {
        int r = it;
        if (r < I_WIN) { const int kb = r / 208, nb = r % 208; tr_item(w_in, NIN, kb * 64, map_win(nb * 32), nullptr, (bf16*)((char*)Wb + WO_WIN), 1024, nb * 32, scr, F.lane); continue; } r -= I_WIN;
        if (r < I_WUQ) { const int kb = r / 24, nb = r % 24; tr_item(w_uq, 768, kb * 64, nb * 32, cq_g, (bf16*)((char*)Wb + WO_WUQ), 384, nb * 32, scr, F.lane); continue; } r -= I_WUQ;
        if (r < I_WKV) { const int kb = r / 32, nb = r % 32; tr_item(w_ukv, 1024, kb * 64, nb * 32, ckv_g, (bf16*)((char*)Wb + WO_WKV), 256, nb * 32, scr, F.lane); continue; } r -= I_WKV;
        if (r < I_WOA) { const int kb = r / 32, nb = r % 32; tr_item(w_oa, 1024, kb * 64, nb * 32, nullptr, (bf16*)((char*)Wb + WO_WOA), 256, nb * 32, scr, F.lane); continue; } r -= I_WOA;
        if (r < I_WOC) { const int kb = r / 32, nb = r % 32; tr_item(w_oc, 1024, kb * 64, nb * 32, nullptr, (bf16*)((char*)Wb + WO_WOC), 512, nb * 32, scr, F.lane); continue; } r -= I_WOC;
        if (r < I_WOUT) { const int kb = r / 32, nb = r % 32; tr_item(w_out, 1024, kb * 64, nb * 32, nullptr, (bf16*)((char*)Wb + WO_WOUT), 1024, nb * 32, scr, F.lane); continue; } r -= I_WOUT;
        if (r < I_SH13) { const int kb = r / 16, nb = r % 16, n0 = nb * 32, hh = n0 >> 8, rr = n0 & 255;
            tr_item(rr < 128 ? sh1 : sh3, 256, kb * 64, hh * 128 + (rr & 127), nullptr, (bf16*)((char*)Wb + WO_SH13), 1024, n0, scr, F.lane); continue; } r -= I_SH13;
        if (r < I_SH2) { tr_cols_i8_k256(sh2, 1024, r * 32, (unsigned char*)Wb + WO_SH2, r * 32, (float*)(F.ws + WS_SSH2), scr, F.lane); continue; } r -= I_SH2;
        { const int kb = r / 2, nb = r % 2; tr_item_hilo(rt_w, 64, kb * 64, nb * 32, (bf16*)((char*)Wb + WO_RTH), (bf16*)((char*)Wb + WO_RTL), 1024, nb * 32, scr, F.lane); }
    }
    { const float* pw = A.in[7] + (size_t)layer * 4 * 128 * 128; const float* ps = A.in[8] + layer * 512; bf16* WPB = (bf16*)((char*)Wb + WO_WPB);
      for (int it = gw; it < 4 * 16 * 16; it += NGW) {
        const int g = it >> 8, c8 = (it >> 4) & 15, n = (it & 15) * 64 + F.lane;
        float pv[8][2];
#pragma unroll
        for (int q = 0; q < 8; ++q)
#pragma unroll
            for (int h = 0; h < 2; ++h) pv[q][h] = pw[((size_t)g * 128 + c8 * 8 + q) * 128 + h * 64 + F.lane] * ps[g * 128 + h * 64 + F.lane];
        float acc[8];
#pragma unroll
        for (int q = 0; q < 8; ++q) acc[q] = 0.f;
#pragma unroll
        for (int h = 0; h < 2; ++h)
#pragma unroll 16
            for (int dd = 0; dd < 64; ++dd) { const float wv = w_ob[(size_t)(g * 128 + h * 64 + dd) * 1024 + n];
#pragma unroll
                for (int q = 0; q < 8; ++q) acc[q] += __builtin_bit_cast(float, __builtin_amdgcn_readlane(__builtin_bit_cast(int, pv[q][h]), dd)) * wv; }
        v4u o; o.x = pk2(acc[0], acc[1]); o.y = pk2(acc[2], acc[3]); o.z = pk2(acc[4], acc[5]); o.w = pk2(acc[6], acc[7]);
        *(v4u*)(WPB + (size_t)n * 512 + g * 128 + c8 * 8) = o; } }
}

struct SchedDense {
    unsigned A, Bt; int lda, ldb; int nM, nN, nwg, G, c, es; int nr = 0, rot = 0;
    __device__ __forceinline__ void init(size_t A_, size_t Bt_, int lda_, int ldb_, int M, int N, int G_, int c_, int es_ = 2) { A = (unsigned)A_; Bt = (unsigned)Bt_; lda = lda_; ldb = ldb_; es = es_; nM = M / 256; nN = N / 256; nwg = nM * nN; G = G_; c = c_; nr = 0; rot = 0; }
    __device__ __forceinline__ void rotate() { if (nwg % G == 0) { nr = nwg / G; rot = ((c & 7) * nr) >> 3; } }
    __device__ __forceinline__ bool next(int i, pg8::Unit& u) const {
        if (nr) { if (i >= nr) return false; i += rot; if (i >= nr) i -= nr; }
        const long L = (long)i * G + c; if (L >= nwg) return false;
        int wgid = (int)L; { const int q = nwg / 8, r = nwg % 8, xcd = wgid % 8, off = wgid / 8; wgid = (xcd < r ? xcd * (q + 1) : r * (q + 1) + (xcd - r) * q) + off; }
        const int nig = 8 * nN, gid = wgid / nig, fm = gid * 8, gsz = (nM - fm) < 8 ? (nM - fm) : 8;
        u.pm = fm + ((wgid % nig) % gsz); u.pn = (wgid % nig) / gsz; u.e = 0; u.aux = 0; return true;
    }
    __device__ __forceinline__ unsigned a_off(const pg8::Unit& u) const { return A + (unsigned)u.pm * 256u * lda * es; }
    __device__ __forceinline__ unsigned b_off(const pg8::Unit& u) const { return Bt + (unsigned)u.pn * 256u * ldb * es; }
    __device__ __forceinline__ unsigned a_rowoff(const pg8::Unit&, int) const { return 0u; }
};

#define OPAQUE_V(v) asm volatile("" : "+v"(v))
struct EpiWin {
    PG8_USE_PERM(Perm8)
    bf16 *QKV, *UB, *CQ, *CKV, *GT; float *SSQ, *SSKV; int dry; const float *SA, *SW;
    __device__ __forceinline__ void operator()(f32x4 (&acc)[2][2][4][2], const pg8::Unit& u, int wr, int wc, int fr, int fq) const {
        if (dry) { float s = 0.f;
#pragma unroll
            for (int ai = 0; ai < 2; ++ai)
#pragma unroll
                for (int m = 0; m < 4; ++m) s += acc[ai][0][m][0][0] + acc[ai][1][m][1][3];
            if (s == 1.2345e-33f) SSQ[0] = 1.f; return; }
        const int pn = u.pn, rowU = u.pm * 256 + wr * 64;
        bf16* base; int pitch, colt, mode = 0; float scl = 1.f; float* ss = nullptr; int ssb = 2, sspitch = 12, ssslot = 0;
        if (pn < 9) { base = QKV; pitch = 2304; colt = pn * 256; if (pn < 3) scl = QA_SCALE; }
        else if (pn < 11) { base = UB; pitch = 512; colt = (pn - 9) * 256; }
        else if (pn < 13) { base = CQ; pitch = 512; colt = (pn - 11) * 256; ss = SSQ; ssb = (pn == 11) ? 2 : 1; ssslot = (pn == 11) ? 0 : 8; }
        else if (pn == 13) { base = CKV; pitch = 256; colt = 0; ss = SSKV; sspitch = 8; }
        else { base = GT; pitch = 3072; colt = (pn - 14) * 256; mode = 1; }
        const unsigned esz = (mode == 1) ? 1u : 2u;
        unsigned lo = (unsigned)(fr * pitch + 8 * fq) * esz; OPAQUE_V(lo);
        unsigned lr4 = (unsigned)fr * 4u; OPAQUE_V(lr4); unsigned lc4 = (unsigned)(8 * fq) * 4u; OPAQUE_V(lc4);
        f32x4 sw[2][2];
#pragma unroll
        for (int bj = 0; bj < 2; ++bj) { const char* sp = (const char*)(SW + pn * 256 + bj * 128 + wc * 32) + lc4; sw[bj][0] = SA ? *(const f32x4*)sp : (f32x4){1.f, 1.f, 1.f, 1.f}; sw[bj][1] = SA ? *(const f32x4*)(sp + 16) : (f32x4){1.f, 1.f, 1.f, 1.f}; }
        char* ub = (char*)base + ((size_t)rowU * pitch + colt + wc * 32) * esz;
        const bool slab = pn < 9; const int ld2 = 2 * (pn % 3);
        unsigned lo2 = 0u;
        if (slab) { const unsigned lrw = (ld2 == 0) ? (unsigned)fr : (ld2 == 2) ? (unsigned)((fr & 3) * 1024 + (fr >> 2)) : (unsigned)(fr * 256); lo2 = lrw * 128u + (unsigned)(((wc & 1) * 32 + 8 * fq) * 2); OPAQUE_V(lo2); }
        unsigned ll4 = (unsigned)(fq * 16 + fr) * 4u; OPAQUE_V(ll4);
        float sah[2];
#pragma unroll
        for (int ai = 0; ai < 2; ++ai) sah[ai] = SA ? *(const float*)((const char*)(SA + rowU + ai * 128) + ll4) : 1.f;
#pragma unroll
        for (int ai = 0; ai < 2; ++ai)
#pragma unroll
            for (int bj = 0; bj < 2; ++bj)
#pragma unroll
                for (int m = 0; m < 4; ++m) { acc[ai][bj][m][0] = acc[ai][bj][m][0] * sw[bj][0]; acc[ai][bj][m][1] = acc[ai][bj][m][1] * sw[bj][1]; }
#pragma unroll
        for (int ai = 0; ai < 2; ++ai)
#pragma unroll
            for (int m = 0; m < 4; ++m) { char* rb = ub + (size_t)(ai * 128 + m * 16) * pitch * esz; float sq[2] = {0.f, 0.f};
                const float sa = __shfl(sah[ai], m * 16 + fr);
#pragma unroll
                for (int bj = 0; bj < 2; ++bj) { f32x4 v0 = acc[ai][bj][m][0] * sa, v1 = acc[ai][bj][m][1] * sa;
                    sq[bj] = (v0[0] * v0[0] + v0[1] * v0[1]) + (v0[2] * v0[2] + v0[3] * v0[3]) + (v1[0] * v1[0] + v1[1] * v1[1]) + (v1[2] * v1[2] + v1[3] * v1[3]);
                    if (mode == 1) {
                        unsigned q0[4], q1[4];
#pragma unroll
                        for (int q = 0; q < 4; ++q) { q0[q] = (unsigned)fmaxf(fsigmoid(v0[q]) * 255.0f + 0.5f, 1.0f); q1[q] = (unsigned)fmaxf(fsigmoid(v1[q]) * 255.0f + 0.5f, 1.0f); }
                        v2u w8; w8.x = q0[0] | (q0[1] << 8) | (q0[2] << 16) | (q0[3] << 24); w8.y = q1[0] | (q1[1] << 8) | (q1[2] << 16) | (q1[3] << 24);
                        *(v2u*)(rb + bj * 128 + lo) = w8; continue; }
                    v0 = v0 * scl; v1 = v1 * scl;
                    v4u w; w.x = cvt_pk_bf16(v0[0], v0[1]); w.y = cvt_pk_bf16(v0[2], v0[3]); w.z = cvt_pk_bf16(v1[0], v1[1]); w.w = cvt_pk_bf16(v1[2], v1[3]);
                    if (slab) { const int r16 = rowU + ai * 128 + m * 16; const size_t tb = (size_t)((r16 & ~4095) + ((r16 & 4095) >> ld2));
                        *(v4u*)((char*)QKV + ((size_t)(pn * 4 + bj * 2 + (wc >> 1)) * NTOK + tb) * 128 + lo2) = w; }
                    else *(v4u*)(rb + bj * 256 + lo) = w; }
                if (ss) {
#pragma unroll
                    for (int bj = 0; bj < 2; ++bj) { float s = sq[bj]; s += __shfl_xor(s, 16); s += __shfl_xor(s, 32);
                        if (fq == 0 && bj < ssb) ss[(size_t)(rowU + ai * 128 + m * 16 + fr) * sspitch + ssslot + 4 * bj + wc] = s; } } }
    }
};
struct EpiQ {
    PG8_USE_PERM(Perm8)
    bf16* Q; const float* SSQ; const float *RC, *RS;
    __device__ __forceinline__ void operator()(const f32x4 (&acc)[2][2][4][2], const pg8::Unit& u, int wr, int wc, int fr, int fq) const {
        const int rowU = u.pm * 256 + wr * 64;
        unsigned lo = (unsigned)(fr * 768 + 8 * fq) * 2u; OPAQUE_V(lo);
        unsigned lr = (unsigned)fr * 48u; OPAQUE_V(lr);
        unsigned lt = (unsigned)(fr * 16 + 8 * (fq & 1)) * 4u; OPAQUE_V(lt);
        char* ub = (char*)Q + ((size_t)rowU * 768 + u.pn * 256 + wc * 32) * 2;
        float rsh[2];
        { unsigned ll = (unsigned)(fq * 16 + fr) * 48u; OPAQUE_V(ll); f32x4 pa[2], pb[2], pc[2];
#pragma unroll
          for (int ai = 0; ai < 2; ++ai) { const f32x4* sp = (const f32x4*)((const char*)(SSQ + (size_t)(rowU + ai * 128) * 12) + ll); pa[ai] = sp[0]; pb[ai] = sp[1]; pc[ai] = sp[2]; }
#pragma unroll
          for (int ai = 0; ai < 2; ++ai) { const float ssum = (((pa[ai][0] + pa[ai][1]) + (pa[ai][2] + pa[ai][3])) + ((pb[ai][0] + pb[ai][1]) + (pb[ai][2] + pb[ai][3]))) + ((pc[ai][0] + pc[ai][1]) + (pc[ai][2] + pc[ai][3]));
              rsh[ai] = QC_SCALE / sqrtf(ssum * (1.0f / 384.0f) + EPSV); } }
        const int g32a = u.pn * 8 + wc, ropebj = (g32a % 3 == 2) ? 0 : ((g32a + 4) % 3 == 2) ? 1 : -1;
#pragma unroll
        for (int ai = 0; ai < 2; ++ai)
#pragma unroll
        for (int mh = 0; mh < 2; ++mh) {
            f32x4 tc0[2], tc1[2], ts0[2], ts1[2];
            if (ropebj >= 0) {
#pragma unroll
                for (int mm = 0; mm < 2; ++mm) { const int rU = rowU + ai * 128 + (mh * 2 + mm) * 16; const char* tc = (const char*)(RC + (size_t)rU * 16) + lt; const char* ts = (const char*)(RS + (size_t)rU * 16) + lt;
                    tc0[mm] = *(const f32x4*)tc; tc1[mm] = *(const f32x4*)(tc + 16); ts0[mm] = *(const f32x4*)ts; ts1[mm] = *(const f32x4*)(ts + 16); }
            }
#pragma unroll
            for (int mm = 0; mm < 2; ++mm) { const int m = mh * 2 + mm; char* rb = ub + (size_t)(ai * 128 + m * 16) * 768 * 2;
                const float rs = __shfl(rsh[ai], m * 16 + fr);
#pragma unroll
                for (int bj = 0; bj < 2; ++bj) { f32x4 v0 = acc[ai][bj][m][0] * rs, v1 = acc[ai][bj][m][1] * rs;
                    if (bj == ropebj) {
                        const f32x4 c0 = tc0[mm], c1 = tc1[mm], s0 = ts0[mm], s1 = ts1[mm];
                        f32x4 p0, p1;
#pragma unroll
                        for (int q = 0; q < 4; ++q) { p0[q] = __shfl_xor(v0[q], 32); p1[q] = __shfl_xor(v1[q], 32); }
                        if (fq < 2) { v0 = v0 * c0 - p0 * s0; v1 = v1 * c1 - p1 * s1; } else { v0 = v0 * c0 + p0 * s0; v1 = v1 * c1 + p1 * s1; }
                    }
                    v4u w; w.x = cvt_pk_bf16(v0[0], v0[1]); w.y = cvt_pk_bf16(v0[2], v0[3]); w.z = cvt_pk_bf16(v1[0], v1[1]); w.w = cvt_pk_bf16(v1[2], v1[3]);
                    *(v4u*)(rb + bj * 256 + lo) = w; } }
            asm volatile("" ::: "memory"); }
    }
};
struct EpiKV {
    PG8_USE_PERM(Perm8)
    bf16* KV; const float* SSKV;
    __device__ __forceinline__ void operator()(const f32x4 (&acc)[2][2][4][2], const pg8::Unit& u, int wr, int wc, int fr, int fq) const {
        const int rowU = u.pm * 256 + wr * 64;
        unsigned lo = (unsigned)(fr * 1024 + 8 * fq) * 2u; OPAQUE_V(lo);
        unsigned lr = (unsigned)fr * 32u; OPAQUE_V(lr);
        char* ub = (char*)KV + ((size_t)rowU * 1024 + u.pn * 256 + wc * 32) * 2;
        float rsh[2];
        { unsigned ll = (unsigned)(fq * 16 + fr) * 32u; OPAQUE_V(ll); f32x4 pa[2], pb[2];
#pragma unroll
          for (int ai = 0; ai < 2; ++ai) { const f32x4* sp = (const f32x4*)((const char*)(SSKV + (size_t)(rowU + ai * 128) * 8) + ll); pa[ai] = sp[0]; pb[ai] = sp[1]; }
#pragma unroll
          for (int ai = 0; ai < 2; ++ai) { const float ssum = ((pa[ai][0] + pa[ai][1]) + (pa[ai][2] + pa[ai][3])) + ((pb[ai][0] + pb[ai][1]) + (pb[ai][2] + pb[ai][3])); rsh[ai] = 1.0f / sqrtf(ssum * (1.0f / 256.0f) + EPSV); } }
#pragma unroll
        for (int ai = 0; ai < 2; ++ai)
#pragma unroll
            for (int m = 0; m < 4; ++m) { char* rb = ub + (size_t)(ai * 128 + m * 16) * 1024 * 2;
                const float rs = __shfl(rsh[ai], m * 16 + fr);
#pragma unroll
                for (int bj = 0; bj < 2; ++bj) { const f32x4 v0 = acc[ai][bj][m][0] * rs, v1 = acc[ai][bj][m][1] * rs;
                    v4u w; w.x = cvt_pk_bf16(v0[0], v0[1]); w.y = cvt_pk_bf16(v0[2], v0[3]); w.z = cvt_pk_bf16(v1[0], v1[1]); w.w = cvt_pk_bf16(v1[2], v1[3]);
                    *(v4u*)(rb + bj * 256 + lo) = w; }
                if (m & 1) asm volatile("" ::: "memory"); }
    }
};
template <int MODE> struct EpiGate {
    PG8_USE_PERM(Perm8)
    bf16* MIX; const bf16* GT;
    __device__ __forceinline__ void operator()(const f32x4 (&acc)[2][2][4][2], const pg8::Unit& u, int wr, int wc, int fr, int fq) const {
        const int rowU = u.pm * 256 + wr * 64, colU = u.pn * 256 + wc * 32;
        unsigned lg = (unsigned)(fr * 3072 + 8 * fq) * 2u; OPAQUE_V(lg);
        unsigned lm = (unsigned)(fr * 1024 + 8 * fq) * 2u; OPAQUE_V(lm);
        const char* ug = (const char*)GT + ((size_t)rowU * 3072 + colU) * 2; char* um = (char*)MIX + ((size_t)rowU * 1024 + colU) * 2;
#pragma unroll
        for (int ai = 0; ai < 2; ++ai)
#pragma unroll
            for (int m = 0; m < 4; ++m) { const char* rg = ug + (size_t)(ai * 128 + m * 16) * 3072 * 2; char* rm = um + (size_t)(ai * 128 + m * 16) * 1024 * 2;
#pragma unroll
                for (int bj = 0; bj < 2; ++bj) {
                    const v4u gw = *(const v4u*)(rg + bj * 256 + lg);
                    f32x4 v0 = acc[ai][bj][m][0], v1 = acc[ai][bj][m][1];
                    v0[0] *= bflo(gw.x); v0[1] *= bfhi(gw.x); v0[2] *= bflo(gw.y); v0[3] *= bfhi(gw.y); v1[0] *= bflo(gw.z); v1[1] *= bfhi(gw.z); v1[2] *= bflo(gw.w); v1[3] *= bfhi(gw.w);
                    char* mp = rm + bj * 256 + lm;
                    if (MODE == 1) { const v4u ow = *(const v4u*)mp;
                        v0[0] += bflo(ow.x); v0[1] += bfhi(ow.x); v0[2] += bflo(ow.y); v0[3] += bfhi(ow.y); v1[0] += bflo(ow.z); v1[1] += bfhi(ow.z); v1[2] += bflo(ow.w); v1[3] += bfhi(ow.w); }
                    v4u w; w.x = cvt_pk_bf16(v0[0], v0[1]); w.y = cvt_pk_bf16(v0[2], v0[3]); w.z = cvt_pk_bf16(v1[0], v1[1]); w.w = cvt_pk_bf16(v1[2], v1[3]);
                    *(v4u*)mp = w; }
                if (m & 1) asm volatile("" ::: "memory"); }
    }
};
struct EpiRes {
    PG8_USE_PERM(Perm8)
    const float* xsrc32; const bf16* xsrc16; bf16* xout; const float* GVt; const float* GS2t; float* XSS; float* XMX;
    __device__ __forceinline__ void operator()(f32x4 (&acc)[2][2][4][2], const pg8::Unit& u, int wr, int wc, int fr, int fq) const {
        const int rowU = u.pm * 256 + wr * 64, colU = u.pn * 256 + wc * 32; const int b = (u.pm * 256) >> 12;
        unsigned lo = (unsigned)(fr * DM + 8 * fq) * 2u; OPAQUE_V(lo);
        unsigned lc = (unsigned)(8 * fq) * 4u; OPAQUE_V(lc);
        const char* ga = (const char*)(GVt + (size_t)b * 1024 + colU);
        f32x4 gs2[2][2];
        { f32x4 gv[2][2];
#pragma unroll
          for (int bj = 0; bj < 2; ++bj)
#pragma unroll
              for (int n = 0; n < 2; ++n) { const int co = (bj * 128 + n * 4) * 4; gv[bj][n] = *(const f32x4*)(ga + co + lc); }
#pragma unroll
          for (int ai = 0; ai < 2; ++ai)
#pragma unroll
              for (int bj = 0; bj < 2; ++bj)
#pragma unroll
                  for (int m = 0; m < 4; ++m) { acc[ai][bj][m][0] = acc[ai][bj][m][0] * gv[bj][0]; acc[ai][bj][m][1] = acc[ai][bj][m][1] * gv[bj][1]; } }
#pragma unroll
        for (int bj = 0; bj < 2; ++bj)
#pragma unroll
            for (int n = 0; n < 2; ++n) { const int co = (bj * 128 + n * 4) * 4;
                gs2[bj][n] = *(const f32x4*)((const char*)(GS2t + (size_t)b * 1024 + colU) + co + lc); }
        const char* us32 = (const char*)xsrc32 + ((size_t)rowU * DM + colU) * 4; const char* us16 = (const char*)xsrc16 + ((size_t)rowU * DM + colU) * 2; char* uo = (char*)xout + ((size_t)rowU * DM + colU) * 2;
#pragma unroll
        for (int ai = 0; ai < 2; ++ai)
#pragma unroll
        for (int mh = 0; mh < 2; ++mh) {
            f32x4 X0[2][2], X1[2][2];
            if (xsrc32) {
#pragma unroll
                for (int mm = 0; mm < 2; ++mm)
#pragma unroll
                    for (int bj = 0; bj < 2; ++bj) { const char* p = us32 + ((size_t)(ai * 128 + (mh * 2 + mm) * 16) * DM + bj * 128) * 4 + 2u * lo; X0[mm][bj] = *(const f32x4*)p; X1[mm][bj] = *(const f32x4*)(p + 16); }
            } else { v4u xw[2][2];
#pragma unroll
                for (int mm = 0; mm < 2; ++mm)
#pragma unroll
                    for (int bj = 0; bj < 2; ++bj) xw[mm][bj] = *(const v4u*)(us16 + ((size_t)(ai * 128 + (mh * 2 + mm) * 16) * DM + bj * 128) * 2 + lo);
#pragma unroll
                for (int mm = 0; mm < 2; ++mm)
#pragma unroll
                    for (int bj = 0; bj < 2; ++bj) { const v4u w = xw[mm][bj]; X0[mm][bj] = (f32x4){bflo(w.x), bfhi(w.x), bflo(w.y), bfhi(w.y)}; X1[mm][bj] = (f32x4){bflo(w.z), bfhi(w.z), bflo(w.w), bfhi(w.w)}; }
            }
#pragma unroll
            for (int mm = 0; mm < 2; ++mm) { const int m = mh * 2 + mm; const size_t ro = (size_t)(ai * 128 + m * 16) * DM;
#pragma unroll
                for (int bj = 0; bj < 2; ++bj) { f32x4 x0 = X0[mm][bj], x1 = X1[mm][bj];
                    x0 = x0 + acc[ai][bj][m][0]; x1 = x1 + acc[ai][bj][m][1];
                    v4u o; o.x = cvt_pk_bf16(x0[0], x0[1]); o.y = cvt_pk_bf16(x0[2], x0[3]); o.z = cvt_pk_bf16(x1[0], x1[1]); o.w = cvt_pk_bf16(x1[2], x1[3]);
                    *(v4u*)(uo + (ro + bj * 128) * 2 + lo) = o;
                    float sq = ((x0[0] * x0[0] + x0[1] * x0[1]) + (x0[2] * x0[2] + x0[3] * x0[3])) + ((x1[0] * x1[0] + x1[1] * x1[1]) + (x1[2] * x1[2] + x1[3] * x1[3]));
                    const f32x4 t0 = x0 * gs2[bj][0], t1 = x1 * gs2[bj][1];
                    float mxv = fmaxf(fmaxf(fmaxf(fabsf(t0[0]), fabsf(t0[1])), fmaxf(fabsf(t0[2]), fabsf(t0[3]))), fmaxf(fmaxf(fabsf(t1[0]), fabsf(t1[1])), fmaxf(fabsf(t1[2]), fabsf(t1[3]))));
                    sq += __shfl_xor(sq, 16); sq += __shfl_xor(sq, 32); mxv = fmaxf(mxv, __shfl_xor(mxv, 16)); mxv = fmaxf(mxv, __shfl_xor(mxv, 32));
                    if (fq == 0) { XSS[(size_t)(rowU + ai * 128 + m * 16 + fr) * 32 + u.pn * 8 + bj * 4 + wc] = sq; XMX[(size_t)(rowU + ai * 128 + m * 16 + fr) * 32 + u.pn * 8 + bj * 4 + wc] = mxv; } } }
            asm volatile("" ::: "memory"); }
    }
};

struct T5Seg { unsigned a_off, b_off; int lda, ldb; };
__device__ __forceinline__ void gemm_t5_phase(LAS unsigned char* lds, const unsigned char* base, const T5Seg s0, const T5Seg s1, const T5Seg s2, const SchedDense& S, const unsigned char* GT, bf16* MIX) {
#define U8F(w, i) ((float)(((w) >> (8 * (i))) & 255u))
    using namespace pg8;
    const __amdgpu_buffer_rsrc_t rsrc = __builtin_amdgcn_make_buffer_rsrc((void*)base, 0, 0xffffffff, 0x00020000);
    int tid_ = threadIdx.x; asm volatile("" : "+v"(tid_));
    const int tid = tid_, wid = __builtin_amdgcn_readfirstlane(tid >> 6), lane = tid & 63, wr = wid >> 2, wc = wid & 3, fr = lane & 15, fq = lane >> 4;
    constexpr int NT = 20;
    int R0, C0; stage_rc(tid * 16, R0, C0); C0 *= 2;
    const int Rb0 = Perm8::bperm(R0);
    const unsigned vA256 = (unsigned)(R0 * 256 * 2 + C0), vA512 = (unsigned)(R0 * 512 * 2 + C0), vB256 = (unsigned)(Rb0 * 256 * 2 + C0), vB512 = (unsigned)(Rb0 * 512 * 2 + C0);
    const unsigned kstep = 128u;
    const unsigned ldsw = (unsigned)wid * 1024u;
    const int aoff = lds_byte(wr * 64 + fr, fq * 8), boff = lds_byte(wc * 32 + fr, fq * 8);
#define T5_SA(b, h) (((b) * 2 + (h)) * HTB)
#define T5_SB(b, h) ((4 + (b) * 2 + (h)) * HTB)
#define T5_SEG(T) ((T) < 4 ? 0 : (T) < 12 ? 1 : 2)
#define T5_AOFF(u, T) ((T) < 4 ? s0.a_off + (unsigned)(u).pm * 256u * 256u * 2u + (unsigned)(T) * kstep : (T) < 12 ? s1.a_off + (unsigned)(u).pm * 256u * 512u * 2u + (unsigned)((T) - 4) * kstep : s2.a_off + (unsigned)(u).pm * 256u * 512u * 2u + (unsigned)((T) - 12) * kstep)
#define T5_BOFF(u, T) ((T) < 4 ? s0.b_off + (unsigned)(u).pn * 256u * 256u * 2u + (unsigned)(T) * kstep : (T) < 12 ? s1.b_off + (unsigned)(u).pn * 256u * 512u * 2u + (unsigned)((T) - 4) * kstep : s2.b_off + (unsigned)(u).pn * 256u * 512u * 2u + (unsigned)((T) - 12) * kstep)
#define T5_LD(T) ((T) < 4 ? 256u : 512u)
#define T5_STAGEB(bufoff, u, T) do { const unsigned ld_ = T5_LD(T), go_ = T5_BOFF(u, T), vo_ = (T) < 4 ? vB256 : vB512; _Pragma("unroll") for (int _i = 0; _i < 2; ++_i) \
        __builtin_amdgcn_raw_ptr_buffer_load_lds(rsrc, (LAS void*)(lds + (bufoff) + ldsw + _i * 8192), 16, vo_, go_ + _i * 64u * ld_ * 2u, 0, 0); } while (0)
#define T5_STAGEB1(bufoff, u, T) do { const unsigned ld_ = T5_LD(T), go_ = T5_BOFF(u, T) + 128u * ld_ * 2u, vo_ = (T) < 4 ? vB256 : vB512; _Pragma("unroll") for (int _i = 0; _i < 2; ++_i) \
        __builtin_amdgcn_raw_ptr_buffer_load_lds(rsrc, (LAS void*)(lds + (bufoff) + ldsw + _i * 8192), 16, vo_, go_ + _i * 64u * ld_ * 2u, 0, 0); } while (0)
#define T5_STAGEA(bufoff, u, T, h) do { const unsigned ld_ = T5_LD(T), go_ = T5_AOFF(u, T) + (h) * 128u * ld_ * 2u, vo_ = (T) < 4 ? vA256 : vA512; _Pragma("unroll") for (int _i = 0; _i < 2; ++_i) \
        __builtin_amdgcn_raw_ptr_buffer_load_lds(rsrc, (LAS void*)(lds + (bufoff) + ldsw + _i * 8192), 16, vo_, go_ + _i * 64u * ld_ * 2u, 0, 0); } while (0)
#define T5_LDA(dst, b, h) do { _Pragma("unroll") for (int m = 0; m < 4; ++m) _Pragma("unroll") for (int k = 0; k < 2; ++k) dst[m][k] = *(const LAS bf16x8*)(lds + T5_SA(b, h) + aoff + m * 2048 + k * 1024); } while (0)
#define T5_LDB(dst, b, h) do { _Pragma("unroll") for (int n = 0; n < 2; ++n) _Pragma("unroll") for (int k = 0; k < 2; ++k) dst[n][k] = *(const LAS bf16x8*)(lds + T5_SB(b, h) + boff + n * 2048 + k * 1024); } while (0)
#define T5_MMA(ai, bj, At, Bt) do { __builtin_amdgcn_s_setprio(1); _Pragma("unroll") for (int m = 0; m < 4; ++m) _Pragma("unroll") for (int n = 0; n < 2; ++n) _Pragma("unroll") for (int k = 0; k < 2; ++k) \
        acc[ai][bj][m][n] = __builtin_amdgcn_mfma_f32_16x16x32_bf16(Bt[n][k], At[m][k], acc[ai][bj][m][n], 0, 0, 0); __builtin_amdgcn_s_setprio(0); } while (0)
#define T5_WAIT_V(n) asm volatile("s_waitcnt vmcnt(" #n ")" ::: "memory")
#define T5_WAIT_L(n) asm volatile("s_waitcnt lgkmcnt(" #n ")" ::: "memory")
#define T5_BAR __builtin_amdgcn_s_barrier()
#define T5_SCHED __builtin_amdgcn_sched_barrier(0)
    Unit cur, nxt; int ui = 0;
    if (!S.next(0, cur)) return;
    f32x4 acc[2][2][4][2];
#pragma unroll
    for (int a = 0; a < 2; ++a)
#pragma unroll
        for (int b = 0; b < 2; ++b)
#pragma unroll
            for (int m = 0; m < 4; ++m)
#pragma unroll
                for (int n = 0; n < 2; ++n) acc[a][b][m][n] = (f32x4){0.f, 0.f, 0.f, 0.f};
    bf16x8 At[4][2], B0[2][2], B1[2][2];
    T5_STAGEB(T5_SB(0, 0), cur, 0); T5_STAGEB1(T5_SB(0, 1), cur, 0); T5_STAGEA(T5_SA(0, 0), cur, 0, 0); T5_STAGEA(T5_SA(0, 1), cur, 0, 1);
    if (wr == 1) T5_BAR;
    T5_WAIT_V(2); T5_BAR;
    T5_STAGEB(T5_SB(1, 0), cur, 1); T5_STAGEA(T5_SA(1, 0), cur, 1, 0); T5_STAGEB1(T5_SB(1, 1), cur, 1);
    T5_WAIT_V(6); T5_BAR;
    for (;;) {
        const bool has_next = S.next(ui + 1, nxt);
        const Unit nu = has_next ? nxt : cur;
#pragma unroll 1
        for (int t = 0; t < NT; t += 2) {
            const bool last = (t == NT - 2);
            if (t == 4 || t == 12) {
                const int gp = (t == 4) ? 0 : 1;
                unsigned lg = (unsigned)(fr * 3072 + 8 * fq); asm volatile("" : "+v"(lg));
                const char* ug = (const char*)GT + ((size_t)(cur.pm * 256 + wr * 64) * 3072 + gp * 1024 + cur.pn * 256 + wc * 32);
#pragma unroll
                for (int ai = 0; ai < 2; ++ai) { v2u ga[4][2], gb[4][2];
#pragma unroll
                    for (int m = 0; m < 4; ++m)
#pragma unroll
                        for (int bj = 0; bj < 2; ++bj) { const char* p = ug + (size_t)(ai * 128 + m * 16) * 3072 + bj * 128 + lg; ga[m][bj] = *(const v2u*)p; gb[m][bj] = *(const v2u*)(p + 1024); }
#pragma unroll
                    for (int m = 0; m < 4; ++m)
#pragma unroll
                        for (int bj = 0; bj < 2; ++bj) { const v2u a = ga[m][bj], b = gb[m][bj];
                            f32x4& v0 = acc[ai][bj][m][0]; f32x4& v1 = acc[ai][bj][m][1];
                            v0[0] *= U8F(a.x, 0) * __builtin_amdgcn_rcpf(U8F(b.x, 0)); v0[1] *= U8F(a.x, 1) * __builtin_amdgcn_rcpf(U8F(b.x, 1)); v0[2] *= U8F(a.x, 2) * __builtin_amdgcn_rcpf(U8F(b.x, 2)); v0[3] *= U8F(a.x, 3) * __builtin_amdgcn_rcpf(U8F(b.x, 3));
                            v1[0] *= U8F(a.y, 0) * __builtin_amdgcn_rcpf(U8F(b.y, 0)); v1[1] *= U8F(a.y, 1) * __builtin_amdgcn_rcpf(U8F(b.y, 1)); v1[2] *= U8F(a.y, 2) * __builtin_amdgcn_rcpf(U8F(b.y, 2)); v1[3] *= U8F(a.y, 3) * __builtin_amdgcn_rcpf(U8F(b.y, 3)); }
                    asm volatile("" ::: "memory"); }
            }
            const bool relax = (t == 0) && (ui > 0);
            T5_LDB(B0, 0, 0); T5_LDB(B1, 0, 1); T5_SCHED; T5_LDA(At, 0, 0); T5_STAGEA(T5_SA(1, 1), cur, t + 1, 1);
            if (!relax) T5_WAIT_V(8);
            T5_WAIT_L(0); T5_BAR; T5_MMA(0, 0, At, B0); T5_MMA(0, 1, At, B1); T5_BAR; T5_SCHED;
            T5_LDA(At, 0, 1);
            if (last) { T5_STAGEB(T5_SB(0, 0), nu, 0); T5_STAGEB1(T5_SB(0, 1), nu, 0); T5_STAGEA(T5_SA(0, 0), nu, 0, 0); }
            else { T5_STAGEB(T5_SB(0, 0), cur, t + 2); T5_STAGEB1(T5_SB(0, 1), cur, t + 2); T5_STAGEA(T5_SA(0, 0), cur, t + 2, 0); }
            if (!relax) T5_WAIT_V(8);
            T5_WAIT_L(0); T5_BAR; T5_MMA(1, 0, At, B0); T5_MMA(1, 1, At, B1); T5_BAR; T5_SCHED;
            T5_LDB(B0, 1, 0); T5_LDB(B1, 1, 1); T5_SCHED; T5_LDA(At, 1, 0);
            if (last) T5_STAGEA(T5_SA(0, 1), nu, 0, 1); else T5_STAGEA(T5_SA(0, 1), cur, t + 2, 1);
            T5_WAIT_V(8); T5_WAIT_L(0); T5_BAR; T5_MMA(0, 0, At, B0); T5_MMA(0, 1, At, B1); T5_BAR; T5_SCHED;
            T5_LDA(At, 1, 1);
            if (last) { T5_STAGEB(T5_SB(1, 0), nu, 1); T5_STAGEB1(T5_SB(1, 1), nu, 1); T5_STAGEA(T5_SA(1, 0), nu, 1, 0); }
            else { T5_STAGEB(T5_SB(1, 0), cur, t + 3); T5_STAGEB1(T5_SB(1, 1), cur, t + 3); T5_STAGEA(T5_SA(1, 0), cur, t + 3, 0); }
            T5_WAIT_V(8); T5_WAIT_L(0); T5_BAR; T5_MMA(1, 0, At, B0); T5_MMA(1, 1, At, B1); T5_BAR; T5_SCHED;
        }
        if (wr == 0) T5_BAR;
        {
            int t2 = threadIdx.x; asm volatile("" : "+v"(t2)); const int fr2 = t2 & 15, fq2 = (t2 & 63) >> 4;
            unsigned lg = (unsigned)(fr2 * 3072 + 8 * fq2); asm volatile("" : "+v"(lg));
            unsigned lm = (unsigned)(fr2 * 1024 + 8 * fq2) * 2u; asm volatile("" : "+v"(lm));
            const char* ug = (const char*)GT + ((size_t)(cur.pm * 256 + wr * 64) * 3072 + 2048 + cur.pn * 256 + wc * 32);
            char* um = (char*)MIX + ((size_t)(cur.pm * 256 + wr * 64) * 1024 + cur.pn * 256 + wc * 32) * 2;
#pragma unroll
            for (int ai = 0; ai < 2; ++ai) { v2u gc[4][2];
#pragma unroll
                for (int m = 0; m < 4; ++m)
#pragma unroll
                    for (int bj = 0; bj < 2; ++bj) gc[m][bj] = *(const v2u*)(ug + (size_t)(ai * 128 + m * 16) * 3072 + bj * 128 + lg);
#pragma unroll
                for (int m = 0; m < 4; ++m)
#pragma unroll
                    for (int bj = 0; bj < 2; ++bj) { const v2u gw = gc[m][bj]; f32x4 v0 = acc[ai][bj][m][0] * (1.0f / 255.0f), v1 = acc[ai][bj][m][1] * (1.0f / 255.0f);
                        v0[0] *= U8F(gw.x, 0); v0[1] *= U8F(gw.x, 1); v0[2] *= U8F(gw.x, 2); v0[3] *= U8F(gw.x, 3); v1[0] *= U8F(gw.y, 0); v1[1] *= U8F(gw.y, 1); v1[2] *= U8F(gw.y, 2); v1[3] *= U8F(gw.y, 3);
                        v4u w; w.x = cvt_pk_bf16(v0[0], v0[1]); w.y = cvt_pk_bf16(v0[2], v0[3]); w.z = cvt_pk_bf16(v1[0], v1[1]); w.w = cvt_pk_bf16(v1[2], v1[3]);
                        *(v4u*)(um + (size_t)(ai * 128 + m * 16) * 1024 * 2 + bj * 256 + lm) = w; }
                asm volatile("" ::: "memory"); }
        }
        if (!has_next) break;
#pragma unroll
        for (int a = 0; a < 2; ++a)
#pragma unroll
            for (int b = 0; b < 2; ++b)
#pragma unroll
                for (int m = 0; m < 4; ++m)
#pragma unroll
                    for (int n = 0; n < 2; ++n) acc[a][b][m][n] = (f32x4){0.f, 0.f, 0.f, 0.f};
        cur = nxt; ++ui;
        if (wr == 1) T5_BAR;
    }
    T5_WAIT_V(0);
    T5_BAR;
#undef U8F
#undef T5_SA
#undef T5_SB
#undef T5_SEG
#undef T5_AOFF
#undef T5_BOFF
#undef T5_LD
#undef T5_STAGEB
#undef T5_STAGEB1
#undef T5_STAGEA
#undef T5_LDA
#undef T5_LDB
#undef T5_MMA
#undef T5_WAIT_V
#undef T5_WAIT_L
#undef T5_BAR
#undef T5_SCHED
}

struct AttnCfg {
    const bf16* Qp; long qpitch;
    const bf16* Kp; long kpitch;
    const bf16* K2p; long k2pitch;
    const bf16* Vp; long vpitch;
    bf16* Op; long opitch;
    float* lsep; long lsepitch;
    int q0, kt_lo, kt_hi, band;
};
__device__ __forceinline__ int crow(int r, int hi) { return (r & 3) + 8 * (r >> 2) + 4 * hi; }
typedef short v4i16_t __attribute__((ext_vector_type(4)));
__device__ __forceinline__ s16x4 vtr(LAS const unsigned char* p) { return __builtin_bit_cast(s16x4, __builtin_amdgcn_ds_read_tr16_b64_v4i16((LAS v4i16_t*)p)); }

template <int DQK>
__device__ __forceinline__ void attn_tile(const AttnCfg& cf, LAS unsigned char* lds, int buf, int kt, int qw_lo, int r32, int hi, int lane, unsigned klane, unsigned vlane,
                                          const bf16x8 (&qf)[DQK / 16], f32x16& o0, f32x16& o1, f32x16& negm, float& mref, float& lrun) {
    constexpr int KST = (DQK == 96) ? 208 : 144, KBUF = 64 * 208, VBUF = 8192, VOFF = 2 * KBUF, ND = DQK / 16; constexpr float THR = 8.0f;
    const int kbase = 64 * kt;
        const bool active = (kbase <= qw_lo + 31) && (cf.band == 0 || kbase + 63 >= qw_lo - cf.band);
        if (active) {
            LAS const unsigned char* Kb = lds + buf * KBUF + klane;
            f32x16 p0, p1;
#pragma unroll
            for (int d0 = 0; d0 < ND; ++d0) {
                const bf16x8 ka0 = *(LAS const bf16x8*)(Kb + d0 * 32), ka1 = *(LAS const bf16x8*)(Kb + 32 * KST + d0 * 32);
                p0 = __builtin_amdgcn_mfma_f32_32x32x16_bf16(ka0, qf[d0], d0 == 0 ? negm : p0, 0, 0, 0);
                p1 = __builtin_amdgcn_mfma_f32_32x32x16_bf16(ka1, qf[d0], d0 == 0 ? negm : p1, 0, 0, 0);
            }
            const bool need_mask = (kbase + 63 > qw_lo) || (cf.band != 0 && kbase < qw_lo + 31 - cf.band);
            if (need_mask) {
                const int q = qw_lo + r32; const int lo = (cf.band != 0) ? q - cf.band : -0x40000000;
#pragma unroll
                for (int r = 0; r < 16; ++r) { const int k0 = kbase + crow(r, hi), k1 = k0 + 32;
                    if (k0 > q || k0 < lo) p0[r] = -1e30f;
                    if (k1 > q || k1 < lo) p1[r] = -1e30f; }
            }
            float mx = fmaxf(fmaxf(p0[0], p0[1]), p1[0]);
#pragma unroll
            for (int r = 2; r < 16; r += 2) mx = fmaxf(fmaxf(mx, p0[r]), p0[r + 1]);
#pragma unroll
            for (int r = 1; r < 15; r += 2) mx = fmaxf(fmaxf(mx, p1[r]), p1[r + 1]);
            mx = fmaxf(mx, p1[15]);
            { auto rr = __builtin_amdgcn_permlane32_swap(__float_as_uint(mx), __float_as_uint(mx), false, false); mx = fmaxf(__uint_as_float(rr[0]), __uint_as_float(rr[1])); }
            if (__builtin_expect(__any(mx > THR), 0)) {
                const float dl = fmaxf(mx, 0.f), alpha = __builtin_amdgcn_exp2f(-dl);
                mref += dl; lrun *= alpha;
#pragma unroll
                for (int r = 0; r < 16; ++r) { p0[r] -= dl; p1[r] -= dl; o0[r] *= alpha; o1[r] *= alpha; negm[r] = -mref; }
            }
            float rs0 = 0.f, rs1 = 0.f;
#pragma unroll
            for (int r = 0; r < 16; ++r) { p0[r] = __builtin_amdgcn_exp2f(p0[r]); p1[r] = __builtin_amdgcn_exp2f(p1[r]); rs0 += p0[r]; rs1 += p1[r]; }
            lrun += rs0 + rs1;
            v4u pw[4];
#pragma unroll
            for (int s = 0; s < 2; ++s) {
                pw[s] = (v4u){cvt_pk_bf16(p0[8 * s + 0], p0[8 * s + 1]), cvt_pk_bf16(p0[8 * s + 2], p0[8 * s + 3]), cvt_pk_bf16(p0[8 * s + 4], p0[8 * s + 5]), cvt_pk_bf16(p0[8 * s + 6], p0[8 * s + 7])};
                pw[2 + s] = (v4u){cvt_pk_bf16(p1[8 * s + 0], p1[8 * s + 1]), cvt_pk_bf16(p1[8 * s + 2], p1[8 * s + 3]), cvt_pk_bf16(p1[8 * s + 4], p1[8 * s + 5]), cvt_pk_bf16(p1[8 * s + 6], p1[8 * s + 7])};
            }
            LAS const unsigned char* Vb = lds + VOFF + buf * VBUF + vlane;
#pragma unroll
            for (int ks = 0; ks < 4; ++ks) {
                const bf16x8 pb = __builtin_bit_cast(bf16x8, pw[ks]);
#pragma unroll
                for (int d = 0; d < 2; ++d) {
                    const s16x4 lo4 = vtr(Vb + d * 4096 + ks * 1024), hi4 = vtr(Vb + d * 4096 + ks * 1024 + 512);
                    const bf16x8 vf = (bf16x8){lo4[0], lo4[1], lo4[2], lo4[3], hi4[0], hi4[1], hi4[2], hi4[3]};
                    if (d == 0) o0 = __builtin_amdgcn_mfma_f32_32x32x16_bf16(vf, pb, o0, 0, 0, 0); else o1 = __builtin_amdgcn_mfma_f32_32x32x16_bf16(vf, pb, o1, 0, 0, 0);
                }
            }
        }
}

template <int DQK>
__device__ __forceinline__ void attn_unit(const AttnCfg& cf, LAS unsigned char* lds) {
    constexpr int KST = (DQK == 96) ? 208 : 144;
    constexpr int KBUF = 64 * 208, VBUF = 8192, VOFF = 2 * KBUF;
    constexpr int ND = DQK / 16;
    int tid_ = threadIdx.x; asm volatile("" : "+v"(tid_));
    const int tid = tid_, lane = tid & 63, r32 = lane & 31, hi = lane >> 5; const int wid = __builtin_amdgcn_readfirstlane(tid >> 6);
    const int qw_lo = cf.q0 + 32 * wid;
    bf16x8 qf[ND];
    { const bf16* qrow = cf.Qp + (long)(qw_lo + r32) * cf.qpitch;
#pragma unroll
      for (int d0 = 0; d0 < ND; ++d0) qf[d0] = *(const bf16x8*)(qrow + 16 * d0 + 8 * hi); }
    const int skey = tid >> 3, sch = tid & 7;
    const int s2key = tid >> 2, s2ch = tid & 3;
    const unsigned kdst = skey * KST + sch * 16, k2dst = s2key * KST + 128 + s2ch * 16, vdst = (sch >> 2) * 4096 + skey * 64 + (sch & 3) * 16;
    v4u kregA, k2regA, vregA, kregB, k2regB, vregB;
#define ATT_LOAD(S, kt) do { const long kr_ = (long)(64 * (kt) + skey); kreg##S = *(const v4u*)(cf.Kp + kr_ * cf.kpitch + sch * 8); vreg##S = *(const v4u*)(cf.Vp + kr_ * cf.vpitch + sch * 8); \
        if (DQK == 96 && tid < 256) k2reg##S = *(const v4u*)(cf.K2p + (long)(64 * (kt) + s2key) * cf.k2pitch + s2ch * 8); } while (0)
#define ATT_STORE(S, buf) do { *(LAS v4u*)(lds + (buf) * KBUF + kdst) = kreg##S; *(LAS v4u*)(lds + VOFF + (buf) * VBUF + vdst) = vreg##S; \
        if (DQK == 96 && tid < 256) *(LAS v4u*)(lds + (buf) * KBUF + k2dst) = k2reg##S; } while (0)
    f32x16 o0, o1, negm;
#pragma unroll
    for (int r = 0; r < 16; ++r) { o0[r] = 0.f; o1[r] = 0.f; negm[r] = 0.f; }
    float mref = 0.f, lrun = 0.f;
    constexpr float THR = 8.0f;
    const unsigned klane = r32 * KST + hi * 16;
    const unsigned vlane = (4 * hi + ((lane & 15) >> 2)) * 64 + ((lane >> 4) & 1) * 32 + (lane & 3) * 8;
    ATT_LOAD(A, cf.kt_lo); ATT_STORE(A, 0);
    if (cf.kt_lo + 1 < cf.kt_hi) ATT_LOAD(A, cf.kt_lo + 1);
    __syncthreads();
#define ATT_STEP(SN, SS) do { const int buf = (kt - cf.kt_lo) & 1; \
        if (kt + 2 < cf.kt_hi) ATT_LOAD(SN, kt + 2); \
        attn_tile<DQK>(cf, lds, buf, kt, qw_lo, r32, hi, lane, klane, vlane, qf, o0, o1, negm, mref, lrun); \
        if (kt + 1 < cf.kt_hi) ATT_STORE(SS, buf ^ 1); \
        __syncthreads(); } while (0)
    for (int kt = cf.kt_lo; kt < cf.kt_hi; kt += 2) {
        ATT_STEP(B, A);
        if (kt + 1 < cf.kt_hi) { ++kt; ATT_STEP(A, B); --kt; }
    }
#undef ATT_STEP
#undef ATT_LOAD
#undef ATT_STORE
    float ltot; { auto rr = __builtin_amdgcn_permlane32_swap(__float_as_uint(lrun), __float_as_uint(lrun), false, false); ltot = __uint_as_float(rr[0]) + __uint_as_float(rr[1]); }
    const float inv = 1.0f / ltot;
    bf16* orow = cf.Op + (long)(qw_lo + r32) * cf.opitch;
#pragma unroll
    for (int g = 0; g < 4; ++g) {
        v2u w0, w1;
        w0.x = cvt_pk_bf16(o0[4 * g] * inv, o0[4 * g + 1] * inv); w0.y = cvt_pk_bf16(o0[4 * g + 2] * inv, o0[4 * g + 3] * inv);
        w1.x = cvt_pk_bf16(o1[4 * g] * inv, o1[4 * g + 1] * inv); w1.y = cvt_pk_bf16(o1[4 * g + 2] * inv, o1[4 * g + 3] * inv);
        *(v2u*)(orow + 8 * g + 4 * hi) = w0; *(v2u*)(orow + 32 + 8 * g + 4 * hi) = w1;
    }
    if (cf.lsep != nullptr && hi == 0) cf.lsep[(long)(qw_lo + r32) * cf.lsepitch] = mref + __builtin_amdgcn_logf(ltot);
}

constexpr int RB_OFF = 61440, RB_ROW = 272, RB_ARR = 64 * RB_ROW, RB_BUF = 2 * RB_ARR;
static_assert(RB_OFF + 2 * RB_BUF <= RING_BYTES, "router chunk buffers");
__device__ __forceinline__ void n2_route_phase(const Frame& F, const Args& A, int layer, const bf16* x) {
    LAS float* GS = (LAS float*)F.lds; LAS float* SH = GS + 1024;
    LAS float* LG = SH + 1024 + F.wave * 1024;
    LAS unsigned* CNT = (LAS unsigned*)(F.lds + 8192 + 8 * 4096); LAS unsigned* BASE = CNT + 64;
    LAS unsigned* ENT = BASE + 64; LAS float* ENTW = (LAS float*)(ENT + 1024);
    const int j = layer * 2 + 1; const float* g = A.in[19] + layer * DM;
    const bf16* RTH = (const bf16*)(F.ws + WS_W + WO_RTH); const bf16* RTL = (const bf16*)(F.ws + WS_W + WO_RTL);
    const float* rbias = A.in[21] + layer * 64; const float* XSS = (const float*)(F.ws + WS_XSS); const float* XMX = (const float*)(F.ws + WS_XMX); float* SA2 = (float*)(F.ws + WS_SA2);
    LAS float* SHM = (LAS float*)(F.lds + 8192 + 8 * 4096 + 16384);
    unsigned char* H2 = F.ws + WS_H2; v2u* LISTS = (v2u*)(F.ws + WS_LISTS);
    unsigned* gcnt = F.ctl + CW_GCNT + layer * NLIST;
    const int tk = F.lane & 15, kq = F.lane >> 4;
    for (int tile = F.bid; tile < NTOK / 128; tile += F.G) {
        const int tok0 = tile * 128, b = tok0 >> 12, half = tok0 >> 14;
        __syncthreads();
        const int rrow = F.tid >> 4, rseg = F.tid & 15;
        const bf16* rsrc0 = RTH + (size_t)rrow * DM + rseg * 8; const bf16* rsrc1 = RTL + (size_t)rrow * DM + rseg * 8;
        LAS unsigned char* rdst = F.lds + RB_OFF + rrow * RB_ROW + rseg * 16;
        v4u rbr[4];
#define RB_LOAD(c) do { rbr[0] = *(const v4u*)(rsrc0 + (c) * 128); rbr[1] = *(const v4u*)(rsrc0 + 32 * DM + (c) * 128); rbr[2] = *(const v4u*)(rsrc1 + (c) * 128); rbr[3] = *(const v4u*)(rsrc1 + 32 * DM + (c) * 128); } while (0)
#define RB_STORE(buf) do { LAS unsigned char* d_ = rdst + (buf) * RB_BUF; *(LAS v4u*)d_ = rbr[0]; *(LAS v4u*)(d_ + 32 * RB_ROW) = rbr[1]; *(LAS v4u*)(d_ + RB_ARR) = rbr[2]; *(LAS v4u*)(d_ + RB_ARR + 32 * RB_ROW) = rbr[3]; } while (0)
        RB_LOAD(0);
        norm_tables(F, A, j, g, b, 1, GS, SH);
        if (F.tid < 64) CNT[F.tid] = 0u;
        __syncthreads();
        { float sm = fmaxf(fabsf(SH[F.tid]), fabsf(SH[F.tid + 512])); sm = wave_max(sm); if (F.lane == 0) SHM[F.wave] = sm; }
        __syncthreads();
        float shmax = SHM[0];
#pragma unroll
        for (int w = 1; w < 8; ++w) shmax = fmaxf(shmax, SHM[w]);
        const int tok = tok0 + F.wave * 16 + tk; const bf16* xr = x + (size_t)tok * DM + 8 * kq;
        float ss; { const f32x4* sp = (const f32x4*)(XSS + (size_t)tok * 32 + 8 * kq); const f32x4 s0 = sp[0], s1 = sp[1]; ss = ((s0[0] + s0[1]) + (s0[2] + s0[3])) + ((s1[0] + s1[1]) + (s1[2] + s1[3])); }
        ss += __shfl_xor(ss, 16); ss += __shfl_xor(ss, 32);
        const float rstd = 1.0f / sqrtf(ss * (1.0f / DM) + EPSV);
        float xm; { const f32x4* mp = (const f32x4*)(XMX + (size_t)tok * 32 + 8 * kq); const f32x4 m0 = mp[0], m1 = mp[1]; xm = fmaxf(fmaxf(fmaxf(m0[0], m0[1]), fmaxf(m0[2], m0[3])), fmaxf(fmaxf(m1[0], m1[1]), fmaxf(m1[2], m1[3]))); }
        xm = fmaxf(xm, __shfl_xor(xm, 16)); xm = fmaxf(xm, __shfl_xor(xm, 32));
        const float hmax = fmaxf(rstd * xm + shmax, 1e-20f), hinv = 126.5f / hmax;
        if (kq == 0) SA2[tok] = hmax * (1.0f / 126.5f);
        f32x4 lg[4];
#pragma unroll
        for (int ge = 0; ge < 4; ++ge) lg[ge] = (f32x4){0.f, 0.f, 0.f, 0.f};
        v4u xw[4], xn[4];
#pragma unroll
        for (int u = 0; u < 4; ++u) xw[u] = *(const v4u*)(xr + 32 * u);
#pragma unroll
        for (int u = 0; u < 4; ++u) asm volatile("" : "+v"(xw[u].x), "+v"(xw[u].y), "+v"(xw[u].z), "+v"(xw[u].w));
        RB_STORE(0);
        __syncthreads();
#pragma unroll 1
        for (int c = 0; c < 8; ++c) { const int kk0 = 4 * c;
            if (c + 1 < 8) { RB_LOAD(c + 1);
#pragma unroll
                for (int u = 0; u < 4; ++u) xn[u] = *(const v4u*)(xr + 32 * (kk0 + 4 + u)); }
            f32x4 xa[4], xc[4];
            const LAS unsigned char* rb = F.lds + RB_OFF + (c & 1) * RB_BUF + tk * RB_ROW + 16 * kq;
#pragma unroll
            for (int u = 0; u < 4; ++u) { xa[u] = (f32x4){bflo(xw[u].x), bfhi(xw[u].x), bflo(xw[u].y), bfhi(xw[u].y)}; xc[u] = (f32x4){bflo(xw[u].z), bfhi(xw[u].z), bflo(xw[u].w), bfhi(xw[u].w)}; }
#pragma unroll
            for (int u = 0; u < 4; ++u) {
                const int k0 = 32 * (kk0 + u) + 8 * kq;
                const f32x4 g0 = *(LAS const f32x4*)(GS + k0), g1 = *(LAS const f32x4*)(GS + k0 + 4), s0 = *(LAS const f32x4*)(SH + k0), s1 = *(LAS const f32x4*)(SH + k0 + 4);
                const f32x4 h0 = (xa[u] * rstd) * g0 + s0, h1 = (xc[u] * rstd) * g1 + s1;
                unsigned hb[8]; float lo[8];
#pragma unroll
                for (int q = 0; q < 4; ++q) { hb[q] = f2bf(h0[q]); lo[q] = h0[q] - bf2f(hb[q]); hb[4 + q] = f2bf(h1[q]); lo[4 + q] = h1[q] - bf2f(hb[4 + q]); }
                v4u hw; hw.x = hb[0] | (hb[1] << 16); hw.y = hb[2] | (hb[3] << 16); hw.z = hb[4] | (hb[5] << 16); hw.w = hb[6] | (hb[7] << 16);
                if (FP8_F2) { v2u h8; h8.x = pk4_i8(h0[0], h0[1], h0[2], h0[3], hinv); h8.y = pk4_i8(h1[0], h1[1], h1[2], h1[3], hinv); *(v2u*)(H2 + (size_t)tok * DM + k0) = h8; }
                else *(v4u*)(H2 + ((size_t)tok * DM + k0) * 2) = hw;
                v4u lw; lw.x = pk2(lo[0], lo[1]); lw.y = pk2(lo[2], lo[3]); lw.z = pk2(lo[4], lo[5]); lw.w = pk2(lo[6], lo[7]);
                const bf16x8 ahi = __builtin_bit_cast(bf16x8, hw), alo = __builtin_bit_cast(bf16x8, lw);
#pragma unroll
                for (int ge = 0; ge < 4; ++ge) {
                    const bf16x8 bh = *(LAS const bf16x8*)(rb + ge * 16 * RB_ROW + 64 * u), bl = *(LAS const bf16x8*)(rb + RB_ARR + ge * 16 * RB_ROW + 64 * u);
                    lg[ge] = __builtin_amdgcn_mfma_f32_16x16x32_bf16(ahi, bh, lg[ge], 0, 0, 0);
                    lg[ge] = __builtin_amdgcn_mfma_f32_16x16x32_bf16(alo, bh, lg[ge], 0, 0, 0);
                    lg[ge] = __builtin_amdgcn_mfma_f32_16x16x32_bf16(ahi, bl, lg[ge], 0, 0, 0);
                }
            }
            if (c + 1 < 8) { RB_STORE((c + 1) & 1);
#pragma unroll
                for (int u = 0; u < 4; ++u) xw[u] = xn[u]; }
            __syncthreads();
        }
#undef RB_LOAD
#undef RB_STORE
#pragma unroll
        for (int ge = 0; ge < 4; ++ge)
#pragma unroll
            for (int r = 0; r < 4; ++r) { const int e = 16 * ge + tk; LG[(4 * kq + r) * 64 + e] = fsigmoid(lg[ge][r]) + rbias[e]; }
        LDS_WAIT(); asm volatile("" ::: "memory");
        {
            const int tq = F.lane >> 2, part = F.lane & 3, qb = F.lane & ~3;
            const LAS float* sel = LG + tq * 64 + part * 16;
            float v[16];
#pragma unroll
            for (int i = 0; i < 16; ++i) v[i] = sel[i];
            float gl[2];
#pragma unroll
            for (int gI = 0; gI < 2; ++gI) { float m1 = -3e38f, m2 = -3e38f;
#pragma unroll
                for (int q = 0; q < 8; ++q) { const float x = v[gI * 8 + q]; if (x > m1) { m2 = m1; m1 = x; } else if (x > m2) m2 = x; }
                gl[gI] = m1 + m2; }
            float gsc[8];
#pragma unroll
            for (int p = 0; p < 4; ++p) { gsc[2 * p] = __shfl(gl[0], qb + p); gsc[2 * p + 1] = __shfl(gl[1], qb + p); }
            unsigned gmask = 0u;
#pragma unroll
            for (int gI = 0; gI < 8; ++gI) { int rank = 0;
#pragma unroll
                for (int q = 0; q < 8; ++q) rank += (gsc[q] > gsc[gI] || (gsc[q] == gsc[gI] && q < gI)) ? 1 : 0;
                if (rank < 4) gmask |= 1u << gI; }
#pragma unroll
            for (int i = 0; i < 16; ++i) if (!((gmask >> (2 * part + (i >> 3))) & 1u)) v[i] = -3e38f;
            unsigned taken = 0u; float wsum = 0.f; int es[8]; float sc[8];
#pragma unroll
            for (int k = 0; k < 8; ++k) { float best = -3.2e38f; int bi = 0;
#pragma unroll
                for (int i = 0; i < 16; ++i) { const bool free_ = !((taken >> i) & 1u); if (free_ && v[i] > best) { best = v[i]; bi = i; } }
                int be = part * 16 + bi;
#pragma unroll
                for (int off = 1; off <= 2; off <<= 1) { const float ob = __shfl_xor(best, off); const int oe = __shfl_xor(be, off); if (ob > best || (ob == best && oe < be)) { best = ob; be = oe; } }
                if ((be >> 4) == part) taken |= 1u << (be & 15);
                es[k] = be; sc[k] = best - rbias[be]; wsum += sc[k]; }
            const float wn = 2.5f / wsum;
#pragma unroll
            for (int k = 0; k < 8; ++k) if ((k & 3) == part) { const unsigned pos = atomicAdd((unsigned*)(CNT + es[k]), 1u); const int ei = (F.wave * 16 + tq) * 8 + k; ENT[ei] = (unsigned)es[k] | (pos << 8); ENTW[ei] = sc[k] * wn; }
        }
        __syncthreads();
        if (F.tid < 64) BASE[F.tid] = CNT[F.tid] ? atomicAdd(gcnt + half * 64 + F.tid, CNT[F.tid]) : 0u;
        __syncthreads();
        for (int ei = F.tid; ei < 1024; ei += NTHR) { const unsigned en = ENT[ei]; const unsigned e = en & 255u, pos = en >> 8; const unsigned slot = (unsigned)(tok0 + (ei >> 3)) * 8u + (unsigned)(ei & 7);
            LISTS[(size_t)(half * 64 + e) * LISTCAP + BASE[e] + pos] = (v2u){slot, __float_as_uint(ENTW[ei])}; }
    }
}
__device__ __forceinline__ void n2_convert_experts(const Frame& F, const Args& A, int layer) {
    LAS float* scr = (LAS float*)(F.lds + F.wave * 16384);
    const int gw = F.bid * NWAVES + F.wave, NGW = F.G * NWAVES;
    const float* w1 = A.in[22] + (size_t)layer * 64 * 1024 * 256; const float* w3 = A.in[23] + (size_t)layer * 64 * 1024 * 256; const float* w2 = A.in[24] + (size_t)layer * 64 * 256 * 1024;
    unsigned char* W13 = F.ws + WS_WEXP13; bf16* W2 = (bf16*)(F.ws + WS_WEXP2);
    if (FP8_F2) { LAS float* CM = (LAS float*)(F.lds + 12288);
        for (int it = F.bid; it < 64 * 16; it += F.G) { const int e = it >> 4, n0 = (it & 15) * 32, hh = n0 >> 8, rr = n0 & 255;
            tr_cols_i8_wg((rr < 128 ? w1 : w3) + (size_t)e * 1024 * 256, 256, hh * 128 + (rr & 127), W13 + (size_t)e * 512 * 1024, 1024, n0, (float*)(F.ws + WS_SW13) + e * 512, scr, CM, F.wave, F.lane); }
        __syncthreads(); }
    for (int it = gw; it < 64 * 32; it += NGW) { const int e = it >> 5, nb = it & 31;
        tr_cols_i8_k256(w2 + (size_t)e * 256 * 1024, 1024, nb * 32, (unsigned char*)W2 + (size_t)e * 1024 * 256, nb * 32, (float*)(F.ws + WS_SW2) + e * 1024, scr, F.lane); }
}

__device__ __forceinline__ void moe_tables(const Frame& F, int layer) {
    LAS int* PRE = (LAS int*)(F.lds + MOE_OFF); LAS int* CNT = PRE + 132;
    __syncthreads();
    if (F.tid < NLIST) CNT[F.tid] = (int)__hip_atomic_load(F.ctl + CW_GCNT + layer * NLIST + F.tid, RLX_AGENT);
    __syncthreads();
    if (F.tid < NLIST) { const int v = (CNT[F.tid] + 255) >> 8; int inc = v;
#pragma unroll
        for (int o = 1; o < 64; o <<= 1) { const int n = __shfl_up(inc, o); if (F.lane >= o) inc += n; }
        PRE[F.tid] = inc - v; if (F.lane == 63) PRE[129 + (F.tid >> 6)] = inc; }
    __syncthreads();
    if (F.tid >= 64 && F.tid < NLIST) PRE[F.tid] += PRE[129];
    if (F.tid == 0) PRE[NLIST] = PRE[129] + PRE[130];
    __syncthreads();
}
__device__ __forceinline__ int moe_find_list(LAS const int* PRE, int pair, int lane) {
    int t_ = threadIdx.x; asm volatile("" : "+v"(t_)); lane = t_ & 63;
    const unsigned long long b0 = __ballot(PRE[1 + lane] <= pair), b1 = __ballot(PRE[65 + lane] <= pair);
    return __popcll(b0) + __popcll(b1);
}
struct SchedMoe1 {
    static constexpr unsigned ESZ = FP8_F2 ? 1u : 2u;
    unsigned H2, W13, SH13; const v2u* LISTS; LAS const int* PRE; LAS const int* CNT; int G, c, T2, lane;
    __device__ __forceinline__ bool next(int i, pg8::Unit& u) const {
        const int idx = i * G + c; if (idx >= T2 + 256) return false;
        if (idx < T2) { const int pair = idx >> 1; const int l = moe_find_list(PRE, pair, lane); u.e = l; u.pm = __builtin_amdgcn_readfirstlane(pair - PRE[l]); u.pn = idx & 1; u.aux = pair * 256; }
        else { const int s = idx - T2; u.e = -1; u.pm = s >> 1; u.pn = s & 1; u.aux = ACT_SH_ROW + (s >> 1) * 256; }
        return true;
    }
    __device__ __forceinline__ unsigned a_off(const pg8::Unit&) const { return H2; }
    __device__ __forceinline__ unsigned b_off(const pg8::Unit& u) const { return u.e < 0 ? SH13 + (unsigned)u.pn * 256u * 1024u * ESZ : W13 + ((unsigned)(u.e & 63) * 512u + (unsigned)u.pn * 256u) * 1024u * ESZ; }
    __device__ __forceinline__ unsigned a_rowoff(const pg8::Unit& u, int r) const {
        if (u.e < 0) return (unsigned)(u.pm * 256 + r) * 1024u * ESZ;
        int pos = u.pm * 256 + r; const int cn = __builtin_amdgcn_readfirstlane(CNT[u.e]); pos = pos < cn ? pos : cn - 1;
        return (LISTS[(size_t)u.e * LISTCAP + pos].x >> 3) * 1024u * ESZ;
    }
};
struct EpiAct {
    PG8_USE_PERM(Perm8)
    unsigned char* ACT; float* SACT; LAS float* RMAX; const v2u* LISTS; LAS const int* CNT; const float *SA2, *SW13, *SSH13;
    __device__ __forceinline__ void operator()(const f32x4 (&acc)[2][2][4][2], const pg8::Unit& u, int wr, int wc, int fr, int fq) const {
        unsigned lo = (unsigned)(fr * 256 + 8 * fq); OPAQUE_V(lo);
        unsigned lf = (unsigned)fr; OPAQUE_V(lf); unsigned lc4 = (unsigned)(8 * fq) * 4u; OPAQUE_V(lc4);
        unsigned char* ub = ACT + ((size_t)(u.aux + wr * 64) * 256 + u.pn * 128 + wc * 32);
        float sa[8]; f32x4 sw[2][2];
        {
            const float* swp = (u.e < 0 ? SSH13 : SW13 + (size_t)(u.e & 63) * 512) + u.pn * 256 + wc * 32;
#pragma unroll
            for (int bj = 0; bj < 2; ++bj) { const char* sp = (const char*)(swp + bj * 128) + lc4; sw[bj][0] = *(const f32x4*)sp; sw[bj][1] = *(const f32x4*)(sp + 16); }
            if (u.e < 0) {
#pragma unroll
                for (int i = 0; i < 8; ++i) sa[i] = SA2[u.pm * 256 + wr * 64 + (i >> 2) * 128 + (i & 3) * 16 + (int)lf];
            } else {
                const int cn = __builtin_amdgcn_readfirstlane(CNT[u.e]); const v2u* lst = LISTS + (size_t)u.e * LISTCAP; unsigned tk[8];
#pragma unroll
                for (int i = 0; i < 8; ++i) { int pos = u.pm * 256 + wr * 64 + (i >> 2) * 128 + (i & 3) * 16 + (int)lf; pos = pos < cn ? pos : cn - 1; tk[i] = lst[pos].x >> 3; }
#pragma unroll
                for (int i = 0; i < 8; ++i) sa[i] = SA2[tk[i]];
            }
        }
        f32x4 v0[8], v1[8];
#pragma unroll
        for (int i = 0; i < 8; ++i) { const int ai = i >> 2, m = i & 3; const float s = sa[i]; float am = 0.f;
#pragma unroll
            for (int q = 0; q < 4; ++q) { const float a0 = acc[ai][0][m][0][q] * (sw[0][0][q] * s), a1 = acc[ai][0][m][1][q] * (sw[0][1][q] * s);
                v0[i][q] = a0 * fsigmoid(a0) * (acc[ai][1][m][0][q] * (sw[1][0][q] * s)); v1[i][q] = a1 * fsigmoid(a1) * (acc[ai][1][m][1][q] * (sw[1][1][q] * s));
                am = fmaxf(am, fmaxf(fabsf(v0[i][q]), fabsf(v1[i][q]))); }
            am = fmaxf(am, __shfl_xor(am, 16)); am = fmaxf(am, __shfl_xor(am, 32));
            if (fq == 0) RMAX[(ai * 128 + wr * 64 + m * 16 + (int)lf) * 4 + wc] = am; }
        asm volatile("s_waitcnt lgkmcnt(0)" ::: "memory"); __builtin_amdgcn_s_barrier(); asm volatile("" ::: "memory");
#pragma unroll
        for (int i = 0; i < 8; ++i) { const int ai = i >> 2, m = i & 3; const int row = ai * 128 + wr * 64 + m * 16 + (int)lf;
            const f32x4 mx = *(const LAS f32x4*)(RMAX + row * 4); const float am = fmaxf(fmaxf(fmaxf(mx[0], mx[1]), fmaxf(mx[2], mx[3])), 1e-4f), inv = 127.0f / am;
            v2u w; w.x = pk4_i8(v0[i][0], v0[i][1], v0[i][2], v0[i][3], inv); w.y = pk4_i8(v1[i][0], v1[i][1], v1[i][2], v1[i][3], inv);
            *(v2u*)(ub + (size_t)(ai * 128 + m * 16) * 256 + lo) = w;
            if (wc == 0 && fq == 0) SACT[(size_t)(u.aux + row) * 2 + u.pn] = am * (1.0f / 127.0f); }
    }
};
constexpr float Y_MUL = 16.0f, Y_INV = 0.0625f;
struct SchedMoe2 {
    unsigned ACT, W2, SH2; LAS const int* PRE; int G, c, T4, lane; const float* SACT;
    __device__ __forceinline__ bool next(int i, pg8::Unit& u) const {
        const int idx = i * G + c; if (idx >= T4 + 512) return false;
        if (idx < T4) { const int pair = idx >> 2; const int l = moe_find_list(PRE, pair, lane); u.e = l; u.pm = __builtin_amdgcn_readfirstlane(pair - PRE[l]); u.pn = idx & 3; u.aux = pair * 256; }
        else { const int s = idx - T4; u.e = -1; u.pm = s >> 2; u.pn = s & 3; u.aux = ACT_SH_ROW + (s >> 2) * 256; }
        return true;
    }
    __device__ __forceinline__ unsigned a_off(const pg8::Unit& u) const { return ACT + (unsigned)u.aux * 256u; }
    __device__ __forceinline__ unsigned b_off(const pg8::Unit& u) const { return u.e < 0 ? SH2 + (unsigned)u.pn * 256u * 256u : W2 + ((unsigned)(u.e & 63) * 1024u + (unsigned)u.pn * 256u) * 256u; }
    __device__ __forceinline__ unsigned a_rowoff(const pg8::Unit&, int) const { return 0u; }
    __device__ __forceinline__ f32x2 kscale(const pg8::Unit& u, int r) const { return *(const f32x2*)(SACT + (size_t)(u.aux + r) * 2); }
};
struct EpiY {
    PG8_USE_PERM(Perm16)
    unsigned char* YH; bf16* SY; const v2u* LISTS; LAS const int* CNT; int mode; const float *SACT, *SW2, *SSH2;
    __device__ __forceinline__ void operator()(const f32x4 (&acc)[2][2][4][2], const pg8::Unit& u, int wr, int wc, int fr, int fq) const {
        if (mode == 1) { float s = 0.f;
#pragma unroll
            for (int ai = 0; ai < 2; ++ai)
#pragma unroll
                for (int m = 0; m < 4; ++m) s += acc[ai][0][m][0][0] + acc[ai][1][m][1][3];
            if (s == 1.2345e-33f) SY[0] = 1; return; }
        unsigned lf = (unsigned)fr; OPAQUE_V(lf);
        unsigned lc = (unsigned)(16 * fq); OPAQUE_V(lc);
        f32x4 sw[2][2]; float sf[8];
        { const char* sp = (const char*)((u.e < 0 ? SSH2 : SW2 + (size_t)(u.e & 63) * 1024) + u.pn * 256 + wc * 64) + lc * 4u;
#pragma unroll
          for (int bj = 0; bj < 2; ++bj)
#pragma unroll
              for (int n = 0; n < 2; ++n) sw[bj][n] = *(const f32x4*)(sp + (bj * 8 + n * 4) * 4);
#pragma unroll
          for (int i = 0; i < 8; ++i) { const f32x2 s = *(const f32x2*)(SACT + (size_t)(u.aux + wr * 64 + (i >> 2) * 128 + (i & 3) * 16 + (int)lf) * 2); sf[i] = fmaxf(s.y, s.x * 1e-3f); } }
        if (u.e < 0) {
            unsigned lo = (unsigned)(fr * 1024 + 16 * fq) * 2u; OPAQUE_V(lo);
            char* ub = (char*)SY + ((size_t)(u.pm * 256 + wr * 64) * 1024 + u.pn * 256 + wc * 64) * 2;
#pragma unroll
            for (int ai = 0; ai < 2; ++ai)
#pragma unroll
                for (int m = 0; m < 4; ++m)
#pragma unroll
                    for (int bj = 0; bj < 2; ++bj) { const f32x4 v0 = acc[ai][bj][m][0] * (sw[bj][0] * sf[ai * 4 + m]), v1 = acc[ai][bj][m][1] * (sw[bj][1] * sf[ai * 4 + m]);
                        v4u o; o.x = cvt_pk_bf16(v0[0], v0[1]); o.y = cvt_pk_bf16(v0[2], v0[3]); o.z = cvt_pk_bf16(v1[0], v1[1]); o.w = cvt_pk_bf16(v1[2], v1[3]);
                        *(v4u*)(ub + (size_t)(ai * 128 + m * 16) * 2048 + bj * 16 + lo) = o; }
            return;
        }
        const int cn = __builtin_amdgcn_readfirstlane(CNT[u.e]); const int posU = u.pm * 256 + wr * 64;
        const v2u* lst = LISTS + (size_t)u.e * LISTCAP + posU; unsigned char* ub = YH + (size_t)(u.pn * 256 + wc * 64);
        v2u ent[8];
#pragma unroll
        for (int i = 0; i < 8; ++i) { const int ro = (i >> 2) * 128 + (i & 3) * 16 + (int)lf; ent[i] = (posU + ro < cn) ? lst[ro] : (v2u){0xffffffffu, 0u}; }
#pragma unroll
        for (int ai = 0; ai < 2; ++ai)
#pragma unroll
            for (int m = 0; m < 4; ++m) { const v2u en = ent[ai * 4 + m];
                if (en.x != 0xffffffffu) { const float w = __uint_as_float(en.y) * Y_MUL * sf[ai * 4 + m];
                    const f32x4 a0 = acc[ai][0][m][0] * (sw[0][0] * w), a1 = acc[ai][0][m][1] * (sw[0][1] * w), b0 = acc[ai][1][m][0] * (sw[1][0] * w), b1 = acc[ai][1][m][1] * (sw[1][1] * w);
                    v4u o; o.x = pk4_fp8(a0[0], a0[1], a0[2], a0[3]); o.y = pk4_fp8(a1[0], a1[1], a1[2], a1[3]); o.z = pk4_fp8(b0[0], b0[1], b0[2], b0[3]); o.w = pk4_fp8(b1[0], b1[1], b1[2], b1[3]);
                    *(v4u*)(ub + (size_t)en.x * 1024 + lc) = o; } }
    }
};
__device__ __forceinline__ f32x4 fp8x4_to_f32(unsigned w) {
    const f32x2 lo = __builtin_amdgcn_cvt_pk_f32_fp8(w, false), hi = __builtin_amdgcn_cvt_pk_f32_fp8(w, true); return (f32x4){lo[0], lo[1], hi[0], hi[1]}; }
__device__ __forceinline__ void combine_phase(const Frame& F, const Args& A, int layer, bf16* x, float* out) {
    const bool last = (layer == NLAYER - 1);
    LAS float* GATE = (LAS float*)F.lds; LAS float* GS = GATE + NB * DM; LAS float* SH = GS + NB * DM;
    __syncthreads();
    { const int j = layer * 2 + 1; const float* bias = ada_bias(A, j);
      for (int i = F.tid; i < NB * DM; i += NTHR) { const int b = i >> 10, k = i & 1023; GATE[i] = ada_acc(F, j, b)[2048 + k] + bias[2048 + k]; } }
    if (!last) norm_tables(F, A, (layer + 1) * 2, A.in[5] + (layer + 1) * DM, 0, NB, GS, SH);
    else for (int i = F.tid; i < DM; i += NTHR) GS[i] = A.in[28][i];
    __syncthreads();
    const unsigned char* YH = F.ws + WS_YH; const bf16* SY = (const bf16*)(F.ws + WS_SY); unsigned char* H = F.ws + WS_HIN;
    const int gw = F.bid * NWAVES + F.wave, NGW = F.G * NWAVES; const int c0 = 16 * F.lane;
    for (int tok = gw; tok < NTOK; tok += NGW) {
        const int b = tok >> 12;
        bf16* xr = x + (size_t)tok * DM + c0;
        f32x4 xv[4]; v4u yv[8], sv[2], xw[2];
        xw[0] = *(const v4u*)xr; xw[1] = *(const v4u*)(xr + 8);
        sv[0] = *(const v4u*)(SY + (size_t)tok * DM + c0); sv[1] = *(const v4u*)(SY + (size_t)tok * DM + c0 + 8);
#pragma unroll
        for (int k = 0; k < 8; ++k) yv[k] = *(const v4u*)(YH + ((size_t)tok * 8 + k) * 1024 + c0);
        float ssq = 0.f;
#pragma unroll
        for (int q = 0; q < 4; ++q) { const unsigned x0 = xw[q >> 1][(q & 1) * 2], x1 = xw[q >> 1][(q & 1) * 2 + 1]; xv[q] = (f32x4){bflo(x0), bfhi(x0), bflo(x1), bfhi(x1)}; }
#pragma unroll
        for (int q = 0; q < 4; ++q) { f32x4 s = (f32x4){0.f, 0.f, 0.f, 0.f};
#pragma unroll
            for (int k = 0; k < 8; ++k) s += fp8x4_to_f32(yv[k][q]);
            const unsigned w0 = sv[q >> 1][(q & 1) * 2], w1 = sv[q >> 1][(q & 1) * 2 + 1];
            s = s * Y_INV + (f32x4){bflo(w0), bfhi(w0), bflo(w1), bfhi(w1)};
            xv[q] = xv[q] + *(LAS const f32x4*)(GATE + b * DM + c0 + 4 * q) * s;
            ssq += (xv[q].x * xv[q].x + xv[q].y * xv[q].y) + (xv[q].z * xv[q].z + xv[q].w * xv[q].w); }
        const float rstd = 1.0f / sqrtf(wave_sum(ssq) * (1.0f / DM) + EPSV);
        if (last) {
#pragma unroll
            for (int q = 0; q < 4; ++q) *(f32x4*)(out + (size_t)tok * DM + c0 + 4 * q) = (xv[q] * rstd) * *(LAS const f32x4*)(GS + c0 + 4 * q);
        } else {
            f32x4 hh[4];
            { v4u o0, o1; o0.x = cvt_pk_bf16(xv[0][0], xv[0][1]); o0.y = cvt_pk_bf16(xv[0][2], xv[0][3]); o0.z = cvt_pk_bf16(xv[1][0], xv[1][1]); o0.w = cvt_pk_bf16(xv[1][2], xv[1][3]);
              o1.x = cvt_pk_bf16(xv[2][0], xv[2][1]); o1.y = cvt_pk_bf16(xv[2][2], xv[2][3]); o1.z = cvt_pk_bf16(xv[3][0], xv[3][1]); o1.w = cvt_pk_bf16(xv[3][2], xv[3][3]);
              *(v4u*)xr = o0; *(v4u*)(xr + 8) = o1; }
#pragma unroll
            for (int q = 0; q < 4; ++q) {
                hh[q] = (xv[q] * rstd) * *(LAS const f32x4*)(GS + b * DM + c0 + 4 * q) + *(LAS const f32x4*)(SH + b * DM + c0 + 4 * q); }
            if (FP8_T1) { float am = 0.f;
#pragma unroll
                for (int q = 0; q < 4; ++q) am = fmaxf(am, fmaxf(fmaxf(fabsf(hh[q][0]), fabsf(hh[q][1])), fmaxf(fabsf(hh[q][2]), fabsf(hh[q][3]))));
                am = fmaxf(wave_max(am), 1e-20f); const float inv = 127.0f / am; if (F.lane == 0) ((float*)(F.ws + WS_SA))[tok] = am * (1.0f / 127.0f);
                v4u o; o.x = pk4_i8(hh[0][0], hh[0][1], hh[0][2], hh[0][3], inv); o.y = pk4_i8(hh[1][0], hh[1][1], hh[1][2], hh[1][3], inv); o.z = pk4_i8(hh[2][0], hh[2][1], hh[2][2], hh[2][3], inv); o.w = pk4_i8(hh[3][0], hh[3][1], hh[3][2], hh[3][3], inv);
                *(v4u*)(H + (size_t)tok * DM + c0) = o; }
            else { v4u o0, o1; o0.x = pk2(hh[0][0], hh[0][1]); o0.y = pk2(hh[0][2], hh[0][3]); o0.z = pk2(hh[1][0], hh[1][1]); o0.w = pk2(hh[1][2], hh[1][3]);
                o1.x = pk2(hh[2][0], hh[2][1]); o1.y = pk2(hh[2][2], hh[2][3]); o1.z = pk2(hh[3][0], hh[3][1]); o1.w = pk2(hh[3][2], hh[3][3]);
                *(v4u*)(H + ((size_t)tok * DM + c0) * 2) = o0; *(v4u*)(H + ((size_t)tok * DM + c0) * 2 + 16) = o1; }
        }
    }
}

__device__ __forceinline__ void krr_job(const Frame& F) {
    const bf16* __restrict__ CQ = (const bf16*)(F.ws + WS_CQ); bf16* __restrict__ KRR = (bf16*)(F.ws + WS_KRR); const float* __restrict__ rc = (const float*)(F.ws + WS_ROPEC); const float* __restrict__ rs = (const float*)(F.ws + WS_ROPES);
    for (int idx = F.bid * NTHR + F.tid; idx < NTOK * 2; idx += F.G * NTHR) { const int tok = idx >> 1, i8 = (idx & 1) * 8;
        const v4u a = *(const v4u*)(CQ + (size_t)tok * 512 + 384 + i8), b = *(const v4u*)(CQ + (size_t)tok * 512 + 400 + i8);
        const f32x4 c0 = *(const f32x4*)(rc + (size_t)tok * 16 + i8), c1 = *(const f32x4*)(rc + (size_t)tok * 16 + i8 + 4), s0 = *(const f32x4*)(rs + (size_t)tok * 16 + i8), s1 = *(const f32x4*)(rs + (size_t)tok * 16 + i8 + 4);
        const float x1[8] = {bflo(a.x), bfhi(a.x), bflo(a.y), bfhi(a.y), bflo(a.z), bfhi(a.z), bflo(a.w), bfhi(a.w)}, x2[8] = {bflo(b.x), bfhi(b.x), bflo(b.y), bfhi(b.y), bflo(b.z), bfhi(b.z), bflo(b.w), bfhi(b.w)};
        const float c[8] = {c0[0], c0[1], c0[2], c0[3], c1[0], c1[1], c1[2], c1[3]}, s[8] = {s0[0], s0[1], s0[2], s0[3], s1[0], s1[1], s1[2], s1[3]};
        float o1[8], o2[8];
#pragma unroll
        for (int q = 0; q < 8; ++q) { o1[q] = x1[q] * c[q] - x2[q] * s[q]; o2[q] = x2[q] * c[q] + x1[q] * s[q]; }
        v4u w1, w2; w1.x = pk2(o1[0], o1[1]); w1.y = pk2(o1[2], o1[3]); w1.z = pk2(o1[4], o1[5]); w1.w = pk2(o1[6], o1[7]); w2.x = pk2(o2[0], o2[1]); w2.y = pk2(o2[2], o2[3]); w2.z = pk2(o2[4], o2[5]); w2.w = pk2(o2[6], o2[7]);
        *(v4u*)(KRR + (size_t)tok * 32 + i8) = w1; *(v4u*)(KRR + (size_t)tok * 32 + 16 + i8) = w2; }
}
#define POOL_ADD(s, v, sg) do { s[0] += sg bflo(v.x); s[1] += sg bfhi(v.x); s[2] += sg bflo(v.y); s[3] += sg bfhi(v.y); s[4] += sg bflo(v.z); s[5] += sg bfhi(v.z); s[6] += sg bflo(v.w); s[7] += sg bfhi(v.w); } while (0)
__device__ __forceinline__ void pool_job(const Frame& F) {
    const bf16* __restrict__ UB = (const bf16*)(F.ws + WS_UB); bf16* __restrict__ PO = (bf16*)(F.ws + WS_POOL);
    for (int idx = F.bid * NTHR + F.tid; idx < (NTOK / 4) * 64; idx += F.G * NTHR) { const int t0 = (idx >> 6) * 4, c8 = idx & 63, g = c8 >> 4, w = 2 << g, ts = t0 & (SEQ - 1);
        const bf16* up = UB + (size_t)t0 * 512 + c8 * 8;
        v4u r[19];
#pragma unroll
        for (int k = 0; k < 19; ++k) { r[k] = (v4u){0u, 0u, 0u, 0u}; if (k >= 16 - w && ts - 15 + k >= 0) r[k] = *(const v4u*)(up + (k - 15) * 512); }
        float s[8];
#pragma unroll
        for (int q = 0; q < 8; ++q) s[q] = 0.f;
#pragma unroll
        for (int k = 0; k < 16; ++k) POOL_ADD(s, r[k], +);
#pragma unroll
        for (int i = 0; i < 4; ++i) {
            if (i > 0) { const v4u nw = r[15 + i]; const v4u od = (g == 0) ? r[13 + i] : (g == 1) ? r[11 + i] : (g == 2) ? r[7 + i] : r[i - 1]; POOL_ADD(s, nw, +); POOL_ADD(s, od, -); }
            const int n = (ts + i + 1 < w) ? ts + i + 1 : w; const float inv = 1.0f / (float)n; const v4u u = r[15 + i];
            v4u o; o.x = pk2(s[0] * inv - bflo(u.x), s[1] * inv - bfhi(u.x)); o.y = pk2(s[2] * inv - bflo(u.y), s[3] * inv - bfhi(u.y)); o.z = pk2(s[4] * inv - bflo(u.z), s[5] * inv - bfhi(u.z)); o.w = pk2(s[6] * inv - bflo(u.w), s[7] * inv - bfhi(u.w));
            *(v4u*)(PO + (size_t)(t0 + i) * 512 + c8 * 8) = o; }
    }
}
#undef POOL_ADD
__device__ __forceinline__ void dil_combine_job(const Frame& F) {
    const bf16* __restrict__ OD = (const bf16*)(F.ws + WS_QKV); const float* __restrict__ LSE = (const float*)(F.ws + WS_LSE); bf16* __restrict__ YA = (bf16*)(F.ws + WS_CKV);
    const int S = F.G * NTHR;
    for (int idx0 = F.bid * NTHR + F.tid; idx0 < NTOK * 32; idx0 += 4 * S) {
        float l[4][3]; v4u a[4], b[4], c[4];
#pragma unroll
        for (int u = 0; u < 4; ++u) { const int idx = idx0 + u * S; if (idx < NTOK * 32) { const int tok = idx >> 5, hh = (idx >> 3) & 3, d8 = idx & 7;
            l[u][0] = LSE[(size_t)tok * 12 + hh]; l[u][1] = LSE[(size_t)tok * 12 + 4 + hh]; l[u][2] = LSE[(size_t)tok * 12 + 8 + hh];
            const int sq = tok & (SEQ - 1), tb = tok & ~(SEQ - 1);
            const size_t t0 = (size_t)tok, t1 = (size_t)(tb + (sq & 3) * (SEQ / 4) + (sq >> 2)), t2 = (size_t)(tb + (sq & 15) * (SEQ / 16) + (sq >> 4));
            a[u] = *(const v4u*)(OD + ((size_t)(0 + hh) * NTOK + t0) * 64 + d8 * 8); b[u] = *(const v4u*)(OD + ((size_t)(4 + hh) * NTOK + t1) * 64 + d8 * 8); c[u] = *(const v4u*)(OD + ((size_t)(8 + hh) * NTOK + t2) * 64 + d8 * 8); } }
#pragma unroll
        for (int u = 0; u < 4; ++u) { const int idx = idx0 + u * S; if (idx < NTOK * 32) { const int tok = idx >> 5, hh = (idx >> 3) & 3, d8 = idx & 7;
            const float mx = fmaxf(l[u][0], fmaxf(l[u][1], l[u][2])); float w0 = __builtin_amdgcn_exp2f(l[u][0] - mx), w1 = __builtin_amdgcn_exp2f(l[u][1] - mx), w2 = __builtin_amdgcn_exp2f(l[u][2] - mx);
            const float inv = 1.0f / (w0 + w1 + w2); w0 *= inv; w1 *= inv; w2 *= inv;
            const v4u A = a[u], B = b[u], C = c[u]; v4u o;
            o.x = pk2(w0 * bflo(A.x) + w1 * bflo(B.x) + w2 * bflo(C.x), w0 * bfhi(A.x) + w1 * bfhi(B.x) + w2 * bfhi(C.x));
            o.y = pk2(w0 * bflo(A.y) + w1 * bflo(B.y) + w2 * bflo(C.y), w0 * bfhi(A.y) + w1 * bfhi(B.y) + w2 * bfhi(C.y));
            o.z = pk2(w0 * bflo(A.z) + w1 * bflo(B.z) + w2 * bflo(C.z), w0 * bfhi(A.z) + w1 * bfhi(B.z) + w2 * bfhi(C.z));
            o.w = pk2(w0 * bflo(A.w) + w1 * bflo(B.w) + w2 * bflo(C.w), w0 * bfhi(A.w) + w1 * bfhi(B.w) + w2 * bfhi(C.w));
            *(v4u*)(YA + (size_t)tok * 256 + hh * 64 + d8 * 8) = o; } }
    }
}
__device__ __forceinline__ void final_norm(const Frame& F, const Args& A, float* x) {
    const int gw = F.bid * NWAVES + F.wave, NGW = F.G * NWAVES; const float* g = A.in[28];
    for (int m = gw; m < NTOK; m += NGW) { f32x4* xr = (f32x4*)(x + (size_t)m * DM) + F.lane; f32x4 v[4]; float s = 0.f;
#pragma unroll
        for (int q = 0; q < 4; ++q) { v[q] = xr[64 * q]; s += (v[q].x * v[q].x + v[q].y * v[q].y) + (v[q].z * v[q].z + v[q].w * v[q].w); }
        const float rstd = 1.0f / sqrtf(wave_sum(s) * (1.0f / DM) + EPSV);
#pragma unroll
        for (int q = 0; q < 4; ++q) xr[64 * q] = (v[q] * rstd) * *(const f32x4*)(g + 4 * F.lane + 256 * q); }
}

__device__ __forceinline__ void dilated_units(const Frame& F, bf16* o_redirect, float* lse_redirect) {
    bf16* QKV = (bf16*)(F.ws + WS_QKV); float* LSE = (float*)(F.ws + WS_LSE);
    for (int u = F.bid; u < 1536; u += F.G) {
        const int g = u >> 9, v = u & 511; int b, r, h, qb, d;
        if (g == 0) { d = 1; b = v >> 6; h = (v >> 4) & 3; qb = v & 15; r = 0; }
        else if (g == 1) { d = 4; b = v >> 6; r = (v >> 4) & 3; h = (v >> 2) & 3; qb = v & 3; }
        else { d = 16; b = v >> 6; r = (v >> 2) & 15; h = v & 3; qb = 0; }
        const int hd = g * 4 + h; const size_t tok0 = (size_t)b * SEQ + r;
        AttnCfg cf;
        const size_t rb0 = (size_t)b * SEQ + (size_t)r * (SEQ / d);
        cf.Qp = QKV + ((size_t)((0 * 3 + g) * 4 + h) * NTOK + rb0) * 64; cf.qpitch = 64; cf.Kp = QKV + ((size_t)((1 * 3 + g) * 4 + h) * NTOK + rb0) * 64; cf.kpitch = 64; cf.K2p = nullptr; cf.k2pitch = 0;
        cf.Vp = QKV + ((size_t)((2 * 3 + g) * 4 + h) * NTOK + rb0) * 64; cf.vpitch = 64; cf.Op = const_cast<bf16*>(cf.Qp); cf.opitch = 64;
        cf.lsep = LSE + tok0 * 12 + hd; cf.lsepitch = (long)d * 12;
        if (o_redirect) { cf.Op = o_redirect + tok0 * 768 + hd * 64; cf.opitch = (long)d * 768; cf.lsep = lse_redirect + tok0 * 12 + hd; }
        cf.q0 = qb * 256; cf.kt_lo = qb == 0 ? 0 : (qb * 256 - 128) / 64; cf.kt_hi = (qb * 256 + 256) / 64; cf.band = 128;
        attn_unit<64>(cf, F.lds);
    }
}
__device__ __forceinline__ void mla_units(const Frame& F) {
    const bf16* Q = (const bf16*)(F.ws + WS_Q); const bf16* KV = (const bf16*)(F.ws + WS_KV); const bf16* KRR = (const bf16*)(F.ws + WS_KRR); bf16* YC = (bf16*)(F.ws + WS_UB);
    for (int p = F.bid; p < 512; p += F.G) {
        const int bh = p >> 3, s = p & 7, b = bh >> 3, h = bh & 7;
        for (int half = 0; half < 2; ++half) { const int qb = half ? 15 - s : s; const size_t tok0 = (size_t)b * SEQ;
            AttnCfg cf;
            cf.Qp = Q + tok0 * 768 + h * 96; cf.qpitch = 768; cf.Kp = KV + tok0 * 1024 + h * 128; cf.kpitch = 1024; cf.K2p = KRR + tok0 * 32; cf.k2pitch = 32;
            cf.Vp = KV + tok0 * 1024 + h * 128 + 64; cf.vpitch = 1024; cf.Op = YC + tok0 * 512 + h * 64; cf.opitch = 512; cf.lsep = nullptr; cf.lsepitch = 0;
            cf.q0 = qb * 256; cf.kt_lo = 0; cf.kt_hi = (qb * 256 + 256) / 64; cf.band = 0;
            attn_unit<96>(cf, F.lds); }
    }
}

constexpr int PH_PER_LAYER = 9, N_PHASES = 2 + NLAYER * PH_PER_LAYER;
#ifndef ONLY_PH
#define ONLY_PH -1
#endif
#ifndef T1_SKEW
#define T1_SKEW 3
#endif
#ifndef PROBE_DUP
#define PROBE_DUP -1
#endif
#ifndef T1_ROT
#define T1_ROT 1
#endif
#ifndef F2_SKEW
#define F2_SKEW 0
#endif
#ifndef F3_SKEW
#define F3_SKEW 0
#endif
#ifndef PROBE_T
#define PROBE_T -1
#endif
#ifndef PROBE_K
#define PROBE_K 3
#endif
__global__ void __launch_bounds__(NTHR, 2) fwd_kernel(Args args) {
    extern __shared__ __attribute__((aligned(16))) unsigned char lds_raw[];
    Frame F;
    F.lds = (LAS unsigned char*)lds_raw;
    F.tid = threadIdx.x; F.lane = F.tid & 63; F.wave = __builtin_amdgcn_readfirstlane(F.tid >> 6); F.G = gridDim.x; F.bid = blockIdx.x;
    F.ws = args.ws; F.ctl = (unsigned*)(args.ws + WS_ZERO);
    volatile LAS unsigned* MISC = (volatile LAS unsigned*)(F.lds + MISC_OFF);
    for (int u = F.tid; u < (LDS_BYTES - LDSCTL_OFF) / 4; u += NTHR) ((LAS unsigned*)(F.lds + LDSCTL_OFF))[u] = 0u;
    __syncthreads();
#if PROBE_T >= 0
    if (blockIdx.x == 0 && threadIdx.x == 0) MISC[16] = (unsigned)__builtin_amdgcn_s_memrealtime();
#endif
    const int lo = args.ph_lo, hi = args.ph_hi;
    const bool multi = (hi - lo) > 1;
    XcdBarrier bar; bar.bar = F.ctl + CW_BAR; bar.x = 0; bar.st = nullptr;
    if (multi) bar = xcd_barrier_post(F.ctl + CW_BAR, MISC + 8);
#define EN(j) (ONLY_PH < 0 || ONLY_PH == (j))
#define REP(k) for (int rep_ = 0; rep_ < ((PROBE_DUP == (k)) ? 2 : 1); ++rep_)
#define PHASE_BEGIN() do { int t_ = threadIdx.x; asm volatile("" : "+v"(t_)); F.tid = t_; F.lane = t_ & 63; GAS unsigned char* w_ = (GAS unsigned char*)args.ws; asm volatile("" : "+s"(w_)); F.ws = (unsigned char*)w_; F.ctl = (unsigned*)F.ws; } while (0)
#define IN(k) (lo <= (k) && (k) < hi)
#define SEAM(k) do { if (IN(k) && IN((k) + 1)) xcd_barrier(bar); TPROBE(k); } while (0)
#if PROBE_T >= 0
#define TMATCH(k) ((k) < 2 ? (PROBE_T == 100 + (k)) : (((k) - 2) % PH_PER_LAYER == PROBE_T))
#define TPROBE(k) do { if (blockIdx.x == 0 && threadIdx.x == 0) { const unsigned t_ = (unsigned)__builtin_amdgcn_s_memrealtime(); if (TMATCH(k)) MISC[17] += t_ - MISC[16]; MISC[16] = t_; } } while (0)
#define TMARK(id) do { if (blockIdx.x == 0 && threadIdx.x == 0) { const unsigned t_ = (unsigned)__builtin_amdgcn_s_memrealtime(); if (PROBE_T == (id)) MISC[17] += t_ - MISC[16]; MISC[16] = t_; } } while (0)
#else
#define TPROBE(k) do {} while (0)
#define TMARK(id) do {} while (0)
#endif
#define Wb ((bf16*)(F.ws + WS_W))
    float* const dout = args.out; bf16* const xres = (bf16*)(args.ws + WS_X);
    if (EN(0) && IN(0)) { PHASE_BEGIN(); REP(0) { p0_phase(F, args); __syncthreads(); } REP(10) { convert_layer_weights(F, args, 0); __syncthreads(); } } SEAM(0);
    if (EN(1) && IN(1)) { PHASE_BEGIN(); ada_tables(F, args); REP(1) { norm_rows(F, args, args.in[0], 0, args.in[5], F.ws + WS_HIN); __syncthreads(); } } SEAM(1);
    for (int layer = 0; layer < NLAYER; ++layer) {
        const int pb = 2 + layer * PH_PER_LAYER;
        if (EN(2) && IN(pb + 0)) { PHASE_BEGIN(); for (int rep_ = 0; rep_ < ((PROBE_DUP == 2 || PROBE_DUP == 23) ? 2 : 1); ++rep_) {
            SchedDense S; S.init(WS_HIN, WS_W + WO_WIN, 1024, 1024, NTOK, NINP, F.G, F.bid, FP8_T1 ? 1 : 2); if (T1_ROT) S.rotate();
            EpiWin E{(bf16*)(F.ws + WS_QKV), (bf16*)(F.ws + WS_UB), (bf16*)(F.ws + WS_CQ), (bf16*)(F.ws + WS_CKV), (bf16*)(F.ws + WS_G), (float*)(F.ws + WS_SSQ), (float*)(F.ws + WS_SSKV), (PROBE_DUP == 23 && rep_ == 0) ? 1 : 0, FP8_T1 ? (const float*)(F.ws + WS_SA) : nullptr, (const float*)(F.ws + WS_SWIN)};
            if (PROBE_DUP == 21) { EpiWin Ed = E; Ed.dry = 1; pg8::gemm_phase<EpiWin, SchedDense, false, (FP8_T1 ? 1 : 2)>(F.lds, F.ws, pg8::Gemm{1024, 1024, 1024, T1_SKEW}, S, Ed); __syncthreads(); }
            pg8::gemm_phase<EpiWin, SchedDense, false, (FP8_T1 ? 1 : 2)>(F.lds, F.ws, pg8::Gemm{1024, 1024, 1024, T1_SKEW}, S, E); }
        } SEAM(pb + 0);
        if (EN(3) && IN(pb + 1)) { PHASE_BEGIN(); REP(3) {
            { SchedDense S; S.init(WS_CQ, WS_W + WO_WUQ, 512, 384, NTOK, 768, F.G, F.bid);
              EpiQ E{(bf16*)(F.ws + WS_Q), (const float*)(F.ws + WS_SSQ), (const float*)(F.ws + WS_ROPEC), (const float*)(F.ws + WS_ROPES)};
              pg8::gemm_phase<EpiQ, SchedDense, false>(F.lds, F.ws, pg8::Gemm{384, 512, 384}, S, E); }
            TMARK(201);
            { SchedDense S; S.init(WS_CKV, WS_W + WO_WKV, 256, 256, NTOK, 1024, F.G, F.bid);
              EpiKV E{(bf16*)(F.ws + WS_KV), (const float*)(F.ws + WS_SSKV)};
              pg8::gemm_phase<EpiKV, SchedDense, false>(F.lds, F.ws, pg8::Gemm{256, 256, 256}, S, E); }
            TMARK(202);
            REP(32) { krr_job(F); } REP(31) { pool_job(F); }
            __syncthreads(); TMARK(203); }
            if (PROBE_DUP == 30 && layer == 0) { dilated_units(F, (bf16*)dout, (float*)dout + 16 * MiB); __syncthreads(); }
            dilated_units(F, nullptr, nullptr);
        } SEAM(pb + 1);
        if (EN(4) && IN(pb + 2)) { PHASE_BEGIN(); REP(4) { mla_units(F); REP(41) { dil_combine_job(F); } } } SEAM(pb + 2);
        if (EN(5) && IN(pb + 3)) { PHASE_BEGIN(); REP(5) {
            SchedDense S; S.init(0, 0, 256, 256, NTOK, 1024, F.G, F.bid);
            const T5Seg s0{(unsigned)WS_CKV, (unsigned)(WS_W + WO_WOA), 256, 256}, s1{(unsigned)WS_POOL, (unsigned)(WS_W + WO_WPB), 512, 512}, s2{(unsigned)WS_UB, (unsigned)(WS_W + WO_WOC), 512, 512};
            gemm_t5_phase(F.lds, F.ws, s0, s1, s2, S, (const unsigned char*)(F.ws + WS_G), (bf16*)(F.ws + WS_KV)); }
        } SEAM(pb + 3);
        if (EN(6) && IN(pb + 4)) { PHASE_BEGIN(); for (int rep_ = 0; rep_ < ((PROBE_DUP == 6 && layer == 0) ? 2 : 1); ++rep_) {
            SchedDense S; S.init(WS_KV, WS_W + WO_WOUT, 1024, 1024, NTOK, 1024, F.G, F.bid);
            EpiRes E{layer == 0 ? args.in[0] : nullptr, xres, xres, (const float*)(F.ws + WS_GVT) + layer * NB * DM, (const float*)(F.ws + WS_GS2T) + layer * NB * DM, (float*)(F.ws + WS_XSS), (float*)(F.ws + WS_XMX)};
            pg8::gemm_phase<EpiRes, SchedDense, false>(F.lds, F.ws, pg8::Gemm{1024, 1024, 1024}, S, E); }
        } SEAM(pb + 4);
        if (EN(7) && IN(pb + 5)) { PHASE_BEGIN(); n2_route_phase(F, args, layer, xres); __syncthreads(); REP(7) { n2_convert_experts(F, args, layer); } } SEAM(pb + 5);
        if (EN(8) && IN(pb + 6)) { PHASE_BEGIN(); REP(8) {
            moe_tables(F, layer);
            LAS const int* PRE = (LAS const int*)(F.lds + MOE_OFF); LAS const int* CNT = PRE + 132;
            SchedMoe1 S{(unsigned)WS_H2, (unsigned)WS_WEXP13, (unsigned)(WS_W + WO_SH13), (const v2u*)(F.ws + WS_LISTS), PRE, CNT, F.G, F.bid, __builtin_amdgcn_readfirstlane(2 * PRE[NLIST]), F.lane};
            EpiAct E{F.ws + WS_ACT, (float*)(F.ws + WS_SACT), (LAS float*)(F.lds + LDSCTL_OFF + 8192), (const v2u*)(F.ws + WS_LISTS), CNT, (const float*)(F.ws + WS_SA2), (const float*)(F.ws + WS_SW13), (const float*)(F.ws + WS_SSH13)};
            pg8::gemm_phase<EpiAct, SchedMoe1, true, (FP8_F2 ? 1 : 2)>(F.lds, F.ws, pg8::Gemm{1024, 1024, 1024, F2_SKEW}, S, E); }
        } SEAM(pb + 6);
        if (EN(9) && IN(pb + 7)) { PHASE_BEGIN(); REP(9) {
            moe_tables(F, layer);
            LAS const int* PRE = (LAS const int*)(F.lds + MOE_OFF); LAS const int* CNT = PRE + 132;
            SchedMoe2 S{(unsigned)WS_ACT, (unsigned)WS_WEXP2, (unsigned)(WS_W + WO_SH2), PRE, F.G, F.bid, __builtin_amdgcn_readfirstlane(4 * PRE[NLIST]), F.lane, (const float*)(F.ws + WS_SACT)};
            EpiY E{F.ws + WS_YH, (bf16*)(F.ws + WS_SY), (const v2u*)(F.ws + WS_LISTS), CNT, 0, (const float*)(F.ws + WS_SACT), (const float*)(F.ws + WS_SW2), (const float*)(F.ws + WS_SSH2)};
            if (PROBE_DUP == 91) { EpiY Ed = E; Ed.mode = 1; pg8::gemm_phase<EpiY, SchedMoe2, false, 1, true>(F.lds, F.ws, pg8::Gemm{256, 256, 256}, S, Ed); __syncthreads(); }
            pg8::gemm_phase<EpiY, SchedMoe2, false, 1, true>(F.lds, F.ws, pg8::Gemm{256, 256, 256, F3_SKEW}, S, E); }
        } SEAM(pb + 7);
        if (EN(10) && IN(pb + 8)) { PHASE_BEGIN();
            combine_phase(F, args, layer, xres, dout);
            if (layer + 1 < NLAYER) { __syncthreads(); convert_layer_weights(F, args, layer + 1); }
        } SEAM(pb + 8);
    }
#if PROBE_T >= 0
    if (blockIdx.x == 0 && threadIdx.x == 0) { const unsigned d_ = MISC[17] * (unsigned)PROBE_K; const unsigned t0_ = (unsigned)__builtin_amdgcn_s_memrealtime();
        while ((unsigned)__builtin_amdgcn_s_memrealtime() - t0_ < d_) __builtin_amdgcn_s_sleep(32); }
#endif
#undef Wb
#undef IN
#undef SEAM
#undef EN
#undef REP
#undef PHASE_BEGIN
}

#ifndef MK_PER_PHASE
#define MK_PER_PHASE 0
#endif
extern "C" void kernel_launch(void* const* d_in, const int* in_sizes, int n_in, void* d_out, int out_size, void* d_ws, size_t ws_size, hipStream_t stream) {
    static int grid = 0;
    if (grid == 0) {
        if (n_in != 29 || out_size != NTOK * DM || ws_size < WS_END) { fprintf(stderr, "kernel_launch: unexpected problem (n_in %d, out %d, ws %zu < %zu)\n", n_in, out_size, ws_size, (size_t)WS_END); grid = -1; return; }
        int dev = 0, cus = 0, per_cu = 0;
        if (hipGetDevice(&dev) != hipSuccess || hipDeviceGetAttribute(&cus, hipDeviceAttributeMultiprocessorCount, dev) != hipSuccess) { grid = -1; return; }
        if (hipFuncSetAttribute((const void*)fwd_kernel, hipFuncAttributeMaxDynamicSharedMemorySize, LDS_BYTES) != hipSuccess) { fprintf(stderr, "kernel_launch: hipFuncSetAttribute failed\n"); grid = -1; return; }
        if (hipOccupancyMaxActiveBlocksPerMultiprocessor(&per_cu, (const void*)fwd_kernel, NTHR, LDS_BYTES) != hipSuccess || per_cu < 1) { fprintf(stderr, "kernel_launch: occupancy query says %d\n", per_cu); (void)hipGetLastError(); per_cu = 1; }
        grid = cus;
    }
    if (grid < 0) return;
    (void)hipMemsetAsync((char*)d_ws + WS_ZERO, 0, ZERO_BYTES, stream);
    Args a{};
    for (int i = 0; i < 29; ++i) a.in[i] = (const float*)d_in[i];
    a.pos = (const int*)d_in[2]; a.out = (float*)d_out; a.ws = (unsigned char*)d_ws;
#if MK_PER_PHASE
    for (int p = 0; p < N_PHASES; ++p) { a.ph_lo = p; a.ph_hi = p + 1; hipLaunchKernelGGL(fwd_kernel, dim3(grid), dim3(NTHR), LDS_BYTES, stream, a); }
#else
    a.ph_lo = 0; a.ph_hi = N_PHASES; hipLaunchKernelGGL(fwd_kernel, dim3(grid), dim3(NTHR), LDS_BYTES, stream, a);
#endif
}
```

```cpp
#define MK_PER_PHASE 0
#define T1_SKEW 0
#include <hip/hip_runtime.h>
#include <cstdio>
#include <cstdint>

#define GAS __attribute__((address_space(1)))
#define LAS __attribute__((address_space(3)))
typedef unsigned short bf16;
typedef unsigned v4u __attribute__((ext_vector_type(4)));
typedef unsigned v2u __attribute__((ext_vector_type(2)));
typedef float f32x4 __attribute__((ext_vector_type(4)));
typedef float f32x2 __attribute__((ext_vector_type(2)));
typedef float f32x16 __attribute__((ext_vector_type(16)));
typedef short bf16x8 __attribute__((ext_vector_type(8)));
typedef short s16x4 __attribute__((ext_vector_type(4)));
typedef GAS unsigned gu32;
#define RLX_AGENT __ATOMIC_RELAXED, __HIP_MEMORY_SCOPE_AGENT
#define LDS_WAIT() asm volatile("s_waitcnt lgkmcnt(0)" ::: "memory")
#define VM_WAIT() asm volatile("s_waitcnt vmcnt(0)" ::: "memory")
__device__ __forceinline__ unsigned f2bf(float f) { unsigned u = __builtin_bit_cast(unsigned, f); return (u + 0x7fffu + ((u >> 16) & 1u)) >> 16; }
__device__ __forceinline__ unsigned pk2(float lo, float hi) { return f2bf(lo) | (f2bf(hi) << 16); }
__device__ __forceinline__ float bf2f(unsigned b) { return __builtin_bit_cast(float, b << 16); }
__device__ __forceinline__ float bflo(unsigned w) { return __builtin_bit_cast(float, w << 16); }
__device__ __forceinline__ float bfhi(unsigned w) { return __builtin_bit_cast(float, w & 0xffff0000u); }
__device__ __forceinline__ unsigned cvt_pk_bf16(float lo, float hi) { unsigned r; asm volatile("v_cvt_pk_bf16_f32 %0, %1, %2" : "=v"(r) : "v"(lo), "v"(hi)); return r; }
__device__ __forceinline__ float wave_sum(float v) {
#pragma unroll
    for (int o = 1; o < 64; o <<= 1) v += __shfl_xor(v, o);
    return v;
}
#ifndef FP8_T1
#define FP8_T1 1
#endif
#ifndef FP8_F2
#define FP8_F2 1
#endif
__device__ __forceinline__ unsigned pk4_fp8(float a, float b, float c, float d) {
    a = __builtin_fminf(__builtin_fmaxf(a, -448.f), 448.f); b = __builtin_fminf(__builtin_fmaxf(b, -448.f), 448.f); c = __builtin_fminf(__builtin_fmaxf(c, -448.f), 448.f); d = __builtin_fminf(__builtin_fmaxf(d, -448.f), 448.f);
    unsigned w = 0u; w = __builtin_amdgcn_cvt_pk_fp8_f32(a, b, w, false); w = __builtin_amdgcn_cvt_pk_fp8_f32(c, d, w, true); return w; }
__device__ __forceinline__ unsigned pk4_i8(float a, float b, float c, float d, float inv) {
    const float M = 12582912.0f;
    const unsigned ua = __builtin_bit_cast(unsigned, __builtin_fmaf(a, inv, M)), ub = __builtin_bit_cast(unsigned, __builtin_fmaf(b, inv, M)), uc = __builtin_bit_cast(unsigned, __builtin_fmaf(c, inv, M)), ud = __builtin_bit_cast(unsigned, __builtin_fmaf(d, inv, M));
    const unsigned lo = __builtin_amdgcn_perm(ub, ua, 0x0c0c0400u), hi = __builtin_amdgcn_perm(ud, uc, 0x0c0c0400u);
    return __builtin_amdgcn_perm(hi, lo, 0x05040100u); }
__device__ __forceinline__ float wave_max(float v) {
#pragma unroll
    for (int o = 1; o < 64; o <<= 1) v = fmaxf(v, __shfl_xor(v, o));
    return v;
}
__device__ __forceinline__ float fsigmoid(float x) { return __builtin_amdgcn_rcpf(1.0f + __builtin_amdgcn_exp2f(-1.4426950408889634f * x)); }

namespace pg8 {
constexpr int BM = 256, BK = 64, HALF = 128, HTB = HALF * BK * 2  , STAGE_BYTES = 8 * HTB;
constexpr int ROWTAB_OFF = STAGE_BYTES + 4096;
__host__ __device__ __forceinline__ int lds_byte(int r, int c) { const int st = (r >> 4) * 2 + (c >> 5), rr = r & 15, cc = c & 31, ob = rr * 64 + cc * 2; return st * 1024 + (ob ^ (((ob >> 9) & 1) << 5)); }
__host__ __device__ __forceinline__ void stage_rc(int b, int& R, int& C) { const int st = b / 1024, sb = b % 1024, swz = sb ^ (((sb >> 9) & 1) << 5); R = (st >> 1) * 16 + swz / 64; C = (st & 1) * 32 + (swz % 64) / 2; }
__host__ __device__ __forceinline__ int perm32(int rho) { const int n = rho >> 4, i = rho & 15; return 8 * (i >> 2) + 4 * n + (i & 3); }

typedef int v8i __attribute__((ext_vector_type(8)));
typedef int v4i __attribute__((ext_vector_type(4)));
__device__ __forceinline__ v8i cat8(bf16x8 a, bf16x8 b) { const v4u x = __builtin_bit_cast(v4u, a), y = __builtin_bit_cast(v4u, b); return (v8i){(int)x.x, (int)x.y, (int)x.z, (int)x.w, (int)y.x, (int)y.y, (int)y.z, (int)y.w}; }
constexpr int F8_SCALE_ONE = 0x7f7f7f7f, F8_SCALE_W = 0x7a7a7a7a; constexpr float F8_WMUL = 32.0f;
struct Unit { int pm, pn, e, aux; };
struct Gemm { int K, lda, ldb; int skew = 0; };

struct PermNone { static constexpr bool PERM = false; static constexpr int B_PIECE = 64, B_HALF = 128; __device__ static __forceinline__ int bperm(int r) { return r; } };
struct Perm8 {
    static constexpr bool PERM = true; static constexpr int B_PIECE = 64, B_HALF = 128; __device__ static __forceinline__ int bperm(int r) { return (r & ~31) + perm32(r & 31); } };
struct Perm16 {
    static constexpr bool PERM = true; static constexpr int B_PIECE = 128, B_HALF = 8;
    __device__ static __forceinline__ int bperm(int r) { return 64 * ((r >> 5) & 3) + 16 * ((r & 15) >> 2) + 8 * (r >> 7) + 4 * ((r >> 4) & 1) + (r & 3); } };
#define PG8_USE_PERM(P) static constexpr bool PERM = pg8::P::PERM; static constexpr int B_PIECE = pg8::P::B_PIECE, B_HALF = pg8::P::B_HALF; __device__ static __forceinline__ int bperm(int r) { return pg8::P::bperm(r); }
template <class Epi, class Sched, bool GATHER, int ES = 2, bool KS = false>
__device__ __forceinline__ void gemm_phase(LAS unsigned char* lds, const unsigned char* base, const Gemm g, const Sched& S, const Epi& E) {
    const __amdgpu_buffer_rsrc_t rsrc = __builtin_amdgcn_make_buffer_rsrc((void*)base, 0, 0xffffffff, 0x00020000);
    int tid_ = threadIdx.x; asm volatile("" : "+v"(tid_));
    const int tid = tid_, wid = __builtin_amdgcn_readfirstlane(tid >> 6), lane = tid & 63, wr = wid >> 2, wc = wid & 3, fr = lane & 15, fq = lane >> 4;
    const int K = g.K, nt = K * ES / 128;
    int R0, C0;
    stage_rc(tid * 16, R0, C0); C0 *= 2;
    const int Rb0 = Epi::bperm(R0);
    const unsigned voffB = (unsigned)(Rb0 * g.ldb * ES + C0);
    const unsigned cvA0 = (unsigned)(R0 * g.lda * ES + C0);
    LAS unsigned* rowtab = (LAS unsigned*)(lds + ROWTAB_OFF);
    const unsigned pstepA = 64u * g.lda * ES, pstepB = (unsigned)Epi::B_PIECE * g.ldb * ES;
    const unsigned hstepA = GATHER ? 0u : (unsigned)HALF * g.lda * ES;
    const unsigned kstep = (unsigned)(BK * 2);
    const unsigned hstepB = (unsigned)Epi::B_HALF * g.ldb * ES;
    const unsigned ldsw = (unsigned)wid * 1024u;
    const int aoff = lds_byte(wr * 64 + fr, fq * 8), boff = lds_byte(wc * 32 + fr, fq * 8);
#define PG8_SA(b, h) (((b) * 2 + (h)) * HTB)
#define PG8_SB(b, h) ((4 + (b) * 2 + (h)) * HTB)
#define PG8_STAGEB(bufoff, goff) do { _Pragma("unroll") for (int _i = 0; _i < 2; ++_i) \
        __builtin_amdgcn_raw_ptr_buffer_load_lds(rsrc, (LAS void*)(lds + (bufoff) + ldsw + _i * 8192), 16, voffB, (goff) + _i * pstepB, 0, 0); } while (0)
#define PG8_STAGEA(bufoff, goff, PAR, h) do { _Pragma("unroll") for (int _i = 0; _i < 2; ++_i) { \
        if constexpr (GATHER) __builtin_amdgcn_raw_ptr_buffer_load_lds(rsrc, (LAS void*)(lds + (bufoff) + ldsw + _i * 8192), 16, rowtab[(PAR) * 256 + R0 + 64 * _i + HALF * (h)] + (unsigned)C0, (goff), 0, 0); \
        else __builtin_amdgcn_raw_ptr_buffer_load_lds(rsrc, (LAS void*)(lds + (bufoff) + ldsw + _i * 8192), 16, cvA0, (goff) + (h) * hstepA + _i * pstepA, 0, 0); } } while (0)
#define PG8_LDA(dst, b, h) do { _Pragma("unroll") for (int m = 0; m < 4; ++m) _Pragma("unroll") for (int k = 0; k < 2; ++k) dst[m][k] = *(const LAS bf16x8*)(lds + PG8_SA(b, h) + aoff + m * 2048 + k * 1024); } while (0)
#define PG8_LDB(dst, b, h) do { _Pragma("unroll") for (int n = 0; n < 2; ++n) _Pragma("unroll") for (int k = 0; k < 2; ++k) dst[n][k] = *(const LAS bf16x8*)(lds + PG8_SB(b, h) + boff + n * 2048 + k * 1024); } while (0)
#define PG8_MMA(ai, bj, At, Bt) do { __builtin_amdgcn_s_setprio(1); _Pragma("unroll") for (int m = 0; m < 4; ++m) _Pragma("unroll") for (int n = 0; n < 2; ++n) _Pragma("unroll") for (int k = 0; k < 2; ++k) { \
        if constexpr (ES == 2) acc[ai][bj][m][n] = __builtin_amdgcn_mfma_f32_16x16x32_bf16(Bt[n][k], At[m][k], acc[ai][bj][m][n], 0, 0, 0); \
        else acc[ai][bj][m][n] = __builtin_bit_cast(f32x4, __builtin_amdgcn_mfma_i32_16x16x64_i8(__builtin_bit_cast(pg8::v4i, Bt[n][k]), __builtin_bit_cast(pg8::v4i, At[m][k]), __builtin_bit_cast(pg8::v4i, acc[ai][bj][m][n]), 0, 0, 0)); } \
        __builtin_amdgcn_s_setprio(0); } while (0)
#define PG8_WAIT_V(n) asm volatile("s_waitcnt vmcnt(" #n ")" ::: "memory")
#define PG8_WAIT_L(n) asm volatile("s_waitcnt lgkmcnt(" #n ")" ::: "memory")
#define PG8_BAR __builtin_amdgcn_s_barrier()
#define PG8_SCHED __builtin_amdgcn_sched_barrier(0)
    Unit cur, nxt; int ui = 0; int later = 0;
    if (!S.next(0, cur)) return;
    if (g.skew > 0) { for (int i = 0; i < (int)(blockIdx.x & 7) * g.skew; ++i) __builtin_amdgcn_s_sleep(16); }

    f32x4 acc[2][2][4][2];
#pragma unroll
    for (int a = 0; a < 2; ++a)
#pragma unroll
        for (int b = 0; b < 2; ++b)
#pragma unroll
            for (int m = 0; m < 4; ++m)
#pragma unroll
                for (int n = 0; n < 2; ++n) acc[a][b][m][n] = (f32x4){0.f, 0.f, 0.f, 0.f};
    bf16x8 At[4][2], B0[2][2], B1[2][2];
    unsigned cA = S.a_off(cur), cB = S.b_off(cur);
    asm volatile("" : "+s"(cA), "+s"(cB));
    int par = 0;
#define PG8_NX1(p) ((p) == 2 ? 0 : (p) + 1)
    LAS float* kstab = (LAS float*)(lds + ROWTAB_OFF + 2048); int kpar = 0;
    if constexpr (KS) { if (tid < 256) { const f32x2 s = S.kscale(cur, tid); kstab[tid] = fminf(s.x * __builtin_amdgcn_rcpf(s.y), 1000.0f); } }
    if constexpr (GATHER) {
        Unit u1; const bool h1 = S.next(1, u1);
        if (tid < 256) { rowtab[tid] = S.a_rowoff(cur, tid); if (h1) rowtab[256 + tid] = S.a_rowoff(u1, tid); }
        asm volatile("s_waitcnt vmcnt(0) lgkmcnt(0)" ::: "memory"); __builtin_amdgcn_s_barrier(); asm volatile("" ::: "memory");
    }
    PG8_STAGEB(PG8_SB(0, 0), cB); PG8_STAGEB(PG8_SB(0, 1), cB + hstepB); PG8_STAGEA(PG8_SA(0, 0), cA, par, 0); PG8_STAGEA(PG8_SA(0, 1), cA, par, 1);
    if (wr == 1) PG8_BAR;
    PG8_WAIT_V(2); PG8_BAR;
    PG8_STAGEB(PG8_SB(1, 0), cB + kstep); PG8_STAGEA(PG8_SA(1, 0), cA + kstep, par, 0); PG8_STAGEB(PG8_SB(1, 1), cB + hstepB + kstep);
    PG8_WAIT_V(6); PG8_BAR;
    for (;;) {
        const bool has_next = S.next(ui + 1, nxt);
        const unsigned nA = has_next ? S.a_off(nxt) : cA, nB = has_next ? S.b_off(nxt) : cB;
        Unit nn; bool has_nn = false;
        if constexpr (GATHER) has_nn = has_next && S.next(ui + 2, nn);
#pragma unroll 1
        for (int t = 0; t < nt; t += 2) {
            const bool last = (t == nt - 2);
            const unsigned a1 = cA + (unsigned)(t + 1) * kstep;
            const unsigned a2 = last ? nA : cA + (unsigned)(t + 2) * kstep, b2 = last ? nB : cB + (unsigned)(t + 2) * kstep;
            const unsigned a3 = a2 + kstep, b3 = b2 + kstep;
            const int xpar = (GATHER && last && has_next) ? PG8_NX1(par) : par;
            const bool relax = (t == 0) && (later != 0);
            PG8_LDB(B0, 0, 0); PG8_LDB(B1, 0, 1); PG8_SCHED; PG8_LDA(At, 0, 0); PG8_STAGEA(PG8_SA(1, 1), a1, par, 1);
            if (!relax) PG8_WAIT_V(8);
            PG8_WAIT_L(0); PG8_BAR; PG8_MMA(0, 0, At, B0); PG8_MMA(0, 1, At, B1); PG8_BAR; PG8_SCHED;
            PG8_LDA(At, 0, 1); PG8_STAGEB(PG8_SB(0, 0), b2); PG8_STAGEB(PG8_SB(0, 1), b2 + hstepB); PG8_STAGEA(PG8_SA(0, 0), a2, xpar, 0);
            if (!relax) PG8_WAIT_V(8);
            PG8_WAIT_L(0); PG8_BAR; PG8_MMA(1, 0, At, B0); PG8_MMA(1, 1, At, B1); PG8_BAR; PG8_SCHED;
            if constexpr (KS) {
                int t3 = threadIdx.x; asm volatile("" : "+v"(t3)); const LAS float* kp = kstab + kpar * 256 + wr * 64 + (t3 & 15); float rs[8];
#pragma unroll
                for (int i = 0; i < 8; ++i) rs[i] = kp[(i >> 2) * 128 + (i & 3) * 16];
#pragma unroll
                for (int a = 0; a < 2; ++a)
#pragma unroll
                    for (int b = 0; b < 2; ++b)
#pragma unroll
                        for (int m = 0; m < 4; ++m)
#pragma unroll
                            for (int n = 0; n < 2; ++n) { const v4i iv = __builtin_bit_cast(v4i, acc[a][b][m][n]); const float r = rs[a * 4 + m];
                                acc[a][b][m][n] = __builtin_bit_cast(f32x4, (v4i){(int)((float)iv[0] * r), (int)((float)iv[1] * r), (int)((float)iv[2] * r), (int)((float)iv[3] * r)}); }
            }
            PG8_LDB(B0, 1, 0); PG8_LDB(B1, 1, 1); PG8_SCHED; PG8_LDA(At, 1, 0); PG8_STAGEA(PG8_SA(0, 1), a2, xpar, 1);
            PG8_WAIT_V(8); PG8_WAIT_L(0); PG8_BAR; PG8_MMA(0, 0, At, B0); PG8_MMA(0, 1, At, B1); PG8_BAR; PG8_SCHED;
            PG8_LDA(At, 1, 1); PG8_STAGEB(PG8_SB(1, 0), b3); PG8_STAGEB(PG8_SB(1, 1), b3 + hstepB); PG8_STAGEA(PG8_SA(1, 0), a3, xpar, 0);
            PG8_WAIT_V(8); PG8_WAIT_L(0); PG8_BAR; PG8_MMA(1, 0, At, B0); PG8_MMA(1, 1, At, B1); PG8_BAR; PG8_SCHED;
        }
        if (wr == 0) PG8_BAR;
        if constexpr (ES == 1) {
#pragma unroll
            for (int a = 0; a < 2; ++a)
#pragma unroll
                for (int b = 0; b < 2; ++b)
#pragma unroll
                    for (int m = 0; m < 4; ++m)
#pragma unroll
                        for (int n = 0; n < 2; ++n) { const v4i iv = __builtin_bit_cast(v4i, acc[a][b][m][n]); acc[a][b][m][n] = (f32x4){(float)iv[0], (float)iv[1], (float)iv[2], (float)iv[3]}; }
        }
        unsigned ro2 = 0u;
        if constexpr (GATHER) { if (has_nn) { int t4 = threadIdx.x; asm volatile("" : "+v"(t4)); ro2 = S.a_rowoff(nn, t4 & 255); } }
        f32x2 ksn = (f32x2){1.f, 1.f};
        if constexpr (KS) { if (has_next) { int t4 = threadIdx.x; asm volatile("" : "+v"(t4)); ksn = S.kscale(nxt, t4 & 255); } }
        { int t2 = threadIdx.x; asm volatile("" : "+v"(t2)); E(acc, cur, wr, wc, t2 & 15, (t2 & 63) >> 4); }
        if constexpr (KS) { if (has_next) { int t4 = threadIdx.x; asm volatile("" : "+v"(t4)); const float kr = fminf(ksn.x * __builtin_amdgcn_rcpf(ksn.y), 1000.0f); if (t4 < 256) kstab[(kpar ^ 1) * 256 + t4] = kr; } }
        if constexpr (GATHER) { if (has_nn) { asm volatile("" : "+v"(ro2)); int t4 = threadIdx.x; asm volatile("" : "+v"(t4)); if (t4 < 256) rowtab[PG8_NX1(PG8_NX1(par)) * 256 + t4] = ro2; } }
        if (!has_next) break;
#pragma unroll
        for (int a = 0; a < 2; ++a)
#pragma unroll
            for (int b = 0; b < 2; ++b)
#pragma unroll
                for (int m = 0; m < 4; ++m)
#pragma unroll
                    for (int n = 0; n < 2; ++n) acc[a][b][m][n] = (f32x4){0.f, 0.f, 0.f, 0.f};
        cur = nxt; cA = nA; cB = nB; ++ui; later = 1; asm volatile("" : "+s"(later));
        if constexpr (GATHER) par = PG8_NX1(par);
        if constexpr (KS) kpar ^= 1;
        if (wr == 1) PG8_BAR;
    }
    PG8_WAIT_V(0);
    PG8_BAR;
#undef PG8_NX1
#undef PG8_SA
#undef PG8_SB
#undef PG8_STAGEA
#undef PG8_STAGEB
#undef PG8_LDA
#undef PG8_LDB
#undef PG8_MMA
#undef PG8_WAIT_V
#undef PG8_WAIT_L
#undef PG8_BAR
#undef PG8_SCHED
}
}

constexpr int DM = 1024, NB = 8, SEQ = 4096, NTOK = NB * SEQ, NLAYER = 2;
constexpr int NIN = 6560, NINP = 6656;
constexpr int NWAVES = 8, NTHR = 512;
constexpr float EPSV = 1e-6f, LOG2E = 1.4426950408889634f;
constexpr float QA_SCALE = 0.125f * LOG2E;
constexpr float QC_SCALE = 0.10206207261596575f * LOG2E;
constexpr int LISTCAP = 16384, NLIST = 128;
constexpr int ACT_SH_ROW = 294912;

constexpr size_t MiB = 1u << 20;
constexpr size_t WS_ZERO = 0, ZERO_BYTES = 2 * MiB;
constexpr int CW_TMO = 0, CW_BAR = 4096, CW_GCNT = 8192;
constexpr size_t WS_ADA = 64 * 1024;
constexpr size_t WS_GVT = 1 * MiB, WS_GS2T = WS_GVT + 64 * 1024;
constexpr size_t WS_MISC = 2 * MiB;
constexpr size_t WS_ROPEC = WS_MISC, WS_ROPES = WS_MISC + 2 * MiB, WS_KRR = WS_MISC + 4 * MiB, WS_LSE = WS_MISC + 6 * MiB, WS_WK = WS_MISC + 8 * MiB;
constexpr size_t WS_SSQ = WS_MISC + 9 * MiB, WS_SSKV = WS_MISC + 10 * MiB + 512 * 1024;
constexpr size_t WS_SA = WS_MISC + 8 * MiB, WS_SA2 = WS_SA + 128 * 1024, WS_SWIN = WS_SA + 256 * 1024, WS_SSH13 = WS_SA + 288 * 1024, WS_SW13 = WS_SA + 320 * 1024;
constexpr size_t WS_SW2 = WS_SA + 448 * 1024, WS_SSH2 = WS_SW2 + 256 * 1024;
constexpr size_t WS_SACT = WS_KRR;
static_assert(WS_SSH2 + 4096 <= WS_SSQ && WS_SACT + 327680 * 8 <= WS_WK, "scale tables");
constexpr size_t WS_W = 14 * MiB;
constexpr size_t WO_WIN = 0, WO_WUQ = WO_WIN + (size_t)NINP * 1024 * 2, WO_WKV = WO_WUQ + 768 * 384 * 2, WO_WOA = WO_WKV + 1024 * 256 * 2, WO_WPB = WO_WOA + 1024 * 256 * 2,
                 WO_WOC = WO_WPB + 1024 * 512 * 2, WO_WOUT = WO_WOC + 1024 * 512 * 2, WO_SH13 = WO_WOUT + 1024 * 1024 * 2, WO_SH2 = WO_SH13 + 512 * 1024 * 2,
                 WO_RTH = WO_SH2 + 1024 * 256 * 2, WO_RTL = WO_RTH + 64 * 1024 * 2, WO_END = WO_RTL + 64 * 1024 * 2;
static_assert(WO_END <= 21 * MiB, "weight region");
constexpr size_t WS_X = 35 * MiB;
constexpr size_t WS_H = 163 * MiB;
constexpr size_t WS_Q = 99 * MiB, WS_H2 = 99 * MiB;
constexpr size_t WS_QKV = 195 * MiB;
constexpr size_t WS_G = 339 * MiB;
constexpr size_t WS_UB = 435 * MiB;
constexpr size_t WS_CQ = 467 * MiB;
constexpr size_t WS_CKV = 499 * MiB;
constexpr size_t WS_KV = 515 * MiB;
constexpr size_t WS_POOL = 579 * MiB;
constexpr size_t WS_WEXP13 = 131 * MiB, WS_WEXP2 = 163 * MiB;
constexpr size_t WS_ACT = 195 * MiB;
constexpr size_t WS_YH = 355 * MiB;
constexpr size_t WS_HIN = WS_H;
constexpr size_t WS_LISTS = 611 * MiB;
constexpr size_t WS_END = 627 * MiB;
constexpr size_t WS_SY = 99 * MiB;
constexpr size_t WS_XMX = WS_UB + 4 * MiB;
constexpr size_t WS_XSS = WS_UB;

constexpr int RING_BYTES = 131072;
constexpr int LDSCTL_OFF = RING_BYTES, MISC_OFF = LDSCTL_OFF + 320, MOE_OFF = LDSCTL_OFF + 1024;
static_assert(pg8::ROWTAB_OFF == LDSCTL_OFF + 4096 && pg8::ROWTAB_OFF + 4096 <= LDSCTL_OFF + 8192, "gathered-A row table (3 slots; the KS factors share its last KiB, never both in one phase) sits in the LDS control area below RMAX");
constexpr int LDS_BYTES = 147456;

#define XB_TMO      128
#define XB_XCNT(j)  (256  + 64 * (j))
#define XB_XSUB(j)  (1280 + 64 * (j))
#define XB_XGEN(j)  (2304 + 64 * (j))
#define XB_TOP      3328
#define XB_TOPGEN   3392
#define XCD_BAR_WORDS 3456
#define XB_SPIN_CAP (1u << 18)

__device__ __forceinline__ unsigned xb_ld(unsigned* p)              { return __hip_atomic_load(p, __ATOMIC_RELAXED, __HIP_MEMORY_SCOPE_AGENT); }
__device__ __forceinline__ unsigned xb_add(unsigned* p, unsigned v) { return __hip_atomic_fetch_add(p, v, __ATOMIC_RELAXED, __HIP_MEMORY_SCOPE_AGENT); }
__device__ __forceinline__ unsigned xb_xcc_id() { return (unsigned)__builtin_amdgcn_s_getreg((3 << 11) | 20) & 0xFu; }
#define XB_SPIN(cond, bar) do { unsigned _sp = 0; while (cond) { __builtin_amdgcn_s_sleep(1); \
    if ((++_sp & 255u) == 0u) { if (xb_ld(&(bar)[XB_TMO])) break; if (_sp > XB_SPIN_CAP) { atomicAdd(&(bar)[XB_TMO], 1u); break; } } } } while (0)

struct XcdBarrier {
    unsigned* bar; unsigned x;
    volatile LAS unsigned* st;
};

__device__ __forceinline__ XcdBarrier xcd_barrier_post(unsigned* bar, volatile LAS unsigned* st) {
    XcdBarrier b; b.bar = bar; b.x = xb_xcc_id(); b.st = st;
    if (threadIdx.x == 0) (void)xb_add(&bar[XB_XCNT(b.x)], 1u);
    return b;
}
__device__ __forceinline__ void xcd_barrier_complete(unsigned* bar, unsigned x, unsigned& nloc, unsigned& nx) {
    const unsigned G = gridDim.x * gridDim.y * gridDim.z;
    unsigned sum, cnt, mine, sp = 0u;
    for (;;) {
        sum = 0u; cnt = 0u; mine = 0u;
#pragma unroll
        for (unsigned j = 0; j < 16; ++j) { const unsigned c = xb_ld(&bar[XB_XCNT(j)]); sum += c; cnt += (c > 0u) ? 1u : 0u; mine = (j == x) ? c : mine; }
        if (sum == G) break;
        __builtin_amdgcn_s_sleep(1);
        if ((++sp & 255u) == 0u) { if (xb_ld(&bar[XB_TMO])) break; if (sp > XB_SPIN_CAP) { atomicAdd(&bar[XB_TMO], 1u); break; } }
    }
    nloc = mine > 0u ? mine : 1u; nx = cnt > 0u ? cnt : 1u;
}

__device__ __forceinline__ void xcd_barrier(const XcdBarrier& b) {
    asm volatile("s_waitcnt vmcnt(0)" ::: "memory");
    __syncthreads();
    if (threadIdx.x == 0) {
        unsigned* bar = b.bar;
        __builtin_amdgcn_s_waitcnt(0);
        unsigned nloc = b.st[0], nx = b.st[1];
        if (nloc == 0u) { xcd_barrier_complete(bar, b.x, nloc, nx); b.st[0] = nloc; b.st[1] = nx; }
        const unsigned old = xb_add(&bar[XB_XSUB(b.x)], 1u);
        const unsigned gen = old / nloc;
        if (old + 1u == (gen + 1u) * nloc) {
            __builtin_amdgcn_fence(__ATOMIC_RELEASE, "agent");
            asm volatile("s_waitcnt vmcnt(0)" ::: "memory");
            const unsigned og = xb_add(&bar[XB_TOP], 1u);
            const unsigned tg = og / nx;
            if (og + 1u == (tg + 1u) * nx) xb_add(&bar[XB_TOPGEN], 1u);
            else XB_SPIN(xb_ld(&bar[XB_TOPGEN]) == tg, bar);
            __builtin_amdgcn_fence(__ATOMIC_ACQUIRE, "agent");
            xb_add(&bar[XB_XGEN(b.x)], 1u);
            asm volatile("s_waitcnt vmcnt(0)" ::: "memory");
        } else {
            XB_SPIN(xb_ld(&bar[XB_XGEN(b.x)]) == gen, bar);
            __builtin_amdgcn_fence(__ATOMIC_ACQUIRE, "agent");
            asm volatile("s_waitcnt vmcnt(0)" ::: "memory");
        }
    }
    __syncthreads();
}


struct Args { const float* in[29]; const int* pos; float* out; unsigned char* ws; int ph_lo, ph_hi; };

struct Frame {
    LAS unsigned char* lds;
    unsigned* ctl; unsigned char* ws;
    int tid, lane, wave, G, bid;
};

__device__ __forceinline__ const float* ada_acc(const Frame& F, int j, int b) { return (const float*)(F.ws + WS_ADA) + ((size_t)j * NB + b) * 3072; }
__device__ __forceinline__ const float* ada_bias(const Args& A, int j) { return ((j & 1) ? A.in[18] : A.in[4]) + (size_t)(j >> 1) * 3072; }

template <int MODE>
__device__ __forceinline__ void tr_item_t(const float* src, int lds_n, int k0, int scol0, const float* kscale, bf16* dst, bf16* dst_lo, int ldd, int drow0, LAS float* scr, int lane, float mul = 1.0f) {
    const int lk = lane >> 3, ln4 = (lane & 7) * 4;
    f32x4 v[8];
#pragma unroll
    for (int i = 0; i < 8; ++i) { v[i] = (f32x4){0.f, 0.f, 0.f, 0.f};
        if (scol0 >= 0) { v[i] = *(const f32x4*)(src + (size_t)(k0 + 8 * i + lk) * lds_n + scol0 + ln4); if (kscale) v[i] = v[i] * kscale[k0 + 8 * i + lk]; } }
#pragma unroll
    for (int i = 0; i < 8; ++i)
#pragma unroll
        for (int c = 0; c < 4; ++c) scr[(ln4 + c) * 65 + 8 * i + lk] = v[i][c];
    LDS_WAIT(); asm volatile("" ::: "memory");
    const int rn = lane & 7, kc = lane >> 3;
#pragma unroll
    for (int j = 0; j < 4; ++j) { const LAS float* s = scr + (rn + 8 * j) * 65 + 8 * kc; float f[8];
#pragma unroll
        for (int q = 0; q < 8; ++q) f[q] = s[q];
        if (MODE == 2) { v2u o; o.x = pk4_fp8(f[0] * mul, f[1] * mul, f[2] * mul, f[3] * mul); o.y = pk4_fp8(f[4] * mul, f[5] * mul, f[6] * mul, f[7] * mul);
            *(v2u*)((unsigned char*)dst + (size_t)(drow0 + rn + 8 * j) * ldd + k0 + 8 * kc) = o; }
        else if (MODE == 0) { v4u o; o.x = pk2(f[0], f[1]); o.y = pk2(f[2], f[3]); o.z = pk2(f[4], f[5]); o.w = pk2(f[6], f[7]);
            *(v4u*)(dst + (size_t)(drow0 + rn + 8 * j) * ldd + k0 + 8 * kc) = o; }
        else { unsigned h[8]; float lo[8];
#pragma unroll
            for (int q = 0; q < 8; ++q) { h[q] = f2bf(f[q]); lo[q] = f[q] - bf2f(h[q]); }
            v4u o; o.x = h[0] | (h[1] << 16); o.y = h[2] | (h[3] << 16); o.z = h[4] | (h[5] << 16); o.w = h[6] | (h[7] << 16);
            *(v4u*)(dst + (size_t)(drow0 + rn + 8 * j) * ldd + k0 + 8 * kc) = o;
            v4u p; p.x = pk2(lo[0], lo[1]); p.y = pk2(lo[2], lo[3]); p.z = pk2(lo[4], lo[5]); p.w = pk2(lo[6], lo[7]);
            *(v4u*)(dst_lo + (size_t)(drow0 + rn + 8 * j) * ldd + k0 + 8 * kc) = p; } }
    LDS_WAIT(); asm volatile("" ::: "memory");
}
__device__ __forceinline__ void tr_item(const float* src, int lds_n, int k0, int scol0, const float* kscale, bf16* dst, int ldd, int drow0, LAS float* scr, int lane) {
    tr_item_t<0>(src, lds_n, k0, scol0, kscale, dst, nullptr, ldd, drow0, scr, lane); }
__device__ __forceinline__ void tr_item_fp8(const float* src, int lds_n, int k0, int scol0, unsigned char* dst, int ldd, int drow0, LAS float* scr, int lane, float mul) {
    tr_item_t<2>(src, lds_n, k0, scol0, nullptr, (bf16*)dst, nullptr, ldd, drow0, scr, lane, mul); }
__device__ __forceinline__ void tr_item_hilo(const float* src, int lds_n, int k0, int scol0, bf16* dhi, bf16* dlo, int ldd, int drow0, LAS float* scr, int lane) {
    tr_item_t<1>(src, lds_n, k0, scol0, nullptr, dhi, dlo, ldd, drow0, scr, lane); }

__device__ __forceinline__ void tr_cols_i8_wg(const float* src, int lds_n, int scol0, unsigned char* dst, int ldd, int drow0, float* scale_out, LAS float* scr, LAS float* CM, int wave, int lane) {
    const int lk = lane >> 3, ln4 = (lane & 7) * 4, kw = wave * 128;
    f32x4 v[16];
#pragma unroll
    for (int i = 0; i < 16; ++i) { v[i] = (f32x4){0.f, 0.f, 0.f, 0.f}; if (scol0 >= 0) v[i] = *(const f32x4*)(src + (size_t)(kw + 8 * i + lk) * lds_n + scol0 + ln4); }
    f32x4 mx = (f32x4){0.f, 0.f, 0.f, 0.f};
#pragma unroll
    for (int i = 0; i < 16; ++i) { mx[0] = fmaxf(mx[0], fabsf(v[i][0])); mx[1] = fmaxf(mx[1], fabsf(v[i][1])); mx[2] = fmaxf(mx[2], fabsf(v[i][2])); mx[3] = fmaxf(mx[3], fabsf(v[i][3])); }
#pragma unroll
    for (int o = 8; o < 64; o <<= 1) { mx[0] = fmaxf(mx[0], __shfl_xor(mx[0], o)); mx[1] = fmaxf(mx[1], __shfl_xor(mx[1], o)); mx[2] = fmaxf(mx[2], __shfl_xor(mx[2], o)); mx[3] = fmaxf(mx[3], __shfl_xor(mx[3], o)); }
    __syncthreads();
    if (lk == 0) *(LAS f32x4*)(CM + wave * 32 + ln4) = mx;
    __syncthreads();
    f32x4 m = *(const LAS f32x4*)(CM + ln4);
#pragma unroll
    for (int w = 1; w < 8; ++w) { const f32x4 t = *(const LAS f32x4*)(CM + w * 32 + ln4); m[0] = fmaxf(m[0], t[0]); m[1] = fmaxf(m[1], t[1]); m[2] = fmaxf(m[2], t[2]); m[3] = fmaxf(m[3], t[3]); }
    f32x4 inv;
#pragma unroll
    for (int cc = 0; cc < 4; ++cc) { const float mm = fmaxf(m[cc], 1e-30f); inv[cc] = (scol0 >= 0) ? 127.0f / mm : 0.f; }
    if (wave == 0 && lk == 0) *(f32x4*)(scale_out + drow0 + ln4) = (scol0 >= 0) ? (f32x4){fmaxf(m[0], 1e-30f), fmaxf(m[1], 1e-30f), fmaxf(m[2], 1e-30f), fmaxf(m[3], 1e-30f)} * (1.0f / 127.0f) : (f32x4){1.f, 1.f, 1.f, 1.f};
    const int rn = lane & 7, kc = lane >> 3;
#pragma unroll
    for (int h = 0; h < 2; ++h) {
#pragma unroll
        for (int i = 0; i < 8; ++i)
#pragma unroll
            for (int cc = 0; cc < 4; ++cc) scr[(ln4 + cc) * 65 + 8 * i + lk] = v[8 * h + i][cc] * inv[cc];
        LDS_WAIT(); asm volatile("" ::: "memory");
#pragma unroll
        for (int j = 0; j < 4; ++j) { const LAS float* s = scr + (rn + 8 * j) * 65 + 8 * kc;
            v2u o; o.x = pk4_i8(s[0], s[1], s[2], s[3], 1.0f); o.y = pk4_i8(s[4], s[5], s[6], s[7], 1.0f);
            *(v2u*)(dst + (size_t)(drow0 + rn + 8 * j) * ldd + kw + 64 * h + 8 * kc) = o; }
        LDS_WAIT(); asm volatile("" ::: "memory");
    }
}

__device__ __forceinline__ void tr_cols_i8_k256(const float* src, int lds_n, int scol0, unsigned char* dst, int drow0, float* scale_out, LAS float* scr, int lane) {
    const int lk = lane >> 3, ln4 = (lane & 7) * 4;
    f32x4 v[32];
#pragma unroll
    for (int i = 0; i < 32; ++i) v[i] = *(const f32x4*)(src + (size_t)(8 * i + lk) * lds_n + scol0 + ln4);
    f32x4 mx = (f32x4){0.f, 0.f, 0.f, 0.f};
#pragma unroll
    for (int i = 0; i < 32; ++i) { mx[0] = fmaxf(mx[0], fabsf(v[i][0])); mx[1] = fmaxf(mx[1], fabsf(v[i][1])); mx[2] = fmaxf(mx[2], fabsf(v[i][2])); mx[3] = fmaxf(mx[3], fabsf(v[i][3])); }
#pragma unroll
    for (int o = 8; o < 64; o <<= 1) { mx[0] = fmaxf(mx[0], __shfl_xor(mx[0], o)); mx[1] = fmaxf(mx[1], __shfl_xor(mx[1], o)); mx[2] = fmaxf(mx[2], __shfl_xor(mx[2], o)); mx[3] = fmaxf(mx[3], __shfl_xor(mx[3], o)); }
    f32x4 inv;
#pragma unroll
    for (int cc = 0; cc < 4; ++cc) { mx[cc] = fmaxf(mx[cc], 1e-30f); inv[cc] = 127.0f / mx[cc]; }
    if (lk == 0) *(f32x4*)(scale_out + drow0 + ln4) = mx * (1.0f / 127.0f);
    const int rn = lane & 7, kc = lane >> 3;
#pragma unroll
    for (int h = 0; h < 4; ++h) {
#pragma unroll
        for (int i = 0; i < 8; ++i)
#pragma unroll
            for (int cc = 0; cc < 4; ++cc) scr[(ln4 + cc) * 65 + 8 * i + lk] = v[8 * h + i][cc] * inv[cc];
        LDS_WAIT(); asm volatile("" ::: "memory");
#pragma unroll
        for (int j = 0; j < 4; ++j) { const LAS float* s = scr + (rn + 8 * j) * 65 + 8 * kc;
            v2u o; o.x = pk4_i8(s[0], s[1], s[2], s[3], 1.0f); o.y = pk4_i8(s[4], s[5], s[6], s[7], 1.0f);
            *(v2u*)(dst + (size_t)(drow0 + rn + 8 * j) * 256 + 64 * h + 8 * kc) = o; }
        LDS_WAIT(); asm volatile("" ::: "memory");
    }
}

__device__ __forceinline__ void sincos_d(float angf, float& s, float& c) {
    const double a = (double)angf;
    const double q = __builtin_rint(a * 0.63661977236758134308);
    double r = __builtin_fma(-q, 1.57079632679489655800e+00, a);
    r = __builtin_fma(-q, 6.12323399573676603587e-17, r);
    const double r2 = r * r;
    double sp = -2.50521083854417187751e-08;
    sp = __builtin_fma(sp, r2, 2.75573192239858906526e-06);
    sp = __builtin_fma(sp, r2, -1.98412698412698412698e-04);
    sp = __builtin_fma(sp, r2, 8.33333333333333333333e-03);
    sp = __builtin_fma(sp, r2, -1.66666666666666666667e-01);
    const double sr = __builtin_fma(sp * r2, r, r);
    double cp = 2.08767569878680989792e-09;
    cp = __builtin_fma(cp, r2, -2.75573192239858906526e-07);
    cp = __builtin_fma(cp, r2, 2.48015873015873015873e-05);
    cp = __builtin_fma(cp, r2, -1.38888888888888888889e-03);
    cp = __builtin_fma(cp, r2, 4.16666666666666666667e-02);
    cp = __builtin_fma(cp, r2, -0.5);
    const double cr = __builtin_fma(cp, r2, 1.0);
    const int qi = (int)q & 3;
    const double ss = (qi == 0) ? sr : (qi == 1) ? cr : (qi == 2) ? -sr : -cr;
    const double cc = (qi == 0) ? cr : (qi == 1) ? -sr : (qi == 2) ? -cr : sr;
    s = (float)ss; c = (float)cc;
}

__constant__ float ROPE_FREQ[16] = {1.0f, 0.5623413324356079f, 0.3162277638912201f, 0.17782793939113617f, 0.10000000149011612f, 0.05623413249850273f, 0.03162277489900589f, 0.017782794311642647f,
    0.009999999776482582f, 0.005623413249850273f, 0.003162277629598975f, 0.0017782794311642647f, 0.0010000000474974513f, 0.000562341301701963f, 0.0003162277571391314f, 0.00017782794020604342f};
__device__ __forceinline__ void p0_phase(const Frame& F, const Args& A) {
    LAS float* sc = (LAS float*)F.lds;
    const float* c = A.in[1];
    for (int i = F.tid; i < NB * DM; i += NTHR) { const float v = c[i]; sc[i] = v / (1.0f + __expf(-v)); }
    __syncthreads();
    float* ada = (float*)(F.ws + WS_ADA);
    for (int item = F.bid; item < 4 * 48; item += F.G) {
        const int j = item / 48, n = (item % 48) * 64 + (F.tid & 63), b = F.tid >> 6;
        const float* w = ((j & 1) ? A.in[17] : A.in[3]) + (size_t)(j >> 1) * DM * 3072 + n;
        float a0 = 0.f, a1 = 0.f, a2 = 0.f, a3 = 0.f;
        for (int k = 0; k < DM; k += 4) {
            a0 += sc[b * DM + k] * w[(size_t)k * 3072]; a1 += sc[b * DM + k + 1] * w[(size_t)(k + 1) * 3072];
            a2 += sc[b * DM + k + 2] * w[(size_t)(k + 2) * 3072]; a3 += sc[b * DM + k + 3] * w[(size_t)(k + 3) * 3072]; }
        ada[((size_t)j * NB + b) * 3072 + n] = (a0 + a1) + (a2 + a3);
    }
    float* rc = (float*)(F.ws + WS_ROPEC); float* rs = (float*)(F.ws + WS_ROPES);
    for (int idx = F.bid * NTHR + F.tid; idx < NTOK * 16; idx += F.G * NTHR) {
        const int tok = idx >> 4, i = idx & 15;
        const float freq = ROPE_FREQ[i];
        const float ang = (float)A.pos[tok] * freq;
        float s, cc; sincos_d(ang, s, cc); rc[idx] = cc; rs[idx] = s;
    }
}

__device__ __forceinline__ int map_win(int n) {
    return n < 3200 ? n : n < 3232 ? 3456 + (n - 3200) : n < 3328 ? -1 : n < 3584 ? 3200 + (n - 3328) : 3488 + (n - 3584);
}
__device__ __forceinline__ void norm_tables(const Frame& F, const Args& A, int j, const float* g, int b0, int nb, LAS float* GS, LAS float* SH) {
    const float* bias = ada_bias(A, j);
    for (int i = F.tid; i < nb * DM; i += NTHR) { const int b = i >> 10, k = i & 1023; const float* acc = ada_acc(F, j, b0 + b);
        GS[i] = g[k] * (1.0f + acc[1024 + k] + bias[1024 + k]); SH[i] = acc[k] + bias[k]; }
}
__device__ __forceinline__ void ada_tables(const Frame& F, const Args& A) {
    float* GV = (float*)(F.ws + WS_GVT); float* GS2 = (float*)(F.ws + WS_GS2T);
    for (int i = F.bid * NTHR + F.tid; i < NLAYER * NB * DM; i += F.G * NTHR) { const int l = i >> 13, b = (i >> 10) & 7, k = i & 1023;
        GV[i] = ada_acc(F, l * 2, b)[2048 + k] + ada_bias(A, l * 2)[2048 + k];
        GS2[i] = A.in[19][l * DM + k] * (1.0f + ada_acc(F, l * 2 + 1, b)[1024 + k] + ada_bias(A, l * 2 + 1)[1024 + k]); }
}
__device__ __forceinline__ void norm_rows(const Frame& F, const Args& A, const float* x, int j, const float* g, unsigned char* H) {
    LAS float* GS = (LAS float*)F.lds; LAS float* SH = GS + NB * DM;
    __syncthreads();
    norm_tables(F, A, j, g, 0, NB, GS, SH);
    __syncthreads();
    const int gw = F.bid * NWAVES + F.wave, NGW = F.G * NWAVES;
    for (int m0 = gw * 4; m0 < NTOK; m0 += NGW * 4) {
        f32x4 v[4][4];
#pragma unroll
        for (int r = 0; r < 4; ++r) { const f32x4* xr = (const f32x4*)(x + (size_t)(m0 + r) * DM) + F.lane;
#pragma unroll
            for (int q = 0; q < 4; ++q) v[r][q] = xr[64 * q]; }
#pragma unroll
        for (int r = 0; r < 4; ++r) { const int m = m0 + r, b = m >> 12; float s = 0.f;
#pragma unroll
            for (int q = 0; q < 4; ++q) s += (v[r][q].x * v[r][q].x + v[r][q].y * v[r][q].y) + (v[r][q].z * v[r][q].z + v[r][q].w * v[r][q].w);
            const float rstd = 1.0f / sqrtf(wave_sum(s) * (1.0f / DM) + EPSV);
            f32x4 h[4]; float am = 0.f;
#pragma unroll
            for (int q = 0; q < 4; ++q) { const int col = 4 * F.lane + 256 * q;
                h[q] = (v[r][q] * rstd) * *(LAS const f32x4*)(GS + b * DM + col) + *(LAS const f32x4*)(SH + b * DM + col);
                am = fmaxf(am, fmaxf(fmaxf(fabsf(h[q].x), fabsf(h[q].y)), fmaxf(fabsf(h[q].z), fabsf(h[q].w)))); }
            if (FP8_T1) { am = fmaxf(wave_max(am), 1e-20f); const float inv = 127.0f / am; if (F.lane == 0) ((float*)(F.ws + WS_SA))[m] = am * (1.0f / 127.0f);
                unsigned* o4 = (unsigned*)(H + (size_t)m * DM) + F.lane;
#pragma unroll
                for (int q = 0; q < 4; ++q) o4[64 * q] = pk4_i8(h[q].x, h[q].y, h[q].z, h[q].w, inv); }
            else {
#pragma unroll
                for (int q = 0; q < 4; ++q) ((unsigned long long*)(H + (size_t)m * DM * 2) + F.lane)[64 * q] = (unsigned long long)pk2(h[q].x, h[q].y) | ((unsigned long long)pk2(h[q].z, h[q].w) << 32); } }
    }
}
__device__ __forceinline__ void convert_layer_weights(const Frame& F, const Args& A, int layer) {
    bf16* Wb = (bf16*)(F.ws + WS_W);
    LAS float* scr = (LAS float*)(F.lds + F.wave * 16384);
    const int gw = F.bid * NWAVES + F.wave, NGW = F.G * NWAVES;
    const float* w_in = A.in[6] + (size_t)layer * DM * NIN;
    const float* w_uq = A.in[11] + (size_t)layer * 384 * 768;   const float* cq_g = A.in[9] + layer * 384;
    const float* w_ukv = A.in[12] + (size_t)layer * 256 * 1024; const float* ckv_g = A.in[10] + layer * 256;
    const float* w_oa = A.in[13] + (size_t)layer * 256 * 1024;
    const float* w_ob = A.in[14] + (size_t)layer * 512 * 1024;
    const float* w_oc = A.in[15] + (size_t)layer * 512 * 1024;
    const float* w_out = A.in[16] + (size_t)layer * 1024 * 1024;
    const float* rt_w = A.in[20] + (size_t)layer * 1024 * 64;
    const float* sh1 = A.in[25] + (size_t)layer * 1024 * 256; const float* sh3 = A.in[26] + (size_t)layer * 1024 * 256; const float* sh2 = A.in[27] + (size_t)layer * 256 * 1024;
    constexpr int I_WIN = FP8_T1 ? 0 : 208 * 16, I_WUQ = 24 * 6, I_WKV = 32 * 4, I_WOA = 32 * 4, I_WOC = 32 * 8, I_WOUT = 32 * 16, I_SH13 = FP8_F2 ? 0 : 16 * 16, I_SH2 = 32, I_RT = 2 * 16;
    constexpr int NITEMS = I_WIN + I_WUQ + I_WKV + I_WOA + I_WOC + I_WOUT + I_SH13 + I_SH2 + I_RT;
    { LAS float* CM = (LAS float*)(F.lds + 12288);
      for (int it = F.bid; it < (FP8_T1 ? 208 : 0) + (FP8_F2 ? 16 : 0); it += F.G) {
        if (FP8_T1 && it < 208) tr_cols_i8_wg(w_in, NIN, map_win(it * 32), (unsigned char*)Wb + WO_WIN, 1024, it * 32, (float*)(F.ws + WS_SWIN), scr, CM, F.wave, F.lane);
        else { const int n0 = (it - (FP8_T1 ? 208 : 0)) * 32, hh = n0 >> 8, rr = n0 & 255;
            tr_cols_i8_wg(rr < 128 ? sh1 : sh3, 256, hh * 128 + (rr & 127), (unsigned char*)Wb + WO_SH13, 1024, n0, (float*)(F.ws + WS_SSH13), scr, CM, F.wave, F.lane); } }
      __syncthreads(); }
    for (int it = gw; it < NITEMS; it += NGW) {
        int r = it;
        if (r < I_WIN) { const int kb = r / 208, nb = r % 208; tr_item(w_in, NIN, kb * 64, map_win(nb * 32), nullptr, (bf16*)((char*)Wb + WO_WIN), 1024, nb * 32, scr, F.lane); continue; } r -= I_WIN;
        if (r < I_WUQ) { const int kb = r / 24, nb = r % 24; tr_item(w_uq, 768, kb * 64, nb * 32, cq_g, (bf16*)((char*)Wb + WO_WUQ), 384, nb * 32, scr, F.lane); continue; } r -= I_WUQ;
        if (r < I_WKV) { const int kb = r / 32, nb = r % 32; tr_item(w_ukv, 1024, kb * 64, nb * 32, ckv_g, (bf16*)((char*)Wb + WO_WKV), 256, nb * 32, scr, F.lane); continue; } r -= I_WKV;
        if (r < I_WOA) { const int kb = r / 32, nb = r % 32; tr_item(w_oa, 1024, kb * 64, nb * 32, nullptr, (bf16*)((char*)Wb + WO_WOA), 256, nb * 32, scr, F.lane); continue; } r -= I_WOA;
        if (r < I_WOC) { const int kb = r / 32, nb = r % 32; tr_item(w_oc, 1024, kb * 64, nb * 32, nullptr, (bf16*)((char*)Wb + WO_WOC), 512, nb * 32, scr, F.lane); continue; } r -= I_WOC;
        if (r < I_WOUT) { const int kb = r / 32, nb = r % 32; tr_item(w_out, 1024, kb * 64, nb * 32, nullptr, (bf16*)((char*)Wb + WO_WOUT), 1024, nb * 32, scr, F.lane); continue; } r -= I_WOUT;
        if (r < I_SH13) { const int kb = r / 16, nb = r % 16, n0 = nb * 32, hh = n0 >> 8, rr = n0 & 255;
            tr_item(rr < 128 ? sh1 : sh3, 256, kb * 64, hh * 128 + (rr & 127), nullptr, (bf16*)((char*)Wb + WO_SH13), 1024, n0, scr, F.lane); continue; } r -= I_SH13;
        if (r < I_SH2) { tr_cols_i8_k256(sh2, 1024, r * 32, (unsigned char*)Wb + WO_SH2, r * 32, (float*)(F.ws + WS_SSH2), scr, F.lane); continue; } r -= I_SH2;
        { const int kb = r / 2, nb = r % 2; tr_item_hilo(rt_w, 64, kb * 64, nb * 32, (bf16*)((char*)Wb + WO_RTH), (bf16*)((char*)Wb + WO_RTL), 1024, nb * 32, scr, F.lane); }
    }
    { const float* pw = A.in[7] + (size_t)layer * 4 * 128 * 128; const float* ps = A.in[8] + layer * 512; bf16* WPB = (bf16*)((char*)Wb + WO_WPB);
      for (int it = gw; it < 4 * 16 * 16; it += NGW) {
        const int g = it >> 8, c8 = (it >> 4) & 15, n = (it & 15) * 64 + F.lane;
        float pv[8][2];
#pragma unroll
        for (int q = 0; q < 8; ++q)
#pragma unroll
            for (int h = 0; h < 2; ++h) pv[q][h] = pw[((size_t)g * 128 + c8 * 8 + q) * 128 + h * 64 + F.lane] * ps[g * 128 + h * 64 + F.lane];
        float acc[8];
#pragma unroll
        for (int q = 0; q < 8; ++q) acc[q] = 0.f;
#pragma unroll
        for (int h = 0; h < 2; ++h)
#pragma unroll 16
            for (int dd = 0; dd < 64; ++dd) { const float wv = w_ob[(size_t)(g * 128 + h * 64 + dd) * 1024 + n];
#pragma unroll
                for (int q = 0; q < 8; ++q) acc[q] += __builtin_bit_cast(float, __builtin_amdgcn_readlane(__builtin_bit_cast(int, pv[q][h]), dd)) * wv; }
        v4u o; o.x = pk2(acc[0], acc[1]); o.y = pk2(acc[2], acc[3]); o.z = pk2(acc[4], acc[5]); o.w = pk2(acc[6], acc[7]);
        *(v4u*)(WPB + (size_t)n * 512 + g * 128 + c8 * 8) = o; } }
}

struct SchedDense {
    unsigned A, Bt; int lda, ldb; int nM, nN, nwg, G, c, es; int nr = 0, rot = 0;
    __device__ __forceinline__ void init(size_t A_, size_t Bt_, int lda_, int ldb_, int M, int N, int G_, int c_, int es_ = 2) { A = (unsigned)A_; Bt = (unsigned)Bt_; lda = lda_; ldb = ldb_; es = es_; nM = M / 256; nN = N / 256; nwg = nM * nN; G = G_; c = c_; nr = 0; rot = 0; }
    __device__ __forceinline__ void rotate() { if (nwg % G == 0) { nr = nwg / G; rot = ((c & 7) * nr) >> 3; } }
    __device__ __forceinline__ bool next(int i, pg8::Unit& u) const {
        if (nr) { if (i >= nr) return false; i += rot; if (i >= nr) i -= nr; }
        const long L = (long)i * G + c; if (L >= nwg) return false;
        int wgid = (int)L; { const int q = nwg / 8, r = nwg % 8, xcd = wgid % 8, off = wgid / 8; wgid = (xcd < r ? xcd * (q + 1) : r * (q + 1) + (xcd - r) * q) + off; }
        const int nig = 8 * nN, gid = wgid / nig, fm = gid * 8, gsz = (nM - fm) < 8 ? (nM - fm) : 8;
        u.pm = fm + ((wgid % nig) % gsz); u.pn = (wgid % nig) / gsz; u.e = 0; u.aux = 0; return true;
    }
    __device__ __forceinline__ unsigned a_off(const pg8::Unit& u) const { return A + (unsigned)u.pm * 256u * lda * es; }
    __device__ __forceinline__ unsigned b_off(const pg8::Unit& u) const { return Bt + (unsigned)u.pn * 256u * ldb * es; }
    __device__ __forceinline__ unsigned a_rowoff(const pg8::Unit&, int) const { return 0u; }
};

#define OPAQUE_V(v) asm volatile("" : "+v"(v))
struct EpiWin {
    PG8_USE_PERM(Perm8)
    bf16 *QKV, *UB, *CQ, *CKV, *GT; float *SSQ, *SSKV; int dry; const float *SA, *SW;
    __device__ __forceinline__ void operator()(f32x4 (&acc)[2][2][4][2], const pg8::Unit& u, int wr, int wc, int fr, int fq) const {
        if (dry) { float s = 0.f;
#pragma unroll
            for (int ai = 0; ai < 2; ++ai)
#pragma unroll
                for (int m = 0; m < 4; ++m) s += acc[ai][0][m][0][0] + acc[ai][1][m][1][3];
            if (s == 1.2345e-33f) SSQ[0] = 1.f; return; }
        const int pn = u.pn, rowU = u.pm * 256 + wr * 64;
        bf16* base; int pitch, colt, mode = 0; float scl = 1.f; float* ss = nullptr; int ssb = 2, sspitch = 12, ssslot = 0;
        if (pn < 9) { base = QKV; pitch = 2304; colt = pn * 256; if (pn < 3) scl = QA_SCALE; }
        else if (pn < 11) { base = UB; pitch = 512; colt = (pn - 9) * 256; }
        else if (pn < 13) { base = CQ; pitch = 512; colt = (pn - 11) * 256; ss = SSQ; ssb = (pn == 11) ? 2 : 1; ssslot = (pn == 11) ? 0 : 8; }
        else if (pn == 13) { base = CKV; pitch = 256; colt = 0; ss = SSKV; sspitch = 8; }
        else { base = GT; pitch = 3072; colt = (pn - 14) * 256; mode = 1; }
        const unsigned esz = (mode == 1) ? 1u : 2u;
        unsigned lo = (unsigned)(fr * pitch + 8 * fq) * esz; OPAQUE_V(lo);
        unsigned lr4 = (unsigned)fr * 4u; OPAQUE_V(lr4); unsigned lc4 = (unsigned)(8 * fq) * 4u; OPAQUE_V(lc4);
        f32x4 sw[2][2];
#pragma unroll
        for (int bj = 0; bj < 2; ++bj) { const char* sp = (const char*)(SW + pn * 256 + bj * 128 + wc * 32) + lc4; sw[bj][0] = SA ? *(const f32x4*)sp : (f32x4){1.f, 1.f, 1.f, 1.f}; sw[bj][1] = SA ? *(const f32x4*)(sp + 16) : (f32x4){1.f, 1.f, 1.f, 1.f}; }
        char* ub = (char*)base + ((size_t)rowU * pitch + colt + wc * 32) * esz;
        unsigned ll4 = (unsigned)(fq * 16 + fr) * 4u; OPAQUE_V(ll4);
        float sah[2];
#pragma unroll
        for (int ai = 0; ai < 2; ++ai) sah[ai] = SA ? *(const float*)((const char*)(SA + rowU + ai * 128) + ll4) : 1.f;
#pragma unroll
        for (int ai = 0; ai < 2; ++ai)
#pragma unroll
            for (int bj = 0; bj < 2; ++bj)
#pragma unroll
                for (int m = 0; m < 4; ++m) { acc[ai][bj][m][0] = acc[ai][bj][m][0] * sw[bj][0]; acc[ai][bj][m][1] = acc[ai][bj][m][1] * sw[bj][1]; }
#pragma unroll
        for (int ai = 0; ai < 2; ++ai)
#pragma unroll
            for (int m = 0; m < 4; ++m) { char* rb = ub + (size_t)(ai * 128 + m * 16) * pitch * esz; float sq[2] = {0.f, 0.f};
                const float sa = __shfl(sah[ai], m * 16 + fr);
#pragma unroll
                for (int bj = 0; bj < 2; ++bj) { f32x4 v0 = acc[ai][bj][m][0] * sa, v1 = acc[ai][bj][m][1] * sa;
                    sq[bj] = (v0[0] * v0[0] + v0[1] * v0[1]) + (v0[2] * v0[2] + v0[3] * v0[3]) + (v1[0] * v1[0] + v1[1] * v1[1]) + (v1[2] * v1[2] + v1[3] * v1[3]);
                    if (mode == 1) {
                        unsigned q0[4], q1[4];
#pragma unroll
                        for (int q = 0; q < 4; ++q) { q0[q] = (unsigned)fmaxf(fsigmoid(v0[q]) * 255.0f + 0.5f, 1.0f); q1[q] = (unsigned)fmaxf(fsigmoid(v1[q]) * 255.0f + 0.5f, 1.0f); }
                        v2u w8; w8.x = q0[0] | (q0[1] << 8) | (q0[2] << 16) | (q0[3] << 24); w8.y = q1[0] | (q1[1] << 8) | (q1[2] << 16) | (q1[3] << 24);
                        *(v2u*)(rb + bj * 128 + lo) = w8; continue; }
                    v0 = v0 * scl; v1 = v1 * scl;
                    v4u w; w.x = cvt_pk_bf16(v0[0], v0[1]); w.y = cvt_pk_bf16(v0[2], v0[3]); w.z = cvt_pk_bf16(v1[0], v1[1]); w.w = cvt_pk_bf16(v1[2], v1[3]);
                    *(v4u*)(rb + bj * 256 + lo) = w; }
                if (ss) {
#pragma unroll
                    for (int bj = 0; bj < 2; ++bj) { float s = sq[bj]; s += __shfl_xor(s, 16); s += __shfl_xor(s, 32);
                        if (fq == 0 && bj < ssb) ss[(size_t)(rowU + ai * 128 + m * 16 + fr) * sspitch + ssslot + 4 * bj + wc] = s; } } }
    }
};
struct EpiQ {
    PG8_USE_PERM(Perm8)
    bf16* Q; const float* SSQ; const float *RC, *RS;
    __device__ __forceinline__ void operator()(const f32x4 (&acc)[2][2][4][2], const pg8::Unit& u, int wr, int wc, int fr, int fq) const {
        const int rowU = u.pm * 256 + wr * 64;
        unsigned lo = (unsigned)(fr * 768 + 8 * fq) * 2u; OPAQUE_V(lo);
        unsigned lr = (unsigned)fr * 48u; OPAQUE_V(lr);
        unsigned lt = (unsigned)(fr * 16 + 8 * (fq & 1)) * 4u; OPAQUE_V(lt);
        char* ub = (char*)Q + ((size_t)rowU * 768 + u.pn * 256 + wc * 32) * 2;
        float rsh[2];
        { unsigned ll = (unsigned)(fq * 16 + fr) * 48u; OPAQUE_V(ll); f32x4 pa[2], pb[2], pc[2];
#pragma unroll
          for (int ai = 0; ai < 2; ++ai) { const f32x4* sp = (const f32x4*)((const char*)(SSQ + (size_t)(rowU + ai * 128) * 12) + ll); pa[ai] = sp[0]; pb[ai] = sp[1]; pc[ai] = sp[2]; }
#pragma unroll
          for (int ai = 0; ai < 2; ++ai) { const float ssum = (((pa[ai][0] + pa[ai][1]) + (pa[ai][2] + pa[ai][3])) + ((pb[ai][0] + pb[ai][1]) + (pb[ai][2] + pb[ai][3]))) + ((pc[ai][0] + pc[ai][1]) + (pc[ai][2] + pc[ai][3]));
              rsh[ai] = QC_SCALE / sqrtf(ssum * (1.0f / 384.0f) + EPSV); } }
        const int g32a = u.pn * 8 + wc, ropebj = (g32a % 3 == 2) ? 0 : ((g32a + 4) % 3 == 2) ? 1 : -1;
#pragma unroll
        for (int ai = 0; ai < 2; ++ai)
#pragma unroll
        for (int mh = 0; mh < 2; ++mh) {
            f32x4 tc0[2], tc1[2], ts0[2], ts1[2];
            if (ropebj >= 0) {
#pragma unroll
                for (int mm = 0; mm < 2; ++mm) { const int rU = rowU + ai * 128 + (mh * 2 + mm) * 16; const char* tc = (const char*)(RC + (size_t)rU * 16) + lt; const char* ts = (const char*)(RS + (size_t)rU * 16) + lt;
                    tc0[mm] = *(const f32x4*)tc; tc1[mm] = *(const f32x4*)(tc + 16); ts0[mm] = *(const f32x4*)ts; ts1[mm] = *(const f32x4*)(ts + 16); }
            }
#pragma unroll
            for (int mm = 0; mm < 2; ++mm) { const int m = mh * 2 + mm; char* rb = ub + (size_t)(ai * 128 + m * 16) * 768 * 2;
                const float rs = __shfl(rsh[ai], m * 16 + fr);
#pragma unroll
                for (int bj = 0; bj < 2; ++bj) { f32x4 v0 = acc[ai][bj][m][0] * rs, v1 = acc[ai][bj][m][1] * rs;
                    if (bj == ropebj) {
                        const f32x4 c0 = tc0[mm], c1 = tc1[mm], s0 = ts0[mm], s1 = ts1[mm];
                        f32x4 p0, p1;
#pragma unroll
                        for (int q = 0; q < 4; ++q) { p0[q] = __shfl_xor(v0[q], 32); p1[q] = __shfl_xor(v1[q], 32); }
                        if (fq < 2) { v0 = v0 * c0 - p0 * s0; v1 = v1 * c1 - p1 * s1; } else { v0 = v0 * c0 + p0 * s0; v1 = v1 * c1 + p1 * s1; }
                    }
                    v4u w; w.x = cvt_pk_bf16(v0[0], v0[1]); w.y = cvt_pk_bf16(v0[2], v0[3]); w.z = cvt_pk_bf16(v1[0], v1[1]); w.w = cvt_pk_bf16(v1[2], v1[3]);
                    *(v4u*)(rb + bj * 256 + lo) = w; } }
            asm volatile("" ::: "memory"); }
    }
};
struct EpiKV {
    PG8_USE_PERM(Perm8)
    bf16* KV; const float* SSKV;
    __device__ __forceinline__ void operator()(const f32x4 (&acc)[2][2][4][2], const pg8::Unit& u, int wr, int wc, int fr, int fq) const {
        const int rowU = u.pm * 256 + wr * 64;
        unsigned lo = (unsigned)(fr * 1024 + 8 * fq) * 2u; OPAQUE_V(lo);
        unsigned lr = (unsigned)fr * 32u; OPAQUE_V(lr);
        char* ub = (char*)KV + ((size_t)rowU * 1024 + u.pn * 256 + wc * 32) * 2;
        float rsh[2];
        { unsigned ll = (unsigned)(fq * 16 + fr) * 32u; OPAQUE_V(ll); f32x4 pa[2], pb[2];
#pragma unroll
          for (int ai = 0; ai < 2; ++ai) { const f32x4* sp = (const f32x4*)((const char*)(SSKV + (size_t)(rowU + ai * 128) * 8) + ll); pa[ai] = sp[0]; pb[ai] = sp[1]; }
#pragma unroll
          for (int ai = 0; ai < 2; ++ai) { const float ssum = ((pa[ai][0] + pa[ai][1]) + (pa[ai][2] + pa[ai][3])) + ((pb[ai][0] + pb[ai][1]) + (pb[ai][2] + pb[ai][3])); rsh[ai] = 1.0f / sqrtf(ssum * (1.0f / 256.0f) + EPSV); } }
#pragma unroll
        for (int ai = 0; ai < 2; ++ai)
#pragma unroll
            for (int m = 0; m < 4; ++m) { char* rb = ub + (size_t)(ai * 128 + m * 16) * 1024 * 2;
                const float rs = __shfl(rsh[ai], m * 16 + fr);
#pragma unroll
                for (int bj = 0; bj < 2; ++bj) { const f32x4 v0 = acc[ai][bj][m][0] * rs, v1 = acc[ai][bj][m][1] * rs;
                    v4u w; w.x = cvt_pk_bf16(v0[0], v0[1]); w.y = cvt_pk_bf16(v0[2], v0[3]); w.z = cvt_pk_bf16(v1[0], v1[1]); w.w = cvt_pk_bf16(v1[2], v1[3]);
                    *(v4u*)(rb + bj * 256 + lo) = w; }
                if (m & 1) asm volatile("" ::: "memory"); }
    }
};
template <int MODE> struct EpiGate {
    PG8_USE_PERM(Perm8)
    bf16* MIX; const bf16* GT;
    __device__ __forceinline__ void operator()(const f32x4 (&acc)[2][2][4][2], const pg8::Unit& u, int wr, int wc, int fr, int fq) const {
        const int rowU = u.pm * 256 + wr * 64, colU = u.pn * 256 + wc * 32;
        unsigned lg = (unsigned)(fr * 3072 + 8 * fq) * 2u; OPAQUE_V(lg);
        unsigned lm = (unsigned)(fr * 1024 + 8 * fq) * 2u; OPAQUE_V(lm);
        const char* ug = (const char*)GT + ((size_t)rowU * 3072 + colU) * 2; char* um = (char*)MIX + ((size_t)rowU * 1024 + colU) * 2;
#pragma unroll
        for (int ai = 0; ai < 2; ++ai)
#pragma unroll
            for (int m = 0; m < 4; ++m) { const char* rg = ug + (size_t)(ai * 128 + m * 16) * 3072 * 2; char* rm = um + (size_t)(ai * 128 + m * 16) * 1024 * 2;
#pragma unroll
                for (int bj = 0; bj < 2; ++bj) {
                    const v4u gw = *(const v4u*)(rg + bj * 256 + lg);
                    f32x4 v0 = acc[ai][bj][m][0], v1 = acc[ai][bj][m][1];
                    v0[0] *= bflo(gw.x); v0[1] *= bfhi(gw.x); v0[2] *= bflo(gw.y); v0[3] *= bfhi(gw.y); v1[0] *= bflo(gw.z); v1[1] *= bfhi(gw.z); v1[2] *= bflo(gw.w); v1[3] *= bfhi(gw.w);
                    char* mp = rm + bj * 256 + lm;
                    if (MODE == 1) { const v4u ow = *(const v4u*)mp;
                        v0[0] += bflo(ow.x); v0[1] += bfhi(ow.x); v0[2] += bflo(ow.y); v0[3] += bfhi(ow.y); v1[0] += bflo(ow.z); v1[1] += bfhi(ow.z); v1[2] += bflo(ow.w); v1[3] += bfhi(ow.w); }
                    v4u w; w.x = cvt_pk_bf16(v0[0], v0[1]); w.y = cvt_pk_bf16(v0[2], v0[3]); w.z = cvt_pk_bf16(v1[0], v1[1]); w.w = cvt_pk_bf16(v1[2], v1[3]);
                    *(v4u*)mp = w; }
                if (m & 1) asm volatile("" ::: "memory"); }
    }
};
struct EpiRes {
    PG8_USE_PERM(Perm8)
    const float* xsrc32; const bf16* xsrc16; bf16* xout; const float* GVt; const float* GS2t; float* XSS; float* XMX;
    __device__ __forceinline__ void operator()(f32x4 (&acc)[2][2][4][2], const pg8::Unit& u, int wr, int wc, int fr, int fq) const {
        const int rowU = u.pm * 256 + wr * 64, colU = u.pn * 256 + wc * 32; const int b = (u.pm * 256) >> 12;
        unsigned lo = (unsigned)(fr * DM + 8 * fq) * 2u; OPAQUE_V(lo);
        unsigned lc = (unsigned)(8 * fq) * 4u; OPAQUE_V(lc);
        const char* ga = (const char*)(GVt + (size_t)b * 1024 + colU);
        f32x4 gs2[2][2];
        { f32x4 gv[2][2];
#pragma unroll
          for (int bj = 0; bj < 2; ++bj)
#pragma unroll
              for (int n = 0; n < 2; ++n) { const int co = (bj * 128 + n * 4) * 4; gv[bj][n] = *(const f32x4*)(ga + co + lc); }
#pragma unroll
          for (int ai = 0; ai < 2; ++ai)
#pragma unroll
              for (int bj = 0; bj < 2; ++bj)
#pragma unroll
                  for (int m = 0; m < 4; ++m) { acc[ai][bj][m][0] = acc[ai][bj][m][0] * gv[bj][0]; acc[ai][bj][m][1] = acc[ai][bj][m][1] * gv[bj][1]; } }
#pragma unroll
        for (int bj = 0; bj < 2; ++bj)
#pragma unroll
            for (int n = 0; n < 2; ++n) { const int co = (bj * 128 + n * 4) * 4;
                gs2[bj][n] = *(const f32x4*)((const char*)(GS2t + (size_t)b * 1024 + colU) + co + lc); }
        const char* us32 = (const char*)xsrc32 + ((size_t)rowU * DM + colU) * 4; const char* us16 = (const char*)xsrc16 + ((size_t)rowU * DM + colU) * 2; char* uo = (char*)xout + ((size_t)rowU * DM + colU) * 2;
#pragma unroll
        for (int ai = 0; ai < 2; ++ai)
#pragma unroll
        for (int mh = 0; mh < 2; ++mh) {
            f32x4 X0[2][2], X1[2][2];
            if (xsrc32) {
#pragma unroll
                for (int mm = 0; mm < 2; ++mm)
#pragma unroll
                    for (int bj = 0; bj < 2; ++bj) { const char* p = us32 + ((size_t)(ai * 128 + (mh * 2 + mm) * 16) * DM + bj * 128) * 4 + 2u * lo; X0[mm][bj] = *(const f32x4*)p; X1[mm][bj] = *(const f32x4*)(p + 16); }
            } else { v4u xw[2][2];
#pragma unroll
                for (int mm = 0; mm < 2; ++mm)
#pragma unroll
                    for (int bj = 0; bj < 2; ++bj) xw[mm][bj] = *(const v4u*)(us16 + ((size_t)(ai * 128 + (mh * 2 + mm) * 16) * DM + bj * 128) * 2 + lo);
#pragma unroll
                for (int mm = 0; mm < 2; ++mm)
#pragma unroll
                    for (int bj = 0; bj < 2; ++bj) { const v4u w = xw[mm][bj]; X0[mm][bj] = (f32x4){bflo(w.x), bfhi(w.x), bflo(w.y), bfhi(w.y)}; X1[mm][bj] = (f32x4){bflo(w.z), bfhi(w.z), bflo(w.w), bfhi(w.w)}; }
            }
#pragma unroll
            for (int mm = 0; mm < 2; ++mm) { const int m = mh * 2 + mm; const size_t ro = (size_t)(ai * 128 + m * 16) * DM;
#pragma unroll
                for (int bj = 0; bj < 2; ++bj) { f32x4 x0 = X0[mm][bj], x1 = X1[mm][bj];
                    x0 = x0 + acc[ai][bj][m][0]; x1 = x1 + acc[ai][bj][m][1];
                    v4u o; o.x = cvt_pk_bf16(x0[0], x0[1]); o.y = cvt_pk_bf16(x0[2], x0[3]); o.z = cvt_pk_bf16(x1[0], x1[1]); o.w = cvt_pk_bf16(x1[2], x1[3]);
                    *(v4u*)(uo + (ro + bj * 128) * 2 + lo) = o;
                    float sq = ((x0[0] * x0[0] + x0[1] * x0[1]) + (x0[2] * x0[2] + x0[3] * x0[3])) + ((x1[0] * x1[0] + x1[1] * x1[1]) + (x1[2] * x1[2] + x1[3] * x1[3]));
                    const f32x4 t0 = x0 * gs2[bj][0], t1 = x1 * gs2[bj][1];
                    float mxv = fmaxf(fmaxf(fmaxf(fabsf(t0[0]), fabsf(t0[1])), fmaxf(fabsf(t0[2]), fabsf(t0[3]))), fmaxf(fmaxf(fabsf(t1[0]), fabsf(t1[1])), fmaxf(fabsf(t1[2]), fabsf(t1[3]))));
                    sq += __shfl_xor(sq, 16); sq += __shfl_xor(sq, 32); mxv = fmaxf(mxv, __shfl_xor(mxv, 16)); mxv = fmaxf(mxv, __shfl_xor(mxv, 32));
                    if (fq == 0) { XSS[(size_t)(rowU + ai * 128 + m * 16 + fr) * 32 + u.pn * 8 + bj * 4 + wc] = sq; XMX[(size_t)(rowU + ai * 128 + m * 16 + fr) * 32 + u.pn * 8 + bj * 4 + wc] = mxv; } } }
            asm volatile("" ::: "memory"); }
    }
};

struct T5Seg { unsigned a_off, b_off; int lda, ldb; };
__device__ __forceinline__ void gemm_t5_phase(LAS unsigned char* lds, const unsigned char* base, const T5Seg s0, const T5Seg s1, const T5Seg s2, const SchedDense& S, const unsigned char* GT, bf16* MIX) {
#define U8F(w, i) ((float)(((w) >> (8 * (i))) & 255u))
    using namespace pg8;
    const __amdgpu_buffer_rsrc_t rsrc = __builtin_amdgcn_make_buffer_rsrc((void*)base, 0, 0xffffffff, 0x00020000);
    int tid_ = threadIdx.x; asm volatile("" : "+v"(tid_));
    const int tid = tid_, wid = __builtin_amdgcn_readfirstlane(tid >> 6), lane = tid & 63, wr = wid >> 2, wc = wid & 3, fr = lane & 15, fq = lane >> 4;
    constexpr int NT = 20;
    int R0, C0; stage_rc(tid * 16, R0, C0); C0 *= 2;
    const int Rb0 = Perm8::bperm(R0);
    const unsigned vA256 = (unsigned)(R0 * 256 * 2 + C0), vA512 = (unsigned)(R0 * 512 * 2 + C0), vB256 = (unsigned)(Rb0 * 256 * 2 + C0), vB512 = (unsigned)(Rb0 * 512 * 2 + C0);
    const unsigned kstep = 128u;
    const unsigned ldsw = (unsigned)wid * 1024u;
    const int aoff = lds_byte(wr * 64 + fr, fq * 8), boff = lds_byte(wc * 32 + fr, fq * 8);
#define T5_SA(b, h) (((b) * 2 + (h)) * HTB)
#define T5_SB(b, h) ((4 + (b) * 2 + (h)) * HTB)
#define T5_SEG(T) ((T) < 4 ? 0 : (T) < 12 ? 1 : 2)
#define T5_AOFF(u, T) ((T) < 4 ? s0.a_off + (unsigned)(u).pm * 256u * 256u * 2u + (unsigned)(T) * kstep : (T) < 12 ? s1.a_off + (unsigned)(u).pm * 256u * 512u * 2u + (unsigned)((T) - 4) * kstep : s2.a_off + (unsigned)(u).pm * 256u * 512u * 2u + (unsigned)((T) - 12) * kstep)
#define T5_BOFF(u, T) ((T) < 4 ? s0.b_off + (unsigned)(u).pn * 256u * 256u * 2u + (unsigned)(T) * kstep : (T) < 12 ? s1.b_off + (unsigned)(u).pn * 256u * 512u * 2u + (unsigned)((T) - 4) * kstep : s2.b_off + (unsigned)(u).pn * 256u * 512u * 2u + (unsigned)((T) - 12) * kstep)
#define T5_LD(T) ((T) < 4 ? 256u : 512u)
#define T5_STAGEB(bufoff, u, T) do { const unsigned ld_ = T5_LD(T), go_ = T5_BOFF(u, T), vo_ = (T) < 4 ? vB256 : vB512; _Pragma("unroll") for (int _i = 0; _i < 2; ++_i) \
        __builtin_amdgcn_raw_ptr_buffer_load_lds(rsrc, (LAS void*)(lds + (bufoff) + ldsw + _i * 8192), 16, vo_, go_ + _i * 64u * ld_ * 2u, 0, 0); } while (0)
#define T5_STAGEB1(bufoff, u, T) do { const unsigned ld_ = T5_LD(T), go_ = T5_BOFF(u, T) + 128u * ld_ * 2u, vo_ = (T) < 4 ? vB256 : vB512; _Pragma("unroll") for (int _i = 0; _i < 2; ++_i) \
        __builtin_amdgcn_raw_ptr_buffer_load_lds(rsrc, (LAS void*)(lds + (bufoff) + ldsw + _i * 8192), 16, vo_, go_ + _i * 64u * ld_ * 2u, 0, 0); } while (0)
#define T5_STAGEA(bufoff, u, T, h) do { const unsigned ld_ = T5_LD(T), go_ = T5_AOFF(u, T) + (h) * 128u * ld_ * 2u, vo_ = (T) < 4 ? vA256 : vA512; _Pragma("unroll") for (int _i = 0; _i < 2; ++_i) \
        __builtin_amdgcn_raw_ptr_buffer_load_lds(rsrc, (LAS void*)(lds + (bufoff) + ldsw + _i * 8192), 16, vo_, go_ + _i * 64u * ld_ * 2u, 0, 0); } while (0)
#define T5_LDA(dst, b, h) do { _Pragma("unroll") for (int m = 0; m < 4; ++m) _Pragma("unroll") for (int k = 0; k < 2; ++k) dst[m][k] = *(const LAS bf16x8*)(lds + T5_SA(b, h) + aoff + m * 2048 + k * 1024); } while (0)
#define T5_LDB(dst, b, h) do { _Pragma("unroll") for (int n = 0; n < 2; ++n) _Pragma("unroll") for (int k = 0; k < 2; ++k) dst[n][k] = *(const LAS bf16x8*)(lds + T5_SB(b, h) + boff + n * 2048 + k * 1024); } while (0)
#define T5_MMA(ai, bj, At, Bt) do { __builtin_amdgcn_s_setprio(1); _Pragma("unroll") for (int m = 0; m < 4; ++m) _Pragma("unroll") for (int n = 0; n < 2; ++n) _Pragma("unroll") for (int k = 0; k < 2; ++k) \
        acc[ai][bj][m][n] = __builtin_amdgcn_mfma_f32_16x16x32_bf16(Bt[n][k], At[m][k], acc[ai][bj][m][n], 0, 0, 0); __builtin_amdgcn_s_setprio(0); } while (0)
#define T5_WAIT_V(n) asm volatile("s_waitcnt vmcnt(" #n ")" ::: "memory")
#define T5_WAIT_L(n) asm volatile("s_waitcnt lgkmcnt(" #n ")" ::: "memory")
#define T5_BAR __builtin_amdgcn_s_barrier()
#define T5_SCHED __builtin_amdgcn_sched_barrier(0)
    Unit cur, nxt; int ui = 0;
    if (!S.next(0, cur)) return;
    f32x4 acc[2][2][4][2];
#pragma unroll
    for (int a = 0; a < 2; ++a)
#pragma unroll
        for (int b = 0; b < 2; ++b)
#pragma unroll
            for (int m = 0; m < 4; ++m)
#pragma unroll
                for (int n = 0; n < 2; ++n) acc[a][b][m][n] = (f32x4){0.f, 0.f, 0.f, 0.f};
    bf16x8 At[4][2], B0[2][2], B1[2][2];
    T5_STAGEB(T5_SB(0, 0), cur, 0); T5_STAGEB1(T5_SB(0, 1), cur, 0); T5_STAGEA(T5_SA(0, 0), cur, 0, 0); T5_STAGEA(T5_SA(0, 1), cur, 0, 1);
    if (wr == 1) T5_BAR;
    T5_WAIT_V(2); T5_BAR;
    T5_STAGEB(T5_SB(1, 0), cur, 1); T5_STAGEA(T5_SA(1, 0), cur, 1, 0); T5_STAGEB1(T5_SB(1, 1), cur, 1);
    T5_WAIT_V(6); T5_BAR;
    for (;;) {
        const bool has_next = S.next(ui + 1, nxt);
        const Unit nu = has_next ? nxt : cur;
#pragma unroll 1
        for (int t = 0; t < NT; t += 2) {
            const bool last = (t == NT - 2);
            if (t == 4 || t == 12) {
                const int gp = (t == 4) ? 0 : 1;
                unsigned lg = (unsigned)(fr * 3072 + 8 * fq); asm volatile("" : "+v"(lg));
                const char* ug = (const char*)GT + ((size_t)(cur.pm * 256 + wr * 64) * 3072 + gp * 1024 + cur.pn * 256 + wc * 32);
#pragma unroll
                for (int ai = 0; ai < 2; ++ai) { v2u ga[4][2], gb[4][2];
#pragma unroll
                    for (int m = 0; m < 4; ++m)
#pragma unroll
                        for (int bj = 0; bj < 2; ++bj) { const char* p = ug + (size_t)(ai * 128 + m * 16) * 3072 + bj * 128 + lg; ga[m][bj] = *(const v2u*)p; gb[m][bj] = *(const v2u*)(p + 1024); }
#pragma unroll
                    for (int m = 0; m < 4; ++m)
#pragma unroll
                        for (int bj = 0; bj < 2; ++bj) { const v2u a = ga[m][bj], b = gb[m][bj];
                            f32x4& v0 = acc[ai][bj][m][0]; f32x4& v1 = acc[ai][bj][m][1];
                            v0[0] *= U8F(a.x, 0) * __builtin_amdgcn_rcpf(U8F(b.x, 0)); v0[1] *= U8F(a.x, 1) * __builtin_amdgcn_rcpf(U8F(b.x, 1)); v0[2] *= U8F(a.x, 2) * __builtin_amdgcn_rcpf(U8F(b.x, 2)); v0[3] *= U8F(a.x, 3) * __builtin_amdgcn_rcpf(U8F(b.x, 3));
                            v1[0] *= U8F(a.y, 0) * __builtin_amdgcn_rcpf(U8F(b.y, 0)); v1[1] *= U8F(a.y, 1) * __builtin_amdgcn_rcpf(U8F(b.y, 1)); v1[2] *= U8F(a.y, 2) * __builtin_amdgcn_rcpf(U8F(b.y, 2)); v1[3] *= U8F(a.y, 3) * __builtin_amdgcn_rcpf(U8F(b.y, 3)); }
                    asm volatile("" ::: "memory"); }
            }
            const bool relax = (t == 0) && (ui > 0);
            T5_LDB(B0, 0, 0); T5_LDB(B1, 0, 1); T5_SCHED; T5_LDA(At, 0, 0); T5_STAGEA(T5_SA(1, 1), cur, t + 1, 1);
            if (!relax) T5_WAIT_V(8);
            T5_WAIT_L(0); T5_BAR; T5_MMA(0, 0, At, B0); T5_MMA(0, 1, At, B1); T5_BAR; T5_SCHED;
            T5_LDA(At, 0, 1);
            if (last) { T5_STAGEB(T5_SB(0, 0), nu, 0); T5_STAGEB1(T5_SB(0, 1), nu, 0); T5_STAGEA(T5_SA(0, 0), nu, 0, 0); }
            else { T5_STAGEB(T5_SB(0, 0), cur, t + 2); T5_STAGEB1(T5_SB(0, 1), cur, t + 2); T5_STAGEA(T5_SA(0, 0), cur, t + 2, 0); }
            if (!relax) T5_WAIT_V(8);
            T5_WAIT_L(0); T5_BAR; T5_MMA(1, 0, At, B0); T5_MMA(1, 1, At, B1); T5_BAR; T5_SCHED;
            T5_LDB(B0, 1, 0); T5_LDB(B1, 1, 1); T5_SCHED; T5_LDA(At, 1, 0);
            if (last) T5_STAGEA(T5_SA(0, 1), nu, 0, 1); else T5_STAGEA(T5_SA(0, 1), cur, t + 2, 1);
            T5_WAIT_V(8); T5_WAIT_L(0); T5_BAR; T5_MMA(0, 0, At, B0); T5_MMA(0, 1, At, B1); T5_BAR; T5_SCHED;
            T5_LDA(At, 1, 1);
            if (last) { T5_STAGEB(T5_SB(1, 0), nu, 1); T5_STAGEB1(T5_SB(1, 1), nu, 1); T5_STAGEA(T5_SA(1, 0), nu, 1, 0); }
            else { T5_STAGEB(T5_SB(1, 0), cur, t + 3); T5_STAGEB1(T5_SB(1, 1), cur, t + 3); T5_STAGEA(T5_SA(1, 0), cur, t + 3, 0); }
            T5_WAIT_V(8); T5_WAIT_L(0); T5_BAR; T5_MMA(1, 0, At, B0); T5_MMA(1, 1, At, B1); T5_BAR; T5_SCHED;
        }
        if (wr == 0) T5_BAR;
        {
            int t2 = threadIdx.x; asm volatile("" : "+v"(t2)); const int fr2 = t2 & 15, fq2 = (t2 & 63) >> 4;
            unsigned lg = (unsigned)(fr2 * 3072 + 8 * fq2); asm volatile("" : "+v"(lg));
            unsigned lm = (unsigned)(fr2 * 1024 + 8 * fq2) * 2u; asm volatile("" : "+v"(lm));
            const char* ug = (const char*)GT + ((size_t)(cur.pm * 256 + wr * 64) * 3072 + 2048 + cur.pn * 256 + wc * 32);
            char* um = (char*)MIX + ((size_t)(cur.pm * 256 + wr * 64) * 1024 + cur.pn * 256 + wc * 32) * 2;
#pragma unroll
            for (int ai = 0; ai < 2; ++ai) { v2u gc[4][2];
#pragma unroll
                for (int m = 0; m < 4; ++m)
#pragma unroll
                    for (int bj = 0; bj < 2; ++bj) gc[m][bj] = *(const v2u*)(ug + (size_t)(ai * 128 + m * 16) * 3072 + bj * 128 + lg);
#pragma unroll
                for (int m = 0; m < 4; ++m)
#pragma unroll
                    for (int bj = 0; bj < 2; ++bj) { const v2u gw = gc[m][bj]; f32x4 v0 = acc[ai][bj][m][0] * (1.0f / 255.0f), v1 = acc[ai][bj][m][1] * (1.0f / 255.0f);
                        v0[0] *= U8F(gw.x, 0); v0[1] *= U8F(gw.x, 1); v0[2] *= U8F(gw.x, 2); v0[3] *= U8F(gw.x, 3); v1[0] *= U8F(gw.y, 0); v1[1] *= U8F(gw.y, 1); v1[2] *= U8F(gw.y, 2); v1[3] *= U8F(gw.y, 3);
                        v4u w; w.x = cvt_pk_bf16(v0[0], v0[1]); w.y = cvt_pk_bf16(v0[2], v0[3]); w.z = cvt_pk_bf16(v1[0], v1[1]); w.w = cvt_pk_bf16(v1[2], v1[3]);
                        *(v4u*)(um + (size_t)(ai * 128 + m * 16) * 1024 * 2 + bj * 256 + lm) = w; }
                asm volatile("" ::: "memory"); }
        }
        if (!has_next) break;
#pragma unroll
        for (int a = 0; a < 2; ++a)
#pragma unroll
            for (int b = 0; b < 2; ++b)
#pragma unroll
                for (int m = 0; m < 4; ++m)
#pragma unroll
                    for (int n = 0; n < 2; ++n) acc[a][b][m][n] = (f32x4){0.f, 0.f, 0.f, 0.f};
        cur = nxt; ++ui;
        if (wr == 1) T5_BAR;
    }
    T5_WAIT_V(0);
    T5_BAR;
#undef U8F
#undef T5_SA
#undef T5_SB
#undef T5_SEG
#undef T5_AOFF
#undef T5_BOFF
#undef T5_LD
#undef T5_STAGEB
#undef T5_STAGEB1
#undef T5_STAGEA
#undef T5_LDA
#undef T5_LDB
#undef T5_MMA
#undef T5_WAIT_V
#undef T5_WAIT_L
#undef T5_BAR
#undef T5_SCHED
}

struct AttnCfg {
    const bf16* Qp; long qpitch;
    const bf16* Kp; long kpitch;
    const bf16* K2p; long k2pitch;
    const bf16* Vp; long vpitch;
    bf16* Op; long opitch;
    float* lsep; long lsepitch;
    int q0, kt_lo, kt_hi, band;
};
__device__ __forceinline__ int crow(int r, int hi) { return (r & 3) + 8 * (r >> 2) + 4 * hi; }
typedef short v4i16_t __attribute__((ext_vector_type(4)));
__device__ __forceinline__ s16x4 vtr(LAS const unsigned char* p) { return __builtin_bit_cast(s16x4, __builtin_amdgcn_ds_read_tr16_b64_v4i16((LAS v4i16_t*)p)); }

template <int DQK>
__device__ __forceinline__ void attn_tile(const AttnCfg& cf, LAS const unsigned char* Kb, LAS const unsigned char* Vb, int kt, int qw_lo, int r32, int hi, int lane,
                                          const bf16x8 (&qf)[DQK / 16], f32x16& o0, f32x16& o1, f32x16& negm, float& mref, float& lrun) {
    constexpr int KST = (DQK == 96) ? 208 : 144, KBUF = 64 * 208, VBUF = 8192, VOFF = 2 * KBUF, ND = DQK / 16; constexpr float THR = 8.0f;
    const int kbase = 64 * kt;
        const bool active = (kbase <= qw_lo + 31) && (cf.band == 0 || kbase + 63 >= qw_lo - cf.band);
        if (active) {
            f32x16 p0, p1;
#pragma unroll
            for (int d0 = 0; d0 < ND; ++d0) {
                const bf16x8 ka0 = *(LAS const bf16x8*)(Kb + d0 * 32), ka1 = *(LAS const bf16x8*)(Kb + 32 * KST + d0 * 32);
                p0 = __builtin_amdgcn_mfma_f32_32x32x16_bf16(ka0, qf[d0], d0 == 0 ? negm : p0, 0, 0, 0);
                p1 = __builtin_amdgcn_mfma_f32_32x32x16_bf16(ka1, qf[d0], d0 == 0 ? negm : p1, 0, 0, 0);
            }
            const bool need_mask = (kbase + 63 > qw_lo) || (cf.band != 0 && kbase < qw_lo + 31 - cf.band);
            if (need_mask) {
                const int q = qw_lo + r32; const int lo = (cf.band != 0) ? q - cf.band : -0x40000000;
#pragma unroll
                for (int r = 0; r < 16; ++r) { const int k0 = kbase + crow(r, hi), k1 = k0 + 32;
                    if (k0 > q || k0 < lo) p0[r] = -1e30f;
                    if (k1 > q || k1 < lo) p1[r] = -1e30f; }
            }
            float mx = fmaxf(fmaxf(p0[0], p0[1]), p1[0]);
#pragma unroll
            for (int r = 2; r < 16; r += 2) mx = fmaxf(fmaxf(mx, p0[r]), p0[r + 1]);
#pragma unroll
            for (int r = 1; r < 15; r += 2) mx = fmaxf(fmaxf(mx, p1[r]), p1[r + 1]);
            mx = fmaxf(mx, p1[15]);
            { auto rr = __builtin_amdgcn_permlane32_swap(__float_as_uint(mx), __float_as_uint(mx), false, false); mx = fmaxf(__uint_as_float(rr[0]), __uint_as_float(rr[1])); }
            if (__builtin_expect(__any(mx > THR), 0)) {
                const float dl = fmaxf(mx, 0.f), alpha = __builtin_amdgcn_exp2f(-dl);
                mref += dl; lrun *= alpha;
#pragma unroll
                for (int r = 0; r < 16; ++r) { p0[r] -= dl; p1[r] -= dl; o0[r] *= alpha; o1[r] *= alpha; negm[r] = -mref; }
            }
            float rs0 = 0.f, rs1 = 0.f;
#pragma unroll
            for (int r = 0; r < 16; ++r) { p0[r] = __builtin_amdgcn_exp2f(p0[r]); p1[r] = __builtin_amdgcn_exp2f(p1[r]); rs0 += p0[r]; rs1 += p1[r]; }
            lrun += rs0 + rs1;
            v4u pw[4];
#pragma unroll
            for (int s = 0; s < 2; ++s) {
                pw[s] = (v4u){cvt_pk_bf16(p0[8 * s + 0], p0[8 * s + 1]), cvt_pk_bf16(p0[8 * s + 2], p0[8 * s + 3]), cvt_pk_bf16(p0[8 * s + 4], p0[8 * s + 5]), cvt_pk_bf16(p0[8 * s + 6], p0[8 * s + 7])};
                pw[2 + s] = (v4u){cvt_pk_bf16(p1[8 * s + 0], p1[8 * s + 1]), cvt_pk_bf16(p1[8 * s + 2], p1[8 * s + 3]), cvt_pk_bf16(p1[8 * s + 4], p1[8 * s + 5]), cvt_pk_bf16(p1[8 * s + 6], p1[8 * s + 7])};
            }
#pragma unroll
            for (int ks = 0; ks < 4; ++ks) {
                const bf16x8 pb = __builtin_bit_cast(bf16x8, pw[ks]);
#pragma unroll
                for (int d = 0; d < 2; ++d) {
                    const s16x4 lo4 = vtr(Vb + d * 4096 + ks * 1024), hi4 = vtr(Vb + d * 4096 + ks * 1024 + 512);
                    const bf16x8 vf = (bf16x8){lo4[0], lo4[1], lo4[2], lo4[3], hi4[0], hi4[1], hi4[2], hi4[3]};
                    if (d == 0) o0 = __builtin_amdgcn_mfma_f32_32x32x16_bf16(vf, pb, o0, 0, 0, 0); else o1 = __builtin_amdgcn_mfma_f32_32x32x16_bf16(vf, pb, o1, 0, 0, 0);
                }
            }
        }
}

template <int DQK>
__device__ __forceinline__ void attn_unit(const AttnCfg& cf, LAS unsigned char* lds) {
    constexpr int KST = (DQK == 96) ? 208 : 144;
    constexpr int KBUF = 64 * 208, VBUF = 8192, VOFF = 2 * KBUF;
    constexpr int ND = DQK / 16;
    int tid_ = threadIdx.x; asm volatile("" : "+v"(tid_));
    const int tid = tid_, lane = tid & 63, r32 = lane & 31, hi = lane >> 5; const int wid = __builtin_amdgcn_readfirstlane(tid >> 6);
    const int qw_lo = cf.q0 + 32 * wid;
    bf16x8 qf[ND];
    { const bf16* qrow = cf.Qp + (long)(qw_lo + r32) * cf.qpitch;
#pragma unroll
      for (int d0 = 0; d0 < ND; ++d0) qf[d0] = *(const bf16x8*)(qrow + 16 * d0 + 8 * hi); }
    const int skey = tid >> 3, sch = tid & 7;
    const int s2key = tid >> 2, s2ch = tid & 3;
    const unsigned kdst = skey * KST + sch * 16, k2dst = s2key * KST + 128 + s2ch * 16, vdst = (sch >> 2) * 4096 + skey * 64 + (sch & 3) * 16;
    v4u kregA, k2regA, vregA, kregB, k2regB, vregB;
#define ATT_LOAD(S, kt) do { const long kr_ = (long)(64 * (kt) + skey); kreg##S = *(const v4u*)(cf.Kp + kr_ * cf.kpitch + sch * 8); vreg##S = *(const v4u*)(cf.Vp + kr_ * cf.vpitch + sch * 8); \
        if (DQK == 96 && tid < 256) k2reg##S = *(const v4u*)(cf.K2p + (long)(64 * (kt) + s2key) * cf.k2pitch + s2ch * 8); } while (0)
#define ATT_STORE(S, buf) do { *(LAS v4u*)(lds + (buf) * KBUF + kdst) = kreg##S; *(LAS v4u*)(lds + VOFF + (buf) * VBUF + vdst) = vreg##S; \
        if (DQK == 96 && tid < 256) *(LAS v4u*)(lds + (buf) * KBUF + k2dst) = k2reg##S; } while (0)
    f32x16 o0, o1, negm;
#pragma unroll
    for (int r = 0; r < 16; ++r) { o0[r] = 0.f; o1[r] = 0.f; negm[r] = 0.f; }
    float mref = 0.f, lrun = 0.f;
    constexpr float THR = 8.0f;
    const unsigned klane = r32 * KST + hi * 16;
    const unsigned vlane = (4 * hi + ((lane & 15) >> 2)) * 64 + ((lane >> 4) & 1) * 32 + (lane & 3) * 8;
    ATT_LOAD(A, cf.kt_lo); ATT_STORE(A, 0);
    if (cf.kt_lo + 1 < cf.kt_hi) ATT_LOAD(A, cf.kt_lo + 1);
    __syncthreads();
#define ATT_STEP(SN, SS) do { const int buf = (kt - cf.kt_lo) & 1; \
        if (kt + 2 < cf.kt_hi) ATT_LOAD(SN, kt + 2); \
        attn_tile<DQK>(cf, lds + buf * KBUF + klane, lds + VOFF + buf * VBUF + vlane, kt, qw_lo, r32, hi, lane, qf, o0, o1, negm, mref, lrun); \
        if (kt + 1 < cf.kt_hi) ATT_STORE(SS, buf ^ 1); \
        __syncthreads(); } while (0)
    for (int kt = cf.kt_lo; kt < cf.kt_hi; kt += 2) {
        ATT_STEP(B, A);
        if (kt + 1 < cf.kt_hi) { ++kt; ATT_STEP(A, B); --kt; }
    }
#undef ATT_STEP
#undef ATT_LOAD
#undef ATT_STORE
    float ltot; { auto rr = __builtin_amdgcn_permlane32_swap(__float_as_uint(lrun), __float_as_uint(lrun), false, false); ltot = __uint_as_float(rr[0]) + __uint_as_float(rr[1]); }
    const float inv = 1.0f / ltot;
    bf16* orow = cf.Op + (long)(qw_lo + r32) * cf.opitch;
#pragma unroll
    for (int g = 0; g < 4; ++g) {
        v2u w0, w1;
        w0.x = cvt_pk_bf16(o0[4 * g] * inv, o0[4 * g + 1] * inv); w0.y = cvt_pk_bf16(o0[4 * g + 2] * inv, o0[4 * g + 3] * inv);
        w1.x = cvt_pk_bf16(o1[4 * g] * inv, o1[4 * g + 1] * inv); w1.y = cvt_pk_bf16(o1[4 * g + 2] * inv, o1[4 * g + 3] * inv);
        *(v2u*)(orow + 8 * g + 4 * hi) = w0; *(v2u*)(orow + 32 + 8 * g + 4 * hi) = w1;
    }
    if (cf.lsep != nullptr && hi == 0) cf.lsep[(long)(qw_lo + r32) * cf.lsepitch] = mref + __builtin_amdgcn_logf(ltot);
}

__device__ __forceinline__ void dil_unit(const AttnCfg& cf, LAS unsigned char* lds) {
    constexpr int KST = 144, KSL = 64 * KST, VSL = 8192, VOFF6 = 6 * KSL;
    int tid_ = threadIdx.x; asm volatile("" : "+v"(tid_));
    const int tid = tid_, lane = tid & 63, r32 = lane & 31, hi = lane >> 5; const int wid = __builtin_amdgcn_readfirstlane(tid >> 6);
    const int qw_lo = cf.q0 + 32 * wid;
    const int nt = cf.kt_hi - cf.kt_lo;
    const int skey = tid >> 3, sch = tid & 7;
    const unsigned kdst = skey * KST + sch * 16, vdst = (sch >> 2) * 4096 + skey * 64 + (sch & 3) * 16;
    v4u kr[6], vr[6];
#pragma unroll
    for (int i = 0; i < 6; ++i) if (i < nt) { const long kr_ = (long)(64 * (cf.kt_lo + i) + skey); kr[i] = *(const v4u*)(cf.Kp + kr_ * cf.kpitch + sch * 8); vr[i] = *(const v4u*)(cf.Vp + kr_ * cf.vpitch + sch * 8); }
    bf16x8 qf[4];
    { const bf16* qrow = cf.Qp + (long)(qw_lo + r32) * cf.qpitch;
#pragma unroll
      for (int d0 = 0; d0 < 4; ++d0) qf[d0] = *(const bf16x8*)(qrow + 16 * d0 + 8 * hi); }
    __syncthreads();
#pragma unroll
    for (int i = 0; i < 6; ++i) if (i < nt) { *(LAS v4u*)(lds + i * KSL + kdst) = kr[i]; *(LAS v4u*)(lds + VOFF6 + i * VSL + vdst) = vr[i]; }
    __syncthreads();
    f32x16 o0, o1, negm;
#pragma unroll
    for (int r = 0; r < 16; ++r) { o0[r] = 0.f; o1[r] = 0.f; negm[r] = 0.f; }
    float mref = 0.f, lrun = 0.f;
    const unsigned klane = r32 * KST + hi * 16;
    const unsigned vlane = (4 * hi + ((lane & 15) >> 2)) * 64 + ((lane >> 4) & 1) * 32 + (lane & 3) * 8;
    int t0 = (qw_lo >> 6) - 2; if (t0 < cf.kt_lo) t0 = cf.kt_lo;
    const int t1 = (qw_lo + 31) >> 6;
    for (int kt = t0; kt <= t1; ++kt) { const int sl = kt - cf.kt_lo;
        attn_tile<64>(cf, lds + sl * KSL + klane, lds + VOFF6 + sl * VSL + vlane, kt, qw_lo, r32, hi, lane, qf, o0, o1, negm, mref, lrun); }
    float ltot; { auto rr = __builtin_amdgcn_permlane32_swap(__float_as_uint(lrun), __float_as_uint(lrun), false, false); ltot = __uint_as_float(rr[0]) + __uint_as_float(rr[1]); }
    const float inv = 1.0f / ltot;
    bf16* orow = cf.Op + (long)(qw_lo + r32) * cf.opitch;
#pragma unroll
    for (int g = 0; g < 4; ++g) {
        v2u w0, w1;
        w0.x = cvt_pk_bf16(o0[4 * g] * inv, o0[4 * g + 1] * inv); w0.y = cvt_pk_bf16(o0[4 * g + 2] * inv, o0[4 * g + 3] * inv);
        w1.x = cvt_pk_bf16(o1[4 * g] * inv, o1[4 * g + 1] * inv); w1.y = cvt_pk_bf16(o1[4 * g + 2] * inv, o1[4 * g + 3] * inv);
        *(v2u*)(orow + 8 * g + 4 * hi) = w0; *(v2u*)(orow + 32 + 8 * g + 4 * hi) = w1;
    }
    if (cf.lsep != nullptr && hi == 0) cf.lsep[(long)(qw_lo + r32) * cf.lsepitch] = mref + __builtin_amdgcn_logf(ltot);
}

constexpr int RB_OFF = 61440, RB_ROW = 272, RB_ARR = 64 * RB_ROW, RB_BUF = 2 * RB_ARR;
static_assert(RB_OFF + 2 * RB_BUF <= RING_BYTES, "router chunk buffers");
__device__ __forceinline__ void n2_route_phase(const Frame& F, const Args& A, int layer, const bf16* x) {
    LAS float* GS = (LAS float*)F.lds; LAS float* SH = GS + 1024;
    LAS float* LG = SH + 1024 + F.wave * 1024;
    LAS unsigned* CNT = (LAS unsigned*)(F.lds + 8192 + 8 * 4096); LAS unsigned* BASE = CNT + 64;
    LAS unsigned* ENT = BASE + 64; LAS float* ENTW = (LAS float*)(ENT + 1024);
    const int j = layer * 2 + 1; const float* g = A.in[19] + layer * DM;
    const bf16* RTH = (const bf16*)(F.ws + WS_W + WO_RTH); const bf16* RTL = (const bf16*)(F.ws + WS_W + WO_RTL);
    const float* rbias = A.in[21] + layer * 64; const float* XSS = (const float*)(F.ws + WS_XSS); const float* XMX = (const float*)(F.ws + WS_XMX); float* SA2 = (float*)(F.ws + WS_SA2);
    LAS float* SHM = (LAS float*)(F.lds + 8192 + 8 * 4096 + 16384);
    unsigned char* H2 = F.ws + WS_H2; v2u* LISTS = (v2u*)(F.ws + WS_LISTS);
    unsigned* gcnt = F.ctl + CW_GCNT + layer * NLIST;
    const int tk = F.lane & 15, kq = F.lane >> 4;
    for (int tile = F.bid; tile < NTOK / 128; tile += F.G) {
        const int tok0 = tile * 128, b = tok0 >> 12, half = tok0 >> 14;
        __syncthreads();
        const int rrow = F.tid >> 4, rseg = F.tid & 15;
        const bf16* rsrc0 = RTH + (size_t)rrow * DM + rseg * 8; const bf16* rsrc1 = RTL + (size_t)rrow * DM + rseg * 8;
        LAS unsigned char* rdst = F.lds + RB_OFF + rrow * RB_ROW + rseg * 16;
        v4u rbr[4];
#define RB_LOAD(c) do { rbr[0] = *(const v4u*)(rsrc0 + (c) * 128); rbr[1] = *(const v4u*)(rsrc0 + 32 * DM + (c) * 128); rbr[2] = *(const v4u*)(rsrc1 + (c) * 128); rbr[3] = *(const v4u*)(rsrc1 + 32 * DM + (c) * 128); } while (0)
#define RB_STORE(buf) do { LAS unsigned char* d_ = rdst + (buf) * RB_BUF; *(LAS v4u*)d_ = rbr[0]; *(LAS v4u*)(d_ + 32 * RB_ROW) = rbr[1]; *(LAS v4u*)(d_ + RB_ARR) = rbr[2]; *(LAS v4u*)(d_ + RB_ARR + 32 * RB_ROW) = rbr[3]; } while (0)
        RB_LOAD(0);
        norm_tables(F, A, j, g, b, 1, GS, SH);
        if (F.tid < 64) CNT[F.tid] = 0u;
        __syncthreads();
        { float sm = fmaxf(fabsf(SH[F.tid]), fabsf(SH[F.tid + 512])); sm = wave_max(sm); if (F.lane == 0) SHM[F.wave] = sm; }
        __syncthreads();
        float shmax = SHM[0];
#pragma unroll
        for (int w = 1; w < 8; ++w) shmax = fmaxf(shmax, SHM[w]);
        const int tok = tok0 + F.wave * 16 + tk; const bf16* xr = x + (size_t)tok * DM + 8 * kq;
        float ss; { const f32x4* sp = (const f32x4*)(XSS + (size_t)tok * 32 + 8 * kq); const f32x4 s0 = sp[0], s1 = sp[1]; ss = ((s0[0] + s0[1]) + (s0[2] + s0[3])) + ((s1[0] + s1[1]) + (s1[2] + s1[3])); }
        ss += __shfl_xor(ss, 16); ss += __shfl_xor(ss, 32);
        const float rstd = 1.0f / sqrtf(ss * (1.0f / DM) + EPSV);
        float xm; { const f32x4* mp = (const f32x4*)(XMX + (size_t)tok * 32 + 8 * kq); const f32x4 m0 = mp[0], m1 = mp[1]; xm = fmaxf(fmaxf(fmaxf(m0[0], m0[1]), fmaxf(m0[2], m0[3])), fmaxf(fmaxf(m1[0], m1[1]), fmaxf(m1[2], m1[3]))); }
        xm = fmaxf(xm, __shfl_xor(xm, 16)); xm = fmaxf(xm, __shfl_xor(xm, 32));
        const float hmax = fmaxf(rstd * xm + shmax, 1e-20f), hinv = 126.5f / hmax;
        if (kq == 0) SA2[tok] = hmax * (1.0f / 126.5f);
        f32x4 lg[4];
#pragma unroll
        for (int ge = 0; ge < 4; ++ge) lg[ge] = (f32x4){0.f, 0.f, 0.f, 0.f};
        v4u xw[4], xn[4];
#pragma unroll
        for (int u = 0; u < 4; ++u) xw[u] = *(const v4u*)(xr + 32 * u);
#pragma unroll
        for (int u = 0; u < 4; ++u) asm volatile("" : "+v"(xw[u].x), "+v"(xw[u].y), "+v"(xw[u].z), "+v"(xw[u].w));
        RB_STORE(0);
        __syncthreads();
#pragma unroll 1
        for (int c = 0; c < 8; ++c) { const int kk0 = 4 * c;
            if (c + 1 < 8) { RB_LOAD(c + 1);
#pragma unroll
                for (int u = 0; u < 4; ++u) xn[u] = *(const v4u*)(xr + 32 * (kk0 + 4 + u)); }
            f32x4 xa[4], xc[4];
            const LAS unsigned char* rb = F.lds + RB_OFF + (c & 1) * RB_BUF + tk * RB_ROW + 16 * kq;
#pragma unroll
            for (int u = 0; u < 4; ++u) { xa[u] = (f32x4){bflo(xw[u].x), bfhi(xw[u].x), bflo(xw[u].y), bfhi(xw[u].y)}; xc[u] = (f32x4){bflo(xw[u].z), bfhi(xw[u].z), bflo(xw[u].w), bfhi(xw[u].w)}; }
#pragma unroll
            for (int u = 0; u < 4; ++u) {
                const int k0 = 32 * (kk0 + u) + 8 * kq;
                const f32x4 g0 = *(LAS const f32x4*)(GS + k0), g1 = *(LAS const f32x4*)(GS + k0 + 4), s0 = *(LAS const f32x4*)(SH + k0), s1 = *(LAS const f32x4*)(SH + k0 + 4);
                const f32x4 h0 = (xa[u] * rstd) * g0 + s0, h1 = (xc[u] * rstd) * g1 + s1;
                unsigned hb[8]; float lo[8];
#pragma unroll
                for (int q = 0; q < 4; ++q) { hb[q] = f2bf(h0[q]); lo[q] = h0[q] - bf2f(hb[q]); hb[4 + q] = f2bf(h1[q]); lo[4 + q] = h1[q] - bf2f(hb[4 + q]); }
                v4u hw; hw.x = hb[0] | (hb[1] << 16); hw.y = hb[2] | (hb[3] << 16); hw.z = hb[4] | (hb[5] << 16); hw.w = hb[6] | (hb[7] << 16);
                if (FP8_F2) { v2u h8; h8.x = pk4_i8(h0[0], h0[1], h0[2], h0[3], hinv); h8.y = pk4_i8(h1[0], h1[1], h1[2], h1[3], hinv); *(v2u*)(H2 + (size_t)tok * DM + k0) = h8; }
                else *(v4u*)(H2 + ((size_t)tok * DM + k0) * 2) = hw;
                v4u lw; lw.x = pk2(lo[0], lo[1]); lw.y = pk2(lo[2], lo[3]); lw.z = pk2(lo[4], lo[5]); lw.w = pk2(lo[6], lo[7]);
                const bf16x8 ahi = __builtin_bit_cast(bf16x8, hw), alo = __builtin_bit_cast(bf16x8, lw);
#pragma unroll
                for (int ge = 0; ge < 4; ++ge) {
                    const bf16x8 bh = *(LAS const bf16x8*)(rb + ge * 16 * RB_ROW + 64 * u), bl = *(LAS const bf16x8*)(rb + RB_ARR + ge * 16 * RB_ROW + 64 * u);
                    lg[ge] = __builtin_amdgcn_mfma_f32_16x16x32_bf16(ahi, bh, lg[ge], 0, 0, 0);
                    lg[ge] = __builtin_amdgcn_mfma_f32_16x16x32_bf16(alo, bh, lg[ge], 0, 0, 0);
                    lg[ge] = __builtin_amdgcn_mfma_f32_16x16x32_bf16(ahi, bl, lg[ge], 0, 0, 0);
                }
            }
            if (c + 1 < 8) { RB_STORE((c + 1) & 1);
#pragma unroll
                for (int u = 0; u < 4; ++u) xw[u] = xn[u]; }
            __syncthreads();
        }
#undef RB_LOAD
#undef RB_STORE
#pragma unroll
        for (int ge = 0; ge < 4; ++ge)
#pragma unroll
            for (int r = 0; r < 4; ++r) { const int e = 16 * ge + tk; LG[(4 * kq + r) * 64 + e] = fsigmoid(lg[ge][r]) + rbias[e]; }
        LDS_WAIT(); asm volatile("" ::: "memory");
        {
            const int tq = F.lane >> 2, part = F.lane & 3, qb = F.lane & ~3;
            const LAS float* sel = LG + tq * 64 + part * 16;
            float v[16];
#pragma unroll
            for (int i = 0; i < 16; ++i) v[i] = sel[i];
            float gl[2];
#pragma unroll
            for (int gI = 0; gI < 2; ++gI) { float m1 = -3e38f, m2 = -3e38f;
#pragma unroll
                for (int q = 0; q < 8; ++q) { const float x = v[gI * 8 + q]; if (x > m1) { m2 = m1; m1 = x; } else if (x > m2) m2 = x; }
                gl[gI] = m1 + m2; }
            float gsc[8];
#pragma unroll
            for (int p = 0; p < 4; ++p) { gsc[2 * p] = __shfl(gl[0], qb + p); gsc[2 * p + 1] = __shfl(gl[1], qb + p); }
            unsigned gmask = 0u;
#pragma unroll
            for (int gI = 0; gI < 8; ++gI) { int rank = 0;
#pragma unroll
                for (int q = 0; q < 8; ++q) rank += (gsc[q] > gsc[gI] || (gsc[q] == gsc[gI] && q < gI)) ? 1 : 0;
                if (rank < 4) gmask |= 1u << gI; }
#pragma unroll
            for (int i = 0; i < 16; ++i) if (!((gmask >> (2 * part + (i >> 3))) & 1u)) v[i] = -3e38f;
            unsigned taken = 0u; float wsum = 0.f; int es[8]; float sc[8];
#pragma unroll
            for (int k = 0; k < 8; ++k) { float best = -3.2e38f; int bi = 0;
#pragma unroll
                for (int i = 0; i < 16; ++i) { const bool free_ = !((taken >> i) & 1u); if (free_ && v[i] > best) { best = v[i]; bi = i; } }
                int be = part * 16 + bi;
#pragma unroll
                for (int off = 1; off <= 2; off <<= 1) { const float ob = __shfl_xor(best, off); const int oe = __shfl_xor(be, off); if (ob > best || (ob == best && oe < be)) { best = ob; be = oe; } }
                if ((be >> 4) == part) taken |= 1u << (be & 15);
                es[k] = be; sc[k] = best - rbias[be]; wsum += sc[k]; }
            const float wn = 2.5f / wsum;
#pragma unroll
            for (int k = 0; k < 8; ++k) if ((k & 3) == part) { const unsigned pos = atomicAdd((unsigned*)(CNT + es[k]), 1u); const int ei = (F.wave * 16 + tq) * 8 + k; ENT[ei] = (unsigned)es[k] | (pos << 8); ENTW[ei] = sc[k] * wn; }
        }
        __syncthreads();
        if (F.tid < 64) BASE[F.tid] = CNT[F.tid] ? atomicAdd(gcnt + half * 64 + F.tid, CNT[F.tid]) : 0u;
        __syncthreads();
        for (int ei = F.tid; ei < 1024; ei += NTHR) { const unsigned en = ENT[ei]; const unsigned e = en & 255u, pos = en >> 8; const unsigned slot = (unsigned)(tok0 + (ei >> 3)) * 8u + (unsigned)(ei & 7);
            LISTS[(size_t)(half * 64 + e) * LISTCAP + BASE[e] + pos] = (v2u){slot, __float_as_uint(ENTW[ei])}; }
    }
}
__device__ __forceinline__ void n2_convert_experts(const Frame& F, const Args& A, int layer) {
    LAS float* scr = (LAS float*)(F.lds + F.wave * 16384);
    const int gw = F.bid * NWAVES + F.wave, NGW = F.G * NWAVES;
    const float* w1 = A.in[22] + (size_t)layer * 64 * 1024 * 256; const float* w3 = A.in[23] + (size_t)layer * 64 * 1024 * 256; const float* w2 = A.in[24] + (size_t)layer * 64 * 256 * 1024;
    unsigned char* W13 = F.ws + WS_WEXP13; bf16* W2 = (bf16*)(F.ws + WS_WEXP2);
    if (FP8_F2) { LAS float* CM = (LAS float*)(F.lds + 12288);
        for (int it = F.bid; it < 64 * 16; it += F.G) { const int e = it >> 4, n0 = (it & 15) * 32, hh = n0 >> 8, rr = n0 & 255;
            tr_cols_i8_wg((rr < 128 ? w1 : w3) + (size_t)e * 1024 * 256, 256, hh * 128 + (rr & 127), W13 + (size_t)e * 512 * 1024, 1024, n0, (float*)(F.ws + WS_SW13) + e * 512, scr, CM, F.wave, F.lane); }
        __syncthreads(); }
    for (int it = gw; it < 64 * 32; it += NGW) { const int e = it >> 5, nb = it & 31;
        tr_cols_i8_k256(w2 + (size_t)e * 256 * 1024, 1024, nb * 32, (unsigned char*)W2 + (size_t)e * 1024 * 256, nb * 32, (float*)(F.ws + WS_SW2) + e * 1024, scr, F.lane); }
}

__device__ __forceinline__ void moe_tables(const Frame& F, int layer) {
    LAS int* PRE = (LAS int*)(F.lds + MOE_OFF); LAS int* CNT = PRE + 132;
    __syncthreads();
    if (F.tid < NLIST) CNT[F.tid] = (int)__hip_atomic_load(F.ctl + CW_GCNT + layer * NLIST + F.tid, RLX_AGENT);
    __syncthreads();
    if (F.tid < NLIST) { const int v = (CNT[F.tid] + 255) >> 8; int inc = v;
#pragma unroll
        for (int o = 1; o < 64; o <<= 1) { const int n = __shfl_up(inc, o); if (F.lane >= o) inc += n; }
        PRE[F.tid] = inc - v; if (F.lane == 63) PRE[129 + (F.tid >> 6)] = inc; }
    __syncthreads();
    if (F.tid >= 64 && F.tid < NLIST) PRE[F.tid] += PRE[129];
    if (F.tid == 0) PRE[NLIST] = PRE[129] + PRE[130];
    __syncthreads();
}
__device__ __forceinline__ int moe_find_list(LAS const int* PRE, int pair, int lane) {
    int t_ = threadIdx.x; asm volatile("" : "+v"(t_)); lane = t_ & 63;
    const unsigned long long b0 = __ballot(PRE[1 + lane] <= pair), b1 = __ballot(PRE[65 + lane] <= pair);
    return __popcll(b0) + __popcll(b1);
}
struct SchedMoe1 {
    static constexpr unsigned ESZ = FP8_F2 ? 1u : 2u;
    unsigned H2, W13, SH13; const v2u* LISTS; LAS const int* PRE; LAS const int* CNT; int G, c, T2, lane;
    __device__ __forceinline__ bool next(int i, pg8::Unit& u) const {
        const int idx = i * G + c; if (idx >= T2 + 256) return false;
        if (idx < T2) { const int pair = idx >> 1; const int l = moe_find_list(PRE, pair, lane); u.e = l; u.pm = __builtin_amdgcn_readfirstlane(pair - PRE[l]); u.pn = idx & 1; u.aux = pair * 256; }
        else { const int s = idx - T2; u.e = -1; u.pm = s >> 1; u.pn = s & 1; u.aux = ACT_SH_ROW + (s >> 1) * 256; }
        return true;
    }
    __device__ __forceinline__ unsigned a_off(const pg8::Unit&) const { return H2; }
    __device__ __forceinline__ unsigned b_off(const pg8::Unit& u) const { return u.e < 0 ? SH13 + (unsigned)u.pn * 256u * 1024u * ESZ : W13 + ((unsigned)(u.e & 63) * 512u + (unsigned)u.pn * 256u) * 1024u * ESZ; }
    __device__ __forceinline__ unsigned a_rowoff(const pg8::Unit& u, int r) const {
        if (u.e < 0) return (unsigned)(u.pm * 256 + r) * 1024u * ESZ;
        int pos = u.pm * 256 + r; const int cn = __builtin_amdgcn_readfirstlane(CNT[u.e]); pos = pos < cn ? pos : cn - 1;
        return (LISTS[(size_t)u.e * LISTCAP + pos].x >> 3) * 1024u * ESZ;
    }
};
struct EpiAct {
    PG8_USE_PERM(Perm8)
    unsigned char* ACT; float* SACT; LAS float* RMAX; const v2u* LISTS; LAS const int* CNT; const float *SA2, *SW13, *SSH13;
    __device__ __forceinline__ void operator()(const f32x4 (&acc)[2][2][4][2], const pg8::Unit& u, int wr, int wc, int fr, int fq) const {
        unsigned lo = (unsigned)(fr * 256 + 8 * fq); OPAQUE_V(lo);
        unsigned lf = (unsigned)fr; OPAQUE_V(lf); unsigned lc4 = (unsigned)(8 * fq) * 4u; OPAQUE_V(lc4);
        unsigned char* ub = ACT + ((size_t)(u.aux + wr * 64) * 256 + u.pn * 128 + wc * 32);
        float sa[8]; f32x4 sw[2][2];
        {
            const float* swp = (u.e < 0 ? SSH13 : SW13 + (size_t)(u.e & 63) * 512) + u.pn * 256 + wc * 32;
#pragma unroll
            for (int bj = 0; bj < 2; ++bj) { const char* sp = (const char*)(swp + bj * 128) + lc4; sw[bj][0] = *(const f32x4*)sp; sw[bj][1] = *(const f32x4*)(sp + 16); }
            if (u.e < 0) {
#pragma unroll
                for (int i = 0; i < 8; ++i) sa[i] = SA2[u.pm * 256 + wr * 64 + (i >> 2) * 128 + (i & 3) * 16 + (int)lf];
            } else {
                const int cn = __builtin_amdgcn_readfirstlane(CNT[u.e]); const v2u* lst = LISTS + (size_t)u.e * LISTCAP; unsigned tk[8];
#pragma unroll
                for (int i = 0; i < 8; ++i) { int pos = u.pm * 256 + wr * 64 + (i >> 2) * 128 + (i & 3) * 16 + (int)lf; pos = pos < cn ? pos : cn - 1; tk[i] = lst[pos].x >> 3; }
#pragma unroll
                for (int i = 0; i < 8; ++i) sa[i] = SA2[tk[i]];
            }
        }
        f32x4 v0[8], v1[8];
#pragma unroll
        for (int i = 0; i < 8; ++i) { const int ai = i >> 2, m = i & 3; const float s = sa[i]; float am = 0.f;
#pragma unroll
            for (int q = 0; q < 4; ++q) { const float a0 = acc[ai][0][m][0][q] * (sw[0][0][q] * s), a1 = acc[ai][0][m][1][q] * (sw[0][1][q] * s);
                v0[i][q] = a0 * fsigmoid(a0) * (acc[ai][1][m][0][q] * (sw[1][0][q] * s)); v1[i][q] = a1 * fsigmoid(a1) * (acc[ai][1][m][1][q] * (sw[1][1][q] * s));
                am = fmaxf(am, fmaxf(fabsf(v0[i][q]), fabsf(v1[i][q]))); }
            am = fmaxf(am, __shfl_xor(am, 16)); am = fmaxf(am, __shfl_xor(am, 32));
            if (fq == 0) RMAX[(ai * 128 + wr * 64 + m * 16 + (int)lf) * 4 + wc] = am; }
        asm volatile("s_waitcnt lgkmcnt(0)" ::: "memory"); __builtin_amdgcn_s_barrier(); asm volatile("" ::: "memory");
#pragma unroll
        for (int i = 0; i < 8; ++i) { const int ai = i >> 2, m = i & 3; const int row = ai * 128 + wr * 64 + m * 16 + (int)lf;
            const f32x4 mx = *(const LAS f32x4*)(RMAX + row * 4); const float am = fmaxf(fmaxf(fmaxf(mx[0], mx[1]), fmaxf(mx[2], mx[3])), 1e-4f), inv = 127.0f / am;
            v2u w; w.x = pk4_i8(v0[i][0], v0[i][1], v0[i][2], v0[i][3], inv); w.y = pk4_i8(v1[i][0], v1[i][1], v1[i][2], v1[i][3], inv);
            *(v2u*)(ub + (size_t)(ai * 128 + m * 16) * 256 + lo) = w;
            if (wc == 0 && fq == 0) SACT[(size_t)(u.aux + row) * 2 + u.pn] = am * (1.0f / 127.0f); }
    }
};
constexpr float Y_MUL = 16.0f, Y_INV = 0.0625f;
struct SchedMoe2 {
    unsigned ACT, W2, SH2; LAS const int* PRE; int G, c, T4, lane; const float* SACT;
    __device__ __forceinline__ bool next(int i, pg8::Unit& u) const {
        const int idx = i * G + c; if (idx >= T4 + 512) return false;
        if (idx < T4) { const int pair = idx >> 2; const int l = moe_find_list(PRE, pair, lane); u.e = l; u.pm = __builtin_amdgcn_readfirstlane(pair - PRE[l]); u.pn = idx & 3; u.aux = pair * 256; }
        else { const int s = idx - T4; u.e = -1; u.pm = s >> 2; u.pn = s & 3; u.aux = ACT_SH_ROW + (s >> 2) * 256; }
        return true;
    }
    __device__ __forceinline__ unsigned a_off(const pg8::Unit& u) const { return ACT + (unsigned)u.aux * 256u; }
    __device__ __forceinline__ unsigned b_off(const pg8::Unit& u) const { return u.e < 0 ? SH2 + (unsigned)u.pn * 256u * 256u : W2 + ((unsigned)(u.e & 63) * 1024u + (unsigned)u.pn * 256u) * 256u; }
    __device__ __forceinline__ unsigned a_rowoff(const pg8::Unit&, int) const { return 0u; }
    __device__ __forceinline__ f32x2 kscale(const pg8::Unit& u, int r) const { return *(const f32x2*)(SACT + (size_t)(u.aux + r) * 2); }
};
struct EpiY {
    PG8_USE_PERM(Perm16)
    unsigned char* YH; bf16* SY; const v2u* LISTS; LAS const int* CNT; int mode; const float *SACT, *SW2, *SSH2;
    __device__ __forceinline__ void operator()(const f32x4 (&acc)[2][2][4][2], const pg8::Unit& u, int wr, int wc, int fr, int fq) const {
        if (mode == 1) { float s = 0.f;
#pragma unroll
            for (int ai = 0; ai < 2; ++ai)
#pragma unroll
                for (int m = 0; m < 4; ++m) s += acc[ai][0][m][0][0] + acc[ai][1][m][1][3];
            if (s == 1.2345e-33f) SY[0] = 1; return; }
        unsigned lf = (unsigned)fr; OPAQUE_V(lf);
        unsigned lc = (unsigned)(16 * fq); OPAQUE_V(lc);
        f32x4 sw[2][2]; float sf[8];
        { const char* sp = (const char*)((u.e < 0 ? SSH2 : SW2 + (size_t)(u.e & 63) * 1024) + u.pn * 256 + wc * 64) + lc * 4u;
#pragma unroll
          for (int bj = 0; bj < 2; ++bj)
#pragma unroll
              for (int n = 0; n < 2; ++n) sw[bj][n] = *(const f32x4*)(sp + (bj * 8 + n * 4) * 4);
#pragma unroll
          for (int i = 0; i < 8; ++i) { const f32x2 s = *(const f32x2*)(SACT + (size_t)(u.aux + wr * 64 + (i >> 2) * 128 + (i & 3) * 16 + (int)lf) * 2); sf[i] = fmaxf(s.y, s.x * 1e-3f); } }
        if (u.e < 0) {
            unsigned lo = (unsigned)(fr * 1024 + 16 * fq) * 2u; OPAQUE_V(lo);
            char* ub = (char*)SY + ((size_t)(u.pm * 256 + wr * 64) * 1024 + u.pn * 256 + wc * 64) * 2;
#pragma unroll
            for (int ai = 0; ai < 2; ++ai)
#pragma unroll
                for (int m = 0; m < 4; ++m)
#pragma unroll
                    for (int bj = 0; bj < 2; ++bj) { const f32x4 v0 = acc[ai][bj][m][0] * (sw[bj][0] * sf[ai * 4 + m]), v1 = acc[ai][bj][m][1] * (sw[bj][1] * sf[ai * 4 + m]);
                        v4u o; o.x = cvt_pk_bf16(v0[0], v0[1]); o.y = cvt_pk_bf16(v0[2], v0[3]); o.z = cvt_pk_bf16(v1[0], v1[1]); o.w = cvt_pk_bf16(v1[2], v1[3]);
                        *(v4u*)(ub + (size_t)(ai * 128 + m * 16) * 2048 + bj * 16 + lo) = o; }
            return;
        }
        const int cn = __builtin_amdgcn_readfirstlane(CNT[u.e]); const int posU = u.pm * 256 + wr * 64;
        const v2u* lst = LISTS + (size_t)u.e * LISTCAP + posU; unsigned char* ub = YH + (size_t)(u.pn * 256 + wc * 64);
        v2u ent[8];
#pragma unroll
        for (int i = 0; i < 8; ++i) { const int ro = (i >> 2) * 128 + (i & 3) * 16 + (int)lf; ent[i] = (posU + ro < cn) ? lst[ro] : (v2u){0xffffffffu, 0u}; }
#pragma unroll
        for (int ai = 0; ai < 2; ++ai)
#pragma unroll
            for (int m = 0; m < 4; ++m) { const v2u en = ent[ai * 4 + m];
                if (en.x != 0xffffffffu) { const float w = __uint_as_float(en.y) * Y_MUL * sf[ai * 4 + m];
                    const f32x4 a0 = acc[ai][0][m][0] * (sw[0][0] * w), a1 = acc[ai][0][m][1] * (sw[0][1] * w), b0 = acc[ai][1][m][0] * (sw[1][0] * w), b1 = acc[ai][1][m][1] * (sw[1][1] * w);
                    v4u o; o.x = pk4_fp8(a0[0], a0[1], a0[2], a0[3]); o.y = pk4_fp8(a1[0], a1[1], a1[2], a1[3]); o.z = pk4_fp8(b0[0], b0[1], b0[2], b0[3]); o.w = pk4_fp8(b1[0], b1[1], b1[2], b1[3]);
                    *(v4u*)(ub + (size_t)en.x * 1024 + lc) = o; } }
    }
};
__device__ __forceinline__ f32x4 fp8x4_to_f32(unsigned w) {
    const f32x2 lo = __builtin_amdgcn_cvt_pk_f32_fp8(w, false), hi = __builtin_amdgcn_cvt_pk_f32_fp8(w, true); return (f32x4){lo[0], lo[1], hi[0], hi[1]}; }
__device__ __forceinline__ void combine_phase(const Frame& F, const Args& A, int layer, bf16* x, float* out) {
    const bool last = (layer == NLAYER - 1);
    LAS float* GATE = (LAS float*)F.lds; LAS float* GS = GATE + NB * DM; LAS float* SH = GS + NB * DM;
    __syncthreads();
    { const int j = layer * 2 + 1; const float* bias = ada_bias(A, j);
      for (int i = F.tid; i < NB * DM; i += NTHR) { const int b = i >> 10, k = i & 1023; GATE[i] = ada_acc(F, j, b)[2048 + k] + bias[2048 + k]; } }
    if (!last) norm_tables(F, A, (layer + 1) * 2, A.in[5] + (layer + 1) * DM, 0, NB, GS, SH);
    else for (int i = F.tid; i < DM; i += NTHR) GS[i] = A.in[28][i];
    __syncthreads();
    const unsigned char* YH = F.ws + WS_YH; const bf16* SY = (const bf16*)(F.ws + WS_SY); unsigned char* H = F.ws + WS_HIN;
    const int gw = F.bid * NWAVES + F.wave, NGW = F.G * NWAVES; const int c0 = 16 * F.lane;
    for (int tok = gw; tok < NTOK; tok += NGW) {
        const int b = tok >> 12;
        bf16* xr = x + (size_t)tok * DM + c0;
        f32x4 xv[4]; v4u yv[8], sv[2], xw[2];
        xw[0] = *(const v4u*)xr; xw[1] = *(const v4u*)(xr + 8);
        sv[0] = *(const v4u*)(SY + (size_t)tok * DM + c0); sv[1] = *(const v4u*)(SY + (size_t)tok * DM + c0 + 8);
#pragma unroll
        for (int k = 0; k < 8; ++k) yv[k] = *(const v4u*)(YH + ((size_t)tok * 8 + k) * 1024 + c0);
        float ssq = 0.f;
#pragma unroll
        for (int q = 0; q < 4; ++q) { const unsigned x0 = xw[q >> 1][(q & 1) * 2], x1 = xw[q >> 1][(q & 1) * 2 + 1]; xv[q] = (f32x4){bflo(x0), bfhi(x0), bflo(x1), bfhi(x1)}; }
#pragma unroll
        for (int q = 0; q < 4; ++q) { f32x4 s = (f32x4){0.f, 0.f, 0.f, 0.f};
#pragma unroll
            for (int k = 0; k < 8; ++k) s += fp8x4_to_f32(yv[k][q]);
            const unsigned w0 = sv[q >> 1][(q & 1) * 2], w1 = sv[q >> 1][(q & 1) * 2 + 1];
            s = s * Y_INV + (f32x4){bflo(w0), bfhi(w0), bflo(w1), bfhi(w1)};
            xv[q] = xv[q] + *(LAS const f32x4*)(GATE + b * DM + c0 + 4 * q) * s;
            ssq += (xv[q].x * xv[q].x + xv[q].y * xv[q].y) + (xv[q].z * xv[q].z + xv[q].w * xv[q].w); }
        const float rstd = 1.0f / sqrtf(wave_sum(ssq) * (1.0f / DM) + EPSV);
        if (last) {
#pragma unroll
            for (int q = 0; q < 4; ++q) *(f32x4*)(out + (size_t)tok * DM + c0 + 4 * q) = (xv[q] * rstd) * *(LAS const f32x4*)(GS + c0 + 4 * q);
        } else {
            f32x4 hh[4];
            { v4u o0, o1; o0.x = cvt_pk_bf16(xv[0][0], xv[0][1]); o0.y = cvt_pk_bf16(xv[0][2], xv[0][3]); o0.z = cvt_pk_bf16(xv[1][0], xv[1][1]); o0.w = cvt_pk_bf16(xv[1][2], xv[1][3]);
              o1.x = cvt_pk_bf16(xv[2][0], xv[2][1]); o1.y = cvt_pk_bf16(xv[2][2], xv[2][3]); o1.z = cvt_pk_bf16(xv[3][0], xv[3][1]); o1.w = cvt_pk_bf16(xv[3][2], xv[3][3]);
              *(v4u*)xr = o0; *(v4u*)(xr + 8) = o1; }
#pragma unroll
            for (int q = 0; q < 4; ++q) {
                hh[q] = (xv[q] * rstd) * *(LAS const f32x4*)(GS + b * DM + c0 + 4 * q) + *(LAS const f32x4*)(SH + b * DM + c0 + 4 * q); }
            if (FP8_T1) { float am = 0.f;
#pragma unroll
                for (int q = 0; q < 4; ++q) am = fmaxf(am, fmaxf(fmaxf(fabsf(hh[q][0]), fabsf(hh[q][1])), fmaxf(fabsf(hh[q][2]), fabsf(hh[q][3]))));
                am = fmaxf(wave_max(am), 1e-20f); const float inv = 127.0f / am; if (F.lane == 0) ((float*)(F.ws + WS_SA))[tok] = am * (1.0f / 127.0f);
                v4u o; o.x = pk4_i8(hh[0][0], hh[0][1], hh[0][2], hh[0][3], inv); o.y = pk4_i8(hh[1][0], hh[1][1], hh[1][2], hh[1][3], inv); o.z = pk4_i8(hh[2][0], hh[2][1], hh[2][2], hh[2][3], inv); o.w = pk4_i8(hh[3][0], hh[3][1], hh[3][2], hh[3][3], inv);
                *(v4u*)(H + (size_t)tok * DM + c0) = o; }
            else { v4u o0, o1; o0.x = pk2(hh[0][0], hh[0][1]); o0.y = pk2(hh[0][2], hh[0][3]); o0.z = pk2(hh[1][0], hh[1][1]); o0.w = pk2(hh[1][2], hh[1][3]);
                o1.x = pk2(hh[2][0], hh[2][1]); o1.y = pk2(hh[2][2], hh[2][3]); o1.z = pk2(hh[3][0], hh[3][1]); o1.w = pk2(hh[3][2], hh[3][3]);
                *(v4u*)(H + ((size_t)tok * DM + c0) * 2) = o0; *(v4u*)(H + ((size_t)tok * DM + c0) * 2 + 16) = o1; }
        }
    }
}

__device__ __forceinline__ void krr_job(const Frame& F) {
    const bf16* __restrict__ CQ = (const bf16*)(F.ws + WS_CQ); bf16* __restrict__ KRR = (bf16*)(F.ws + WS_KRR); const float* __restrict__ rc = (const float*)(F.ws + WS_ROPEC); const float* __restrict__ rs = (const float*)(F.ws + WS_ROPES);
    for (int idx = F.bid * NTHR + F.tid; idx < NTOK * 2; idx += F.G * NTHR) { const int tok = idx >> 1, i8 = (idx & 1) * 8;
        const v4u a = *(const v4u*)(CQ + (size_t)tok * 512 + 384 + i8), b = *(const v4u*)(CQ + (size_t)tok * 512 + 400 + i8);
        const f32x4 c0 = *(const f32x4*)(rc + (size_t)tok * 16 + i8), c1 = *(const f32x4*)(rc + (size_t)tok * 16 + i8 + 4), s0 = *(const f32x4*)(rs + (size_t)tok * 16 + i8), s1 = *(const f32x4*)(rs + (size_t)tok * 16 + i8 + 4);
        const float x1[8] = {bflo(a.x), bfhi(a.x), bflo(a.y), bfhi(a.y), bflo(a.z), bfhi(a.z), bflo(a.w), bfhi(a.w)}, x2[8] = {bflo(b.x), bfhi(b.x), bflo(b.y), bfhi(b.y), bflo(b.z), bfhi(b.z), bflo(b.w), bfhi(b.w)};
        const float c[8] = {c0[0], c0[1], c0[2], c0[3], c1[0], c1[1], c1[2], c1[3]}, s[8] = {s0[0], s0[1], s0[2], s0[3], s1[0], s1[1], s1[2], s1[3]};
        float o1[8], o2[8];
#pragma unroll
        for (int q = 0; q < 8; ++q) { o1[q] = x1[q] * c[q] - x2[q] * s[q]; o2[q] = x2[q] * c[q] + x1[q] * s[q]; }
        v4u w1, w2; w1.x = pk2(o1[0], o1[1]); w1.y = pk2(o1[2], o1[3]); w1.z = pk2(o1[4], o1[5]); w1.w = pk2(o1[6], o1[7]); w2.x = pk2(o2[0], o2[1]); w2.y = pk2(o2[2], o2[3]); w2.z = pk2(o2[4], o2[5]); w2.w = pk2(o2[6], o2[7]);
        *(v4u*)(KRR + (size_t)tok * 32 + i8) = w1; *(v4u*)(KRR + (size_t)tok * 32 + 16 + i8) = w2; }
}
#define POOL_ADD(s, v, sg) do { s[0] += sg bflo(v.x); s[1] += sg bfhi(v.x); s[2] += sg bflo(v.y); s[3] += sg bfhi(v.y); s[4] += sg bflo(v.z); s[5] += sg bfhi(v.z); s[6] += sg bflo(v.w); s[7] += sg bfhi(v.w); } while (0)
__device__ __forceinline__ void pool_job(const Frame& F) {
    const bf16* __restrict__ UB = (const bf16*)(F.ws + WS_UB); bf16* __restrict__ PO = (bf16*)(F.ws + WS_POOL);
    for (int idx = F.bid * NTHR + F.tid; idx < (NTOK / 4) * 64; idx += F.G * NTHR) { const int t0 = (idx >> 6) * 4, c8 = idx & 63, g = c8 >> 4, w = 2 << g, ts = t0 & (SEQ - 1);
        const bf16* up = UB + (size_t)t0 * 512 + c8 * 8;
        v4u r[19];
#pragma unroll
        for (int k = 0; k < 19; ++k) { r[k] = (v4u){0u, 0u, 0u, 0u}; if (k >= 16 - w && ts - 15 + k >= 0) r[k] = *(const v4u*)(up + (k - 15) * 512); }
        float s[8];
#pragma unroll
        for (int q = 0; q < 8; ++q) s[q] = 0.f;
#pragma unroll
        for (int k = 0; k < 16; ++k) POOL_ADD(s, r[k], +);
#pragma unroll
        for (int i = 0; i < 4; ++i) {
            if (i > 0) { const v4u nw = r[15 + i]; const v4u od = (g == 0) ? r[13 + i] : (g == 1) ? r[11 + i] : (g == 2) ? r[7 + i] : r[i - 1]; POOL_ADD(s, nw, +); POOL_ADD(s, od, -); }
            const int n = (ts + i + 1 < w) ? ts + i + 1 : w; const float inv = 1.0f / (float)n; const v4u u = r[15 + i];
            v4u o; o.x = pk2(s[0] * inv - bflo(u.x), s[1] * inv - bfhi(u.x)); o.y = pk2(s[2] * inv - bflo(u.y), s[3] * inv - bfhi(u.y)); o.z = pk2(s[4] * inv - bflo(u.z), s[5] * inv - bfhi(u.z)); o.w = pk2(s[6] * inv - bflo(u.w), s[7] * inv - bfhi(u.w));
            *(v4u*)(PO + (size_t)(t0 + i) * 512 + c8 * 8) = o; }
    }
}
#undef POOL_ADD
__device__ __forceinline__ void dil_combine_job(const Frame& F) {
    const bf16* __restrict__ OD = (const bf16*)(F.ws + WS_QKV); const float* __restrict__ LSE = (const float*)(F.ws + WS_LSE); bf16* __restrict__ YA = (bf16*)(F.ws + WS_CKV);
    const int S = F.G * NTHR;
    for (int idx0 = F.bid * NTHR + F.tid; idx0 < NTOK * 32; idx0 += 4 * S) {
        float l[4][3]; v4u a[4], b[4], c[4];
#pragma unroll
        for (int u = 0; u < 4; ++u) { const int idx = idx0 + u * S; if (idx < NTOK * 32) { const int tok = idx >> 5, hh = (idx >> 3) & 3, d8 = idx & 7;
            l[u][0] = LSE[(size_t)tok * 12 + hh]; l[u][1] = LSE[(size_t)tok * 12 + 4 + hh]; l[u][2] = LSE[(size_t)tok * 12 + 8 + hh];
            a[u] = *(const v4u*)(OD + (size_t)tok * 2304 + hh * 64 + d8 * 8); b[u] = *(const v4u*)(OD + (size_t)tok * 2304 + (4 + hh) * 64 + d8 * 8); c[u] = *(const v4u*)(OD + (size_t)tok * 2304 + (8 + hh) * 64 + d8 * 8); } }
#pragma unroll
        for (int u = 0; u < 4; ++u) { const int idx = idx0 + u * S; if (idx < NTOK * 32) { const int tok = idx >> 5, hh = (idx >> 3) & 3, d8 = idx & 7;
            const float mx = fmaxf(l[u][0], fmaxf(l[u][1], l[u][2])); float w0 = __builtin_amdgcn_exp2f(l[u][0] - mx), w1 = __builtin_amdgcn_exp2f(l[u][1] - mx), w2 = __builtin_amdgcn_exp2f(l[u][2] - mx);
            const float inv = 1.0f / (w0 + w1 + w2); w0 *= inv; w1 *= inv; w2 *= inv;
            const v4u A = a[u], B = b[u], C = c[u]; v4u o;
            o.x = pk2(w0 * bflo(A.x) + w1 * bflo(B.x) + w2 * bflo(C.x), w0 * bfhi(A.x) + w1 * bfhi(B.x) + w2 * bfhi(C.x));
            o.y = pk2(w0 * bflo(A.y) + w1 * bflo(B.y) + w2 * bflo(C.y), w0 * bfhi(A.y) + w1 * bfhi(B.y) + w2 * bfhi(C.y));
            o.z = pk2(w0 * bflo(A.z) + w1 * bflo(B.z) + w2 * bflo(C.z), w0 * bfhi(A.z) + w1 * bfhi(B.z) + w2 * bfhi(C.z));
            o.w = pk2(w0 * bflo(A.w) + w1 * bflo(B.w) + w2 * bflo(C.w), w0 * bfhi(A.w) + w1 * bfhi(B.w) + w2 * bfhi(C.w));
            *(v4u*)(YA + (size_t)tok * 256 + hh * 64 + d8 * 8) = o; } }
    }
}
__device__ __forceinline__ void final_norm(const Frame& F, const Args& A, float* x) {
    const int gw = F.bid * NWAVES + F.wave, NGW = F.G * NWAVES; const float* g = A.in[28];
    for (int m = gw; m < NTOK; m += NGW) { f32x4* xr = (f32x4*)(x + (size_t)m * DM) + F.lane; f32x4 v[4]; float s = 0.f;
#pragma unroll
        for (int q = 0; q < 4; ++q) { v[q] = xr[64 * q]; s += (v[q].x * v[q].x + v[q].y * v[q].y) + (v[q].z * v[q].z + v[q].w * v[q].w); }
        const float rstd = 1.0f / sqrtf(wave_sum(s) * (1.0f / DM) + EPSV);
#pragma unroll
        for (int q = 0; q < 4; ++q) xr[64 * q] = (v[q] * rstd) * *(const f32x4*)(g + 4 * F.lane + 256 * q); }
}

__device__ __forceinline__ void dilated_units(const Frame& F, bf16* o_redirect, float* lse_redirect) {
    bf16* QKV = (bf16*)(F.ws + WS_QKV); float* LSE = (float*)(F.ws + WS_LSE);
    for (int u = F.bid; u < 1536; u += F.G) {
        const int g = u >> 9, v = u & 511; int b, r, h, qb, d;
        if (g == 0) { d = 1; b = v >> 6; h = (v >> 4) & 3; qb = v & 15; r = 0; }
        else if (g == 1) { d = 4; b = v >> 6; r = (v >> 4) & 3; h = (v >> 2) & 3; qb = v & 3; }
        else { d = 16; b = v >> 6; r = (v >> 2) & 15; h = v & 3; qb = 0; }
        const int hd = g * 4 + h; const size_t tok0 = (size_t)b * SEQ + r;
        AttnCfg cf; const long pitch = (long)d * 2304;
        cf.Qp = QKV + tok0 * 2304 + hd * 64; cf.qpitch = pitch; cf.Kp = QKV + tok0 * 2304 + 768 + hd * 64; cf.kpitch = pitch; cf.K2p = nullptr; cf.k2pitch = 0;
        cf.Vp = QKV + tok0 * 2304 + 1536 + hd * 64; cf.vpitch = pitch; cf.Op = QKV + tok0 * 2304 + hd * 64; cf.opitch = pitch;
        cf.lsep = LSE + tok0 * 12 + hd; cf.lsepitch = (long)d * 12;
        if (o_redirect) { cf.Op = o_redirect + tok0 * 768 + hd * 64; cf.opitch = (long)d * 768; cf.lsep = lse_redirect + tok0 * 12 + hd; }
        cf.q0 = qb * 256; cf.kt_lo = qb == 0 ? 0 : (qb * 256 - 128) / 64; cf.kt_hi = (qb * 256 + 256) / 64; cf.band = 128;
        dil_unit(cf, F.lds);
    }
}
__device__ __forceinline__ void mla_units(const Frame& F) {
    const bf16* Q = (const bf16*)(F.ws + WS_Q); const bf16* KV = (const bf16*)(F.ws + WS_KV); const bf16* KRR = (const bf16*)(F.ws + WS_KRR); bf16* YC = (bf16*)(F.ws + WS_UB);
    for (int p = F.bid; p < 512; p += F.G) {
        const int bh = p >> 3, s = p & 7, b = bh >> 3, h = bh & 7;
        for (int half = 0; half < 2; ++half) { const int qb = half ? 15 - s : s; const size_t tok0 = (size_t)b * SEQ;
            AttnCfg cf;
            cf.Qp = Q + tok0 * 768 + h * 96; cf.qpitch = 768; cf.Kp = KV + tok0 * 1024 + h * 128; cf.kpitch = 1024; cf.K2p = KRR + tok0 * 32; cf.k2pitch = 32;
            cf.Vp = KV + tok0 * 1024 + h * 128 + 64; cf.vpitch = 1024; cf.Op = YC + tok0 * 512 + h * 64; cf.opitch = 512; cf.lsep = nullptr; cf.lsepitch = 0;
            cf.q0 = qb * 256; cf.kt_lo = 0; cf.kt_hi = (qb * 256 + 256) / 64; cf.band = 0;
            attn_unit<96>(cf, F.lds); }
    }
}

constexpr int PH_PER_LAYER = 9, N_PHASES = 2 + NLAYER * PH_PER_LAYER;
#ifndef ONLY_PH
#define ONLY_PH -1
#endif
#ifndef T1_SKEW
#define T1_SKEW 3
#endif
#ifndef PROBE_DUP
#define PROBE_DUP -1
#endif
#ifndef T1_ROT
#define T1_ROT 1
#endif
#ifndef PROBE_T
#define PROBE_T -1
#endif
#ifndef PROBE_K
#define PROBE_K 3
#endif
__global__ void __launch_bounds__(NTHR, 2) fwd_kernel(Args args) {
    extern __shared__ __attribute__((aligned(16))) unsigned char lds_raw[];
    Frame F;
    F.lds = (LAS unsigned char*)lds_raw;
    F.tid = threadIdx.x; F.lane = F.tid & 63; F.wave = __builtin_amdgcn_readfirstlane(F.tid >> 6); F.G = gridDim.x; F.bid = blockIdx.x;
    F.ws = args.ws; F.ctl = (unsigned*)(args.ws + WS_ZERO);
    volatile LAS unsigned* MISC = (volatile LAS unsigned*)(F.lds + MISC_OFF);
    for (int u = F.tid; u < (LDS_BYTES - LDSCTL_OFF) / 4; u += NTHR) ((LAS unsigned*)(F.lds + LDSCTL_OFF))[u] = 0u;
    __syncthreads();
#if PROBE_T >= 0
    if (blockIdx.x == 0 && threadIdx.x == 0) MISC[16] = (unsigned)__builtin_amdgcn_s_memrealtime();
#endif
    const int lo = args.ph_lo, hi = args.ph_hi;
    const bool multi = (hi - lo) > 1;
    XcdBarrier bar; bar.bar = F.ctl + CW_BAR; bar.x = 0; bar.st = nullptr;
    if (multi) bar = xcd_barrier_post(F.ctl + CW_BAR, MISC + 8);
#define EN(j) (ONLY_PH < 0 || ONLY_PH == (j))
#define REP(k) for (int rep_ = 0; rep_ < ((PROBE_DUP == (k)) ? 2 : 1); ++rep_)
#define PHASE_BEGIN() do { int t_ = threadIdx.x; asm volatile("" : "+v"(t_)); F.tid = t_; F.lane = t_ & 63; GAS unsigned char* w_ = (GAS unsigned char*)args.ws; asm volatile("" : "+s"(w_)); F.ws = (unsigned char*)w_; F.ctl = (unsigned*)F.ws; } while (0)
#define IN(k) (lo <= (k) && (k) < hi)
#define SEAM(k) do { if (IN(k) && IN((k) + 1)) xcd_barrier(bar); TPROBE(k); } while (0)
#if PROBE_T >= 0
#define TMATCH(k) ((k) < 2 ? (PROBE_T == 100 + (k)) : (((k) - 2) % PH_PER_LAYER == PROBE_T))
#define TPROBE(k) do { if (blockIdx.x == 0 && threadIdx.x == 0) { const unsigned t_ = (unsigned)__builtin_amdgcn_s_memrealtime(); if (TMATCH(k)) MISC[17] += t_ - MISC[16]; MISC[16] = t_; } } while (0)
#define TMARK(id) do { if (blockIdx.x == 0 && threadIdx.x == 0) { const unsigned t_ = (unsigned)__builtin_amdgcn_s_memrealtime(); if (PROBE_T == (id)) MISC[17] += t_ - MISC[16]; MISC[16] = t_; } } while (0)
#else
#define TPROBE(k) do {} while (0)
#define TMARK(id) do {} while (0)
#endif
#define Wb ((bf16*)(F.ws + WS_W))
    float* const dout = args.out; bf16* const xres = (bf16*)(args.ws + WS_X);
    if (EN(0) && IN(0)) { PHASE_BEGIN(); REP(0) { p0_phase(F, args); __syncthreads(); } REP(10) { convert_layer_weights(F, args, 0); __syncthreads(); } } SEAM(0);
    if (EN(1) && IN(1)) { PHASE_BEGIN(); ada_tables(F, args); REP(1) { norm_rows(F, args, args.in[0], 0, args.in[5], F.ws + WS_HIN); __syncthreads(); } } SEAM(1);
    for (int layer = 0; layer < NLAYER; ++layer) {
        const int pb = 2 + layer * PH_PER_LAYER;
        if (EN(2) && IN(pb + 0)) { PHASE_BEGIN(); for (int rep_ = 0; rep_ < ((PROBE_DUP == 2 || PROBE_DUP == 23) ? 2 : 1); ++rep_) {
            SchedDense S; S.init(WS_HIN, WS_W + WO_WIN, 1024, 1024, NTOK, NINP, F.G, F.bid, FP8_T1 ? 1 : 2); if (T1_ROT) S.rotate();
            EpiWin E{(bf16*)(F.ws + WS_QKV), (bf16*)(F.ws + WS_UB), (bf16*)(F.ws + WS_CQ), (bf16*)(F.ws + WS_CKV), (bf16*)(F.ws + WS_G), (float*)(F.ws + WS_SSQ), (float*)(F.ws + WS_SSKV), (PROBE_DUP == 23 && rep_ == 0) ? 1 : 0, FP8_T1 ? (const float*)(F.ws + WS_SA) : nullptr, (const float*)(F.ws + WS_SWIN)};
            if (PROBE_DUP == 21) { EpiWin Ed = E; Ed.dry = 1; pg8::gemm_phase<EpiWin, SchedDense, false, (FP8_T1 ? 1 : 2)>(F.lds, F.ws, pg8::Gemm{1024, 1024, 1024, T1_SKEW}, S, Ed); __syncthreads(); }
            pg8::gemm_phase<EpiWin, SchedDense, false, (FP8_T1 ? 1 : 2)>(F.lds, F.ws, pg8::Gemm{1024, 1024, 1024, T1_SKEW}, S, E); }
        } SEAM(pb + 0);
        if (EN(3) && IN(pb + 1)) { PHASE_BEGIN(); REP(3) {
            { SchedDense S; S.init(WS_CQ, WS_W + WO_WUQ, 512, 384, NTOK, 768, F.G, F.bid);
              EpiQ E{(bf16*)(F.ws + WS_Q), (const float*)(F.ws + WS_SSQ), (const float*)(F.ws + WS_ROPEC), (const float*)(F.ws + WS_ROPES)};
              pg8::gemm_phase<EpiQ, SchedDense, false>(F.lds, F.ws, pg8::Gemm{384, 512, 384}, S, E); }
            { SchedDense S; S.init(WS_CKV, WS_W + WO_WKV, 256, 256, NTOK, 1024, F.G, F.bid);
              EpiKV E{(bf16*)(F.ws + WS_KV), (const float*)(F.ws + WS_SSKV)};
              pg8::gemm_phase<EpiKV, SchedDense, false>(F.lds, F.ws, pg8::Gemm{256, 256, 256}, S, E); }
            REP(32) { krr_job(F); } REP(31) { pool_job(F); }
            __syncthreads(); }
            if (PROBE_DUP == 30 && layer == 0) { dilated_units(F, (bf16*)dout, (float*)dout + 16 * MiB); __syncthreads(); }
            dilated_units(F, nullptr, nullptr);
        } SEAM(pb + 1);
        if (EN(4) && IN(pb + 2)) { PHASE_BEGIN(); REP(4) { mla_units(F); REP(41) { dil_combine_job(F); } } } SEAM(pb + 2);
        if (EN(5) && IN(pb + 3)) { PHASE_BEGIN(); REP(5) {
            SchedDense S; S.init(0, 0, 256, 256, NTOK, 1024, F.G, F.bid);
            const T5Seg s0{(unsigned)WS_CKV, (unsigned)(WS_W + WO_WOA), 256, 256}, s1{(unsigned)WS_POOL, (unsigned)(WS_W + WO_WPB), 512, 512}, s2{(unsigned)WS_UB, (unsigned)(WS_W + WO_WOC), 512, 512};
            gemm_t5_phase(F.lds, F.ws, s0, s1, s2, S, (const unsigned char*)(F.ws + WS_G), (bf16*)(F.ws + WS_KV)); }
        } SEAM(pb + 3);
        if (EN(6) && IN(pb + 4)) { PHASE_BEGIN(); for (int rep_ = 0; rep_ < ((PROBE_DUP == 6 && layer == 0) ? 2 : 1); ++rep_) {
            SchedDense S; S.init(WS_KV, WS_W + WO_WOUT, 1024, 1024, NTOK, 1024, F.G, F.bid);
            EpiRes E{layer == 0 ? args.in[0] : nullptr, xres, xres, (const float*)(F.ws + WS_GVT) + layer * NB * DM, (const float*)(F.ws + WS_GS2T) + layer * NB * DM, (float*)(F.ws + WS_XSS), (float*)(F.ws + WS_XMX)};
            pg8::gemm_phase<EpiRes, SchedDense, false>(F.lds, F.ws, pg8::Gemm{1024, 1024, 1024}, S, E); }
        } SEAM(pb + 4);
        if (EN(7) && IN(pb + 5)) { PHASE_BEGIN(); n2_route_phase(F, args, layer, xres); __syncthreads(); REP(7) { n2_convert_experts(F, args, layer); } } SEAM(pb + 5);
        if (EN(8) && IN(pb + 6)) { PHASE_BEGIN(); REP(8) {
            moe_tables(F, layer);
            LAS const int* PRE = (LAS const int*)(F.lds + MOE_OFF); LAS const int* CNT = PRE + 132;
            SchedMoe1 S{(unsigned)WS_H2, (unsigned)WS_WEXP13, (unsigned)(WS_W + WO_SH13), (const v2u*)(F.ws + WS_LISTS), PRE, CNT, F.G, F.bid, __builtin_amdgcn_readfirstlane(2 * PRE[NLIST]), F.lane};
            EpiAct E{F.ws + WS_ACT, (float*)(F.ws + WS_SACT), (LAS float*)(F.lds + LDSCTL_OFF + 8192), (const v2u*)(F.ws + WS_LISTS), CNT, (const float*)(F.ws + WS_SA2), (const float*)(F.ws + WS_SW13), (const float*)(F.ws + WS_SSH13)};
            pg8::gemm_phase<EpiAct, SchedMoe1, true, (FP8_F2 ? 1 : 2)>(F.lds, F.ws, pg8::Gemm{1024, 1024, 1024}, S, E); }
        } SEAM(pb + 6);
        if (EN(9) && IN(pb + 7)) { PHASE_BEGIN(); REP(9) {
            moe_tables(F, layer);
            LAS const int* PRE = (LAS const int*)(F.lds + MOE_OFF); LAS const int* CNT = PRE + 132;
            SchedMoe2 S{(unsigned)WS_ACT, (unsigned)WS_WEXP2, (unsigned)(WS_W + WO_SH2), PRE, F.G, F.bid, __builtin_amdgcn_readfirstlane(4 * PRE[NLIST]), F.lane, (const float*)(F.ws + WS_SACT)};
            EpiY E{F.ws + WS_YH, (bf16*)(F.ws + WS_SY), (const v2u*)(F.ws + WS_LISTS), CNT, 0, (const float*)(F.ws + WS_SACT), (const float*)(F.ws + WS_SW2), (const float*)(F.ws + WS_SSH2)};
            if (PROBE_DUP == 91) { EpiY Ed = E; Ed.mode = 1; pg8::gemm_phase<EpiY, SchedMoe2, false, 1, true>(F.lds, F.ws, pg8::Gemm{256, 256, 256}, S, Ed); __syncthreads(); }
            pg8::gemm_phase<EpiY, SchedMoe2, false, 1, true>(F.lds, F.ws, pg8::Gemm{256, 256, 256}, S, E); }
        } SEAM(pb + 7);
        if (EN(10) && IN(pb + 8)) { PHASE_BEGIN();
            combine_phase(F, args, layer, xres, dout);
            if (layer + 1 < NLAYER) { __syncthreads(); convert_layer_weights(F, args, layer + 1); }
        } SEAM(pb + 8);
    }
#if PROBE_T >= 0
    if (blockIdx.x == 0 && threadIdx.x == 0) { const unsigned d_ = MISC[17] * (unsigned)PROBE_K; const unsigned t0_ = (unsigned)__builtin_amdgcn_s_memrealtime();
        while ((unsigned)__builtin_amdgcn_s_memrealtime() - t0_ < d_) __builtin_amdgcn_s_sleep(32); }
#endif
#undef Wb
#undef IN
#undef SEAM
#undef EN
#undef REP
#undef PHASE_BEGIN
}

#ifndef MK_PER_PHASE
#define MK_PER_PHASE 0
#endif
extern "C" void kernel_launch(void* const* d_in, const int* in_sizes, int n_in, void* d_out, int out_size, void* d_ws, size_t ws_size, hipStream_t stream) {
    static int grid = 0;
    if (grid == 0) {
        if (n_in != 29 || out_size != NTOK * DM || ws_size < WS_END) { fprintf(stderr, "kernel_launch: unexpected problem (n_in %d, out %d, ws %zu < %zu)\n", n_in, out_size, ws_size, (size_t)WS_END); grid = -1; return; }
        int dev = 0, cus = 0, per_cu = 0;
        if (hipGetDevice(&dev) != hipSuccess || hipDeviceGetAttribute(&cus, hipDeviceAttributeMultiprocessorCount, dev) != hipSuccess) { grid = -1; return; }
        if (hipFuncSetAttribute((const void*)fwd_kernel, hipFuncAttributeMaxDynamicSharedMemorySize, LDS_BYTES) != hipSuccess) { fprintf(stderr, "kernel_launch: hipFuncSetAttribute failed\n"); grid = -1; return; }
        if (hipOccupancyMaxActiveBlocksPerMultiprocessor(&per_cu, (const void*)fwd_kernel, NTHR, LDS_BYTES) != hipSuccess || per_cu < 1) { fprintf(stderr, "kernel_launch: occupancy query says %d\n", per_cu); (void)hipGetLastError(); per_cu = 1; }
        grid = cus;
    }
    if (grid < 0) return;
    (void)hipMemsetAsync((char*)d_ws + WS_ZERO, 0, ZERO_BYTES, stream);
    Args a{};
    for (int i = 0; i < 29; ++i) a.in[i] = (const float*)d_in[i];
    a.pos = (const int*)d_in[2]; a.out = (float*)d_out; a.ws = (unsigned char*)d_ws;
#if MK_PER_PHASE
    for (int p = 0; p < N_PHASES; ++p) { a.ph_lo = p; a.ph_hi = p + 1; hipLaunchKernelGGL(fwd_kernel, dim3(grid), dim3(NTHR), LDS_BYTES, stream, a); }
#else
    a.ph_lo = 0; a.ph_hi = N_PHASES; hipLaunchKernelGGL(fwd_kernel, dim3(grid), dim3(NTHR), LDS_BYTES, stream, a);
#endif
}
```
